# Optimizing an MI355X kernel written in HIP

```python
import math
import jax, jax.numpy as jnp
from jax import lax
import numpy as np

D_MODEL = 1024
BATCH = 2
SEQ = 8192
DEPTH = 2

GRID_W = 64
CTX_LEN = 256
SSM_WIDTH = 3 * D_MODEL // 8
SSM_GROUP = 16
SSM_GROUPS = SSM_WIDTH // SSM_GROUP
SSM_STATE = 64
FNET_WIDTH = D_MODEL // 4
FNET_GROUPS = 4
FNET_GROUP = FNET_WIDTH // FNET_GROUPS
HEAD_DIM = 64
NA_WIDTH = 3 * D_MODEL // 8
NA_HEADS = NA_WIDTH // HEAD_DIM
IN_WIDTH = SSM_WIDTH + FNET_WIDTH + 3 * NA_WIDTH
NA_ROWS_MAX = 8
NA_COLS = 16
RPB_ROWS = 2 * NA_ROWS_MAX - 1
RPB_COLS = 2 * NA_COLS - 1
ROPE_BASE = 10000.0
D_FF = -(-8 * D_MODEL // (3 * 256)) * 256
EPS = 1e-6

kernel_name = "hybrid_s5_fnet_natten_dit_block"


def rmsnorm(x, g):
    x32 = x.astype(jnp.float32)
    y = x32 * lax.rsqrt(jnp.mean(x32 * x32, axis=-1, keepdims=True) + EPS)
    return (y * g.astype(jnp.float32)).astype(x.dtype)


def modulate(x, shift, scale):
    return x * (1 + scale) + shift


def axial_rope(x, row, col):
    half = HEAD_DIM // 2
    quarter = half // 2
    freqs = ROPE_BASE ** (-jnp.arange(quarter, dtype=jnp.float32) / quarter)

    def rot(xs, pos):
        ang = pos.astype(jnp.float32)[:, None] * freqs
        cos = jnp.cos(ang)[None, :, None, :]
        sin = jnp.sin(ang)[None, :, None, :]
        x1, x2 = xs[..., :quarter], xs[..., quarter:]
        return jnp.concatenate([x1 * cos - x2 * sin, x2 * cos + x1 * sin], axis=-1)

    x32 = x.astype(jnp.float32)
    return jnp.concatenate([rot(x32[..., :half], row), rot(x32[..., half:], col)], axis=-1).astype(x.dtype)


def ssm_discretise(a_re, a_im, log_dt, b_re, b_im):
    lam = lax.complex(a_re.astype(jnp.float32), a_im.astype(jnp.float32))
    dt = jnp.exp(log_dt.astype(jnp.float32))[:, None]
    lam_bar = jnp.exp(lam * dt)
    bmat = lax.complex(b_re.astype(jnp.float32), b_im.astype(jnp.float32))
    b_bar = ((lam_bar - 1) / lam)[..., None] * bmat
    return lam_bar, b_bar


def ssm_scan(lam_bar, bu, h0, reverse):
    if h0 is not None:
        edge = -1 if reverse else 0
        bu = bu.at[:, edge].add(lam_bar * h0)
    a = jnp.broadcast_to(lam_bar, bu.shape)

    def combine(e1, e2):
        a1, b1 = e1
        a2, b2 = e2
        return a1 * a2, a2 * b1 + b2

    _, h = lax.associative_scan(combine, (a, bu), axis=1, reverse=reverse)
    return h


def s5_mixer(u, uc, a_re, a_im, log_dt, b_re, b_im, c_re, c_im, d_skip, w_glu, need_ctx_out):
    B, L, _ = u.shape
    Lc = uc.shape[1]
    u32 = u.astype(jnp.float32)
    uc32 = uc.astype(jnp.float32)
    ug = u32.reshape(B, L, SSM_GROUPS, SSM_GROUP).astype(jnp.complex64)
    ucg = uc32.reshape(B, Lc, SSM_GROUPS, SSM_GROUP).astype(jnp.complex64)
    dsk = d_skip.astype(jnp.float32)
    y = u32 * dsk
    yc = uc32 * dsk if need_ctx_out else None
    for direction in range(2):
        rev = direction == 1
        lam_bar, b_bar = ssm_discretise(a_re[direction], a_im[direction], log_dt[direction],
                                        b_re[direction], b_im[direction])
        cmat = lax.complex(c_re[direction].astype(jnp.float32), c_im[direction].astype(jnp.float32))
        hc = ssm_scan(lam_bar, jnp.einsum('gph,blgh->blgp', b_bar, ucg), None, rev)
        h0 = hc[:, 0] if rev else hc[:, -1]
        h = ssm_scan(lam_bar, jnp.einsum('gph,blgh->blgp', b_bar, ug), h0, rev)
        y = y + jnp.einsum('ghp,blgp->blgh', cmat, h).real.reshape(B, L, SSM_WIDTH)
        if need_ctx_out:
            yc = yc + jnp.einsum('ghp,blgp->blgh', cmat, hc).real.reshape(B, Lc, SSM_WIDTH)

    def glu(z):
        z = jax.nn.gelu(z).astype(u.dtype)
        return z * jax.nn.sigmoid(z @ w_glu)

    return glu(y), (glu(yc) if need_ctx_out else None)


def fnet_mixer(f, w_fourier):
    B, L, _ = f.shape
    fg = f.astype(jnp.float32).reshape(B, L, FNET_GROUPS, FNET_GROUP)
    mixed = jnp.fft.fft2(fg, axes=(1, 3), norm="ortho").real.reshape(B, L, FNET_WIDTH)
    return mixed.astype(f.dtype) @ w_fourier


def na_latent(q, k, v, kc, vc, rpb):
    B, L, H, d = q.shape
    R = L // GRID_W
    wr = min(NA_ROWS_MAX, R)
    nwin = wr * NA_COLS
    qg = q.reshape(B, R, GRID_W, H, d)
    kg = k.reshape(B, R, GRID_W, H, d)
    vg = v.reshape(B, R, GRID_W, H, d)
    cols = jnp.arange(GRID_W)
    col_start = jnp.clip(cols - NA_COLS // 2, 0, GRID_W - NA_COLS)
    col_idx = col_start[:, None] + jnp.arange(NA_COLS)
    dc = col_idx - cols[:, None] + (NA_COLS - 1)
    scale = d ** -0.5

    def row_block(args):
        r, q_row = args
        rs = jnp.clip(r - wr // 2, 0, R - wr)
        k_rows = lax.dynamic_slice_in_dim(kg, rs, wr, axis=1)
        v_rows = lax.dynamic_slice_in_dim(vg, rs, wr, axis=1)
        k_win = k_rows[:, :, col_idx]
        v_win = v_rows[:, :, col_idx]
        dr = rs + jnp.arange(wr) - r + (NA_ROWS_MAX - 1)
        bias = rpb[:, dr[:, None, None], dc[None]]
        bias = jnp.transpose(bias, (0, 2, 1, 3)).astype(jnp.float32)
        s_win = jnp.einsum('bqhd,bwqkhd->bhqwk', q_row, k_win).astype(jnp.float32) * scale + bias[None]
        s_win = s_win.reshape(B, H, GRID_W, nwin)
        s_ctx = jnp.einsum('bqhd,bchd->bhqc', q_row, kc).astype(jnp.float32) * scale
        p = jax.nn.softmax(jnp.concatenate([s_win, s_ctx], axis=-1), axis=-1).astype(q.dtype)
        p_win = p[..., :nwin].reshape(B, H, GRID_W, wr, NA_COLS)
        p_ctx = p[..., nwin:]
        return (jnp.einsum('bhqwk,bwqkhd->bqhd', p_win, v_win)
                + jnp.einsum('bhqc,bchd->bqhd', p_ctx, vc))

    o = lax.map(row_block, (jnp.arange(R), jnp.moveaxis(qg, 1, 0)))
    return jnp.moveaxis(o, 0, 1).reshape(B, L, H * d)


def na_context(qc, kc, vc):
    B, Lc, H, d = qc.shape
    s = jnp.einsum('bqhd,bkhd->bhqk', qc, kc).astype(jnp.float32) * d ** -0.5
    p = jax.nn.softmax(s, axis=-1).astype(qc.dtype)
    return jnp.einsum('bhqk,bkhd->bqhd', p, vc).reshape(B, Lc, H * d)


def swiglu(h, w_gate, w_up, w_down):
    return (jax.nn.silu(h @ w_gate) * (h @ w_up)) @ w_down


def trunk_layer(x, xc, c, c_ctx, row, col, w_mod, b_mod, g_pre_mix, g_post_mix, w_in,
                ssm_a_re, ssm_a_im, ssm_log_dt, ssm_b_re, ssm_b_im, ssm_c_re, ssm_c_im, ssm_d, w_glu,
                w_fourier, na_rpb, w_out, g_pre_ffn, g_post_ffn, w_ffn_gate, w_ffn_up, w_ffn_down, last):
    B, L, _ = x.shape
    Lc = xc.shape[1]
    mod = (jax.nn.silu(c) @ w_mod + b_mod)[:, None, :]
    mod_c = jax.nn.silu(c_ctx) @ w_mod + b_mod
    sh1, sc1, g1, sh2, sc2, g2 = jnp.split(mod, 6, axis=-1)
    sh1c, sc1c, g1c, sh2c, sc2c, g2c = jnp.split(mod_c, 6, axis=-1)

    h = modulate(rmsnorm(x, g_pre_mix), sh1, sc1) @ w_in
    hc = modulate(rmsnorm(xc, g_pre_mix), sh1c, sc1c) @ w_in
    splits = list(np.cumsum([SSM_WIDTH, FNET_WIDTH, NA_WIDTH, NA_WIDTH]))
    u, f, q, k, v = jnp.split(h, splits, axis=-1)
    uc, fc, qc, kc, vc = jnp.split(hc, splits, axis=-1)

    y_ssm, yc_ssm = s5_mixer(u, uc, ssm_a_re, ssm_a_im, ssm_log_dt, ssm_b_re, ssm_b_im,
                             ssm_c_re, ssm_c_im, ssm_d, w_glu, not last)
    y_fft = fnet_mixer(f, w_fourier)
    q = axial_rope(q.reshape(B, L, NA_HEADS, HEAD_DIM), row, col)
    k = axial_rope(k.reshape(B, L, NA_HEADS, HEAD_DIM), row, col)
    v = v.reshape(B, L, NA_HEADS, HEAD_DIM)
    kc = kc.reshape(B, Lc, NA_HEADS, HEAD_DIM)
    vc = vc.reshape(B, Lc, NA_HEADS, HEAD_DIM)
    y_na = na_latent(q, k, v, kc, vc, na_rpb)
    o = jnp.concatenate([y_ssm, y_fft, y_na], axis=-1) @ w_out
    x = x + g1 * rmsnorm(o, g_post_mix)
    if not last:
        y_fft_c = fnet_mixer(fc, w_fourier)
        y_na_c = na_context(qc.reshape(B, Lc, NA_HEADS, HEAD_DIM), kc, vc)
        oc = jnp.concatenate([yc_ssm, y_fft_c, y_na_c], axis=-1) @ w_out
        xc = xc + g1c * rmsnorm(oc, g_post_mix)

    x = x + g2 * rmsnorm(swiglu(modulate(rmsnorm(x, g_pre_ffn), sh2, sc2), w_ffn_gate, w_ffn_up, w_ffn_down), g_post_ffn)
    if not last:
        xc = xc + g2c * rmsnorm(swiglu(modulate(rmsnorm(xc, g_pre_ffn), sh2c, sc2c), w_ffn_gate, w_ffn_up, w_ffn_down), g_post_ffn)
    else:
        xc = None
    return x, xc


def setup_inputs(seed: int = 0) -> dict:
    key = jax.random.key(seed)
    ks = jax.random.split(key, 26)
    f32 = jnp.float32

    def nrm(k, shape, scale):
        return jax.random.normal(k, shape, f32) * scale

    G, P, Hc = SSM_GROUPS, SSM_STATE, SSM_GROUP
    n_idx = jnp.arange(P, dtype=f32)
    return {
        "x": nrm(ks[0], (BATCH, SEQ, D_MODEL), 1.0),
        "c": nrm(ks[1], (BATCH, D_MODEL), 1.0),
        "ctx": nrm(ks[2], (BATCH, CTX_LEN, D_MODEL), 1.0),
        "c_ctx": nrm(ks[3], (D_MODEL,), 1.0),
        "w_mod": nrm(ks[4], (DEPTH, D_MODEL, 6 * D_MODEL), D_MODEL ** -0.5),
        "b_mod": nrm(ks[5], (DEPTH, 6 * D_MODEL), 0.01),
        "g_pre_mix": 1.0 + nrm(ks[6], (DEPTH, D_MODEL), 0.1),
        "g_post_mix": 1.0 + nrm(ks[7], (DEPTH, D_MODEL), 0.1),
        "w_in": nrm(ks[8], (DEPTH, D_MODEL, IN_WIDTH), D_MODEL ** -0.5),
        "ssm_a_re": -0.5 + nrm(ks[9], (DEPTH, 2, G, P), 0.01),
        "ssm_a_im": math.pi * n_idx + nrm(ks[10], (DEPTH, 2, G, P), 0.01),
        "ssm_log_dt": jax.random.uniform(ks[11], (DEPTH, 2, G), f32, math.log(1e-3), math.log(1e-1)),
        "ssm_b_re": nrm(ks[12], (DEPTH, 2, G, P, Hc), (2 * Hc) ** -0.5),
        "ssm_b_im": nrm(ks[13], (DEPTH, 2, G, P, Hc), (2 * Hc) ** -0.5),
        "ssm_c_re": nrm(ks[14], (DEPTH, 2, G, Hc, P), (2 * P) ** -0.5),
        "ssm_c_im": nrm(ks[15], (DEPTH, 2, G, Hc, P), (2 * P) ** -0.5),
        "ssm_d": nrm(ks[16], (DEPTH, SSM_WIDTH), 1.0),
        "w_glu": nrm(ks[17], (DEPTH, SSM_WIDTH, SSM_WIDTH), SSM_WIDTH ** -0.5),
        "w_fourier": nrm(ks[18], (DEPTH, FNET_WIDTH, FNET_WIDTH), FNET_WIDTH ** -0.5),
        "na_rpb": nrm(ks[19], (DEPTH, NA_HEADS, RPB_ROWS, RPB_COLS), 0.02),
        "w_out": nrm(ks[20], (DEPTH, D_MODEL, D_MODEL), D_MODEL ** -0.5),
        "g_pre_ffn": 1.0 + nrm(ks[21], (DEPTH, D_MODEL), 0.1),
        "g_post_ffn": 1.0 + nrm(ks[22], (DEPTH, D_MODEL), 0.1),
        "w_ffn_gate": nrm(ks[23], (DEPTH, D_MODEL, D_FF), D_MODEL ** -0.5),
        "w_ffn_up": nrm(ks[24], (DEPTH, D_MODEL, D_FF), D_MODEL ** -0.5),
        "w_ffn_down": nrm(ks[25], (DEPTH, D_FF, D_MODEL), D_FF ** -0.5),
    }


def reference(x, c, ctx, c_ctx, w_mod, b_mod, g_pre_mix, g_post_mix, w_in,
              ssm_a_re, ssm_a_im, ssm_log_dt, ssm_b_re, ssm_b_im, ssm_c_re, ssm_c_im, ssm_d, w_glu,
              w_fourier, na_rpb, w_out, g_pre_ffn, g_post_ffn, w_ffn_gate, w_ffn_up, w_ffn_down):
    L = x.shape[1]
    t = jnp.arange(L)
    row = t // GRID_W
    col = t % GRID_W
    xc = ctx
    for layer in range(DEPTH):
        x, xc = trunk_layer(
            x, xc, c, c_ctx, row, col, w_mod[layer], b_mod[layer], g_pre_mix[layer], g_post_mix[layer], w_in[layer],
            ssm_a_re[layer], ssm_a_im[layer], ssm_log_dt[layer], ssm_b_re[layer], ssm_b_im[layer],
            ssm_c_re[layer], ssm_c_im[layer], ssm_d[layer], w_glu[layer], w_fourier[layer], na_rpb[layer],
            w_out[layer], g_pre_ffn[layer], g_post_ffn[layer], w_ffn_gate[layer], w_ffn_up[layer], w_ffn_down[layer],
            last=(layer == DEPTH - 1))
    return x
```

```cpp
#include <hip/hip_runtime.h>
#include <hip/hip_bf16.h>
#include <hip/hip_cooperative_groups.h>
#include <cstdio>
#include <cstdint>
namespace cg = cooperative_groups;

#ifndef MK_MULTI
#define MK_MULTI 1
#endif

typedef __attribute__((ext_vector_type(8))) short bf16x8;
typedef __attribute__((ext_vector_type(4))) float f32x4;
typedef __attribute__((ext_vector_type(16))) float f32x16;
typedef unsigned short u16;

#define DEV __device__ __forceinline__

constexpr int DM = 1024, SEQ = 8192, LCX = 256;
constexpr int NLAT = 2 * SEQ, NCTX = 2 * LCX, MR = NLAT + NCTX;
constexpr int INW = 1792, DFF = 2816;
constexpr int TCH = 32, NCH = MR / TCH;
constexpr int NPH = 22;
constexpr float EPS = 1e-6f;

struct Params {
  const float *x, *c, *ctx, *c_ctx, *w_mod, *b_mod, *g_pre_mix, *g_post_mix, *w_in;
  const float *a_re, *a_im, *log_dt, *b_re, *b_im, *c_re, *c_im, *ssm_d, *w_glu, *w_fourier, *rpb, *w_out;
  const float *g_pre_ffn, *g_post_ffn, *w_gate, *w_up, *w_down;
  float* out;
  u16 *wt_in, *wt_out, *wt_glu, *wt_gu, *wt_dn, *A_out, *A_end, *D128, *D256, *Tmat, *MWt;
  float *lamT, *mod, *xctx, *E;
  u16 *abuf, *UB, *fbuf, *qbuf, *kbuf, *vT, *vTc, *zbuf, *A1, *Gbuf, *ycat, *obuf, *hidden;
};

DEV int g_tid() { int t = threadIdx.x; asm volatile("" : "+v"(t)); return t; }
DEV u16 f2bf(float f) { unsigned u = __float_as_uint(f); u += 0x7fffu + ((u >> 16) & 1u); return (u16)(u >> 16); }
DEV float bf2f(u16 h) { return __uint_as_float(((unsigned)h) << 16); }
DEV unsigned pack2(float a, float b) { return (unsigned)f2bf(a) | ((unsigned)f2bf(b) << 16); }
DEV void store_bf4(u16* p, float a, float b, float c, float d) { uint2 v; v.x = pack2(a, b); v.y = pack2(c, d); *(uint2*)p = v; }
DEV float wave_sum(float v) {
#pragma unroll
  for (int o = 32; o >= 1; o >>= 1) v += __shfl_xor(v, o);
  return v;
}
DEV float hw_sin_rev(float r) { return __builtin_amdgcn_sinf(r); }
DEV float hw_cos_rev(float r) { return __builtin_amdgcn_cosf(r); }

template <bool BT, class Epi>
DEV void gemm_tile(const u16* A, int lda, const u16* B, int ldb, int K, int n0, int m0, int mmax, char* smem,
                   const Epi& epi) {
  const int tid = g_tid(), lane = tid & 63, w = tid >> 6;
  const int wn = w & 1, wm = w >> 1;
  f32x16 acc[2][2];
#pragma unroll
  for (int i = 0; i < 2; ++i)
#pragma unroll
    for (int j = 0; j < 2; ++j)
#pragma unroll
      for (int r = 0; r < 16; ++r) acc[i][j][r] = 0.f;
  uint4 ra[4], rb[4];
  auto gload = [&](int k0) {
#pragma unroll
    for (int i = 0; i < 4; ++i) {
      int id = tid + 256 * i;
      int r = id >> 3, ch = id & 7;
      ra[i] = *(const uint4*)(A + (size_t)(n0 + r) * lda + k0 + ch * 8);
      if (!BT) {
        int m = m0 + r;
        m = m < mmax ? m : mmax - 1;
        rb[i] = *(const uint4*)(B + (size_t)m * ldb + k0 + ch * 8);
      } else {
        int kk = id >> 4, nch = id & 15;
        rb[i] = *(const uint4*)(B + (size_t)(k0 + kk) * ldb + m0 + nch * 8);
      }
    }
  };
  auto sstore = [&](int buf) {
    char* sa = smem + buf * 32768;
    char* sb = sa + 16384;
#pragma unroll
    for (int i = 0; i < 4; ++i) {
      int id = tid + 256 * i;
      int r = id >> 3, ch = id & 7;
      *(uint4*)(sa + r * 128 + ((ch ^ (r & 7)) << 4)) = ra[i];
      if (!BT) {
        *(uint4*)(sb + r * 128 + ((ch ^ (r & 7)) << 4)) = rb[i];
      } else {
        int kk = id >> 4, nch = id & 15;
#pragma unroll
        for (int e = 0; e < 8; ++e) {
          unsigned wd = (e >> 1) == 0 ? rb[i].x : (e >> 1) == 1 ? rb[i].y : (e >> 1) == 2 ? rb[i].z : rb[i].w;
          u16 v = (u16)((e & 1) ? (wd >> 16) : (wd & 0xffffu));
          int n = nch * 8 + e;
          *(u16*)(sb + n * 128 + ((((kk >> 3) ^ (n & 7)) << 4) + (kk & 7) * 2)) = v;
        }
      }
    }
  };
  const int nk = K >> 6;
  gload(0);
  sstore(0);
  __syncthreads();
  for (int kt = 0; kt < nk; ++kt) {
    if (kt + 1 < nk) gload((kt + 1) << 6);
    const char* sa = smem + (kt & 1) * 32768;
    const char* sb = sa + 16384;
#pragma unroll
    for (int ks = 0; ks < 4; ++ks) {
      bf16x8 af[2], bfr[2];
      const int ch = ks * 2 + (lane >> 5);
#pragma unroll
      for (int i = 0; i < 2; ++i) {
        int row = wn * 64 + i * 32 + (lane & 31);
        af[i] = *(const bf16x8*)(sa + row * 128 + ((ch ^ (row & 7)) << 4));
      }
#pragma unroll
      for (int j = 0; j < 2; ++j) {
        int row = wm * 64 + j * 32 + (lane & 31);
        bfr[j] = *(const bf16x8*)(sb + row * 128 + ((ch ^ (row & 7)) << 4));
      }
#pragma unroll
      for (int i = 0; i < 2; ++i)
#pragma unroll
        for (int j = 0; j < 2; ++j)
          acc[i][j] = __builtin_amdgcn_mfma_f32_32x32x16_bf16(af[i], bfr[j], acc[i][j], 0, 0, 0);
    }
    if (kt + 1 < nk) sstore((kt + 1) & 1);
    __syncthreads();
  }
  epi(acc, n0 + wn * 64, m0 + wm * 64, lane);
}

template <class F>
DEV void for_quads(f32x16 (&acc)[2][2], int nW, int mW, int lane, F f) {
#pragma unroll
  for (int i = 0; i < 2; ++i)
#pragma unroll
    for (int j = 0; j < 2; ++j)
#pragma unroll
      for (int q = 0; q < 4; ++q) {
        int nf = nW + i * 32 + 8 * q + 4 * (lane >> 5);
        int m = mW + j * 32 + (lane & 31);
        f(nf, m, acc[i][j][4 * q], acc[i][j][4 * q + 1], acc[i][j][4 * q + 2], acc[i][j][4 * q + 3]);
      }
}

struct EpiInproj {
  const Params& P;
  DEV void operator()(f32x16 (&acc)[2][2], int nW, int mW, int lane) const {
    const int hi = lane >> 5;
#pragma unroll
    for (int i = 0; i < 2; ++i) {
      const int nt = nW + i * 32;
#pragma unroll
      for (int j = 0; j < 2; ++j) {
        const int m = mW + j * 32 + (lane & 31);
        f32x16 a = acc[i][j];
        if (nt < 384) {
#pragma unroll
          for (int q = 0; q < 4; ++q) {
            int nf = nt + 8 * q + 4 * hi;
            int g = nf >> 4, h = nf & 15;
            u16* dst = P.UB + ((size_t)(g * NCH + (m >> 5))) * 768 + (m & 31) * 16 + h;
            store_bf4(dst, a[4 * q], a[4 * q + 1], a[4 * q + 2], a[4 * q + 3]);
          }
        } else if (nt < 640) {
#pragma unroll
          for (int q = 0; q < 4; ++q) {
            int nf = nt + 8 * q + 4 * hi - 384;
            store_bf4(P.fbuf + (size_t)m * 256 + nf, a[4 * q], a[4 * q + 1], a[4 * q + 2], a[4 * q + 3]);
          }
        } else if (nt < 1408) {
          const bool isq = nt < 1024;
          const int off = nt - (isq ? 640 : 1024);
          if (m < NLAT) {
            const int l = m & (SEQ - 1);
            const float pos = (off & 32) ? (float)(l & 63) : (float)(l >> 6);
#pragma unroll
            for (int e = 0; e < 8; ++e) {
              int fl = 8 * (e >> 2) + 4 * hi + (e & 3);
              float freq = exp2f(-(float)fl * (13.287712379549449f / 16.f));
              float rev = pos * freq * 0.15915494309189535f;
              float sn = hw_sin_rev(rev), cs = hw_cos_rev(rev);
              float x1 = a[e], x2 = a[e + 8];
              a[e] = x1 * cs - x2 * sn;
              a[e + 8] = x2 * cs + x1 * sn;
            }
          }
          const float sc = isq ? 0.125f : 1.f;
          u16* base = (isq ? P.qbuf : P.kbuf) + (size_t)m * 384 + off;
#pragma unroll
          for (int q = 0; q < 4; ++q)
            store_bf4(base + 8 * q + 4 * hi, a[4 * q] * sc, a[4 * q + 1] * sc, a[4 * q + 2] * sc, a[4 * q + 3] * sc);
        } else {
#pragma unroll
          for (int r = 0; r < 16; ++r) {
            int feat = nt - 1408 + (r & 3) + 8 * (r >> 2) + 4 * hi;
            if (m < NLAT)
              P.vT[((size_t)((m >> 13) * 384 + feat)) * SEQ + (m & (SEQ - 1))] = f2bf(a[r]);
            else
              P.vTc[((size_t)(((m - NLAT) >> 8) * 384 + feat)) * LCX + ((m - NLAT) & 255)] = f2bf(a[r]);
          }
        }
      }
    }
  }
};

struct EpiSsmEnd {
  float* Eg;
  DEV void operator()(f32x16 (&acc)[2][2], int nW, int mW, int lane) const {
    for_quads(acc, nW, mW, lane, [&](int nf, int m, float a, float b, float c, float d) {
      if (m < NCH) *(float4*)(Eg + (size_t)m * 256 + nf) = make_float4(a, b, c, d);
    });
  }
};

DEV float gelu_tanh(float x) {
  float u = 0.7978845608028654f * (x + 0.044715f * x * x * x);
  float t = 1.f - 2.f / (1.f + __expf(2.f * u));
  return 0.5f * x * (1.f + t);
}

struct EpiSsmOut {
  u16* zb;
  int g;
  DEV void operator()(f32x16 (&acc)[2][2], int nW, int mW, int lane) const {
    for_quads(acc, nW, mW, lane, [&](int nf, int m, float a, float b, float c, float d) {
      if (m < NCH) {
        int t = nf >> 4, h = nf & 15;
        store_bf4(zb + ((size_t)(m * TCH + t)) * 384 + g * 16 + h, gelu_tanh(a), gelu_tanh(b), gelu_tanh(c),
                  gelu_tanh(d));
      }
    });
  }
};

struct EpiGlu {
  const u16* zb;
  u16* yc;
  DEV void operator()(f32x16 (&acc)[2][2], int nW, int mW, int lane) const {
    for_quads(acc, nW, mW, lane, [&](int nf, int m, float a, float b, float c, float d) {
      uint2 zz = *(const uint2*)(zb + (size_t)m * 384 + nf);
      float z0 = bf2f((u16)(zz.x & 0xffff)), z1 = bf2f((u16)(zz.x >> 16));
      float z2 = bf2f((u16)(zz.y & 0xffff)), z3 = bf2f((u16)(zz.y >> 16));
      store_bf4(yc + (size_t)m * 1024 + nf, z0 / (1.f + __expf(-a)), z1 / (1.f + __expf(-b)), z2 / (1.f + __expf(-c)),
                z3 / (1.f + __expf(-d)));
    });
  }
};

struct EpiFnetA {
  u16* A1b;
  DEV void operator()(f32x16 (&acc)[2][2], int nW, int mW, int lane) const {
    for_quads(acc, nW, mW, lane, [&](int nf, int m, float a, float b, float c, float d) {
      int k1 = nf >> 1;
      int cc = m >> 8, j = m & 255;
      u16* p = A1b + ((size_t)(k1 * 128 + cc * 2)) * 256 + j;
      p[0] = f2bf(a);
      p[256] = f2bf(b);
      p[128 * 256] = f2bf(c);
      p[128 * 256 + 256] = f2bf(d);
    });
  }
};

struct EpiFnetCtx {
  u16* Gb;
  DEV void operator()(f32x16 (&acc)[2][2], int nW, int mW, int lane) const {
    for_quads(acc, nW, mW, lane, [&](int nf, int m, float a, float b, float c, float d) {
      int k = nf >> 1;
      const float s = 1.f / 128.f;
      u16* p = Gb + (size_t)k * 512 + m;
      p[0] = f2bf(a * s);
      p[256] = f2bf(b * s);
      p[512] = f2bf(c * s);
      p[512 + 256] = f2bf(d * s);
    });
  }
};

struct EpiFnetC {
  u16* Gb;
  DEV void operator()(f32x16 (&acc)[2][2], int nW, int mW, int lane) const {
    for_quads(acc, nW, mW, lane, [&](int nf, int m, float a, float b, float c, float d) {
      int k2 = nf >> 1;
      const float s = 0.0013810679320049757f;
      u16* p = Gb + (size_t)k2 * 128 * 512 + m;
      p[0] = f2bf(a * s);
      p[256] = f2bf(b * s);
      p[128 * 512] = f2bf(c * s);
      p[128 * 512 + 256] = f2bf(d * s);
    });
  }
};

struct EpiStoreBf {
  u16* dst;
  int ld, coff;
  DEV void operator()(f32x16 (&acc)[2][2], int nW, int mW, int lane) const {
    for_quads(acc, nW, mW, lane, [&](int nf, int m, float a, float b, float c, float d) {
      store_bf4(dst + (size_t)m * ld + coff + nf, a, b, c, d);
    });
  }
};

struct EpiGateUp {
  u16* hid;
  DEV void operator()(f32x16 (&acc)[2][2], int nW, int mW, int lane) const {
    const int hi = lane >> 5;
#pragma unroll
    for (int j = 0; j < 2; ++j) {
      const int m = mW + j * 32 + (lane & 31);
#pragma unroll
      for (int q = 0; q < 4; ++q) {
        float o[4];
#pragma unroll
        for (int e = 0; e < 4; ++e) {
          float g = acc[0][j][4 * q + e], u = acc[1][j][4 * q + e];
          o[e] = g / (1.f + __expf(-g)) * u;
        }
        int col = (nW >> 6) * 32 + 8 * q + 4 * hi;
        store_bf4(hid + (size_t)m * DFF + col, o[0], o[1], o[2], o[3]);
      }
    }
  }
};

DEV void transpose_tile(const float* src, int K, int N, u16* dst, int mode, int kt, int nt, char* smem) {
  float* s = (float*)smem;
  const int tid = g_tid();
  const int k0 = kt * 64, n0 = nt * 64;
#pragma unroll
  for (int i = 0; i < 4; ++i) {
    int id = tid + 256 * i;
    int kk = id >> 4, c4 = id & 15;
    float4 v = *(const float4*)(src + (size_t)(k0 + kk) * N + n0 + c4 * 4);
    s[kk * 65 + c4 * 4 + 0] = v.x;
    s[kk * 65 + c4 * 4 + 1] = v.y;
    s[kk * 65 + c4 * 4 + 2] = v.z;
    s[kk * 65 + c4 * 4 + 3] = v.w;
  }
  __syncthreads();
#pragma unroll
  for (int i = 0; i < 2; ++i) {
    int id = tid + 256 * i;
    int nn = id >> 3, kc = id & 7;
    int n = n0 + nn;
    int row = mode == 0 ? n : (64 * (n >> 5) + (n & 31) + (mode == 2 ? 32 : 0));
    uint4 o;
    o.x = pack2(s[(kc * 8 + 0) * 65 + nn], s[(kc * 8 + 1) * 65 + nn]);
    o.y = pack2(s[(kc * 8 + 2) * 65 + nn], s[(kc * 8 + 3) * 65 + nn]);
    o.z = pack2(s[(kc * 8 + 4) * 65 + nn], s[(kc * 8 + 5) * 65 + nn]);
    o.w = pack2(s[(kc * 8 + 6) * 65 + nn], s[(kc * 8 + 7) * 65 + nn]);
    *(uint4*)(dst + (size_t)row * K + k0 + kc * 8) = o;
  }
  __syncthreads();
}

DEV void lam_pow(float are, float aim, float dt, int n, float& pr, float& pi) {
  float mag = expf((float)n * are * dt);
  double rev = (double)n * (double)aim * (double)dt * 0.15915494309189535;
  rev -= rint(rev);
  float fr = (float)rev;
  pr = mag * hw_cos_rev(fr);
  pi = mag * hw_sin_rev(fr);
}
DEV void zoh_factor(float are, float aim, float dt, float& fr, float& fi) {
  float lr, li;
  lam_pow(are, aim, dt, 1, lr, li);
  float nr = lr - 1.f, ni = li;
  float d2 = are * are + aim * aim;
  fr = (nr * are + ni * aim) / d2;
  fi = (ni * are - nr * aim) / d2;
}

constexpr int PREP_TR = 2852;
constexpr int PREP_KF = 24 * 63;
constexpr int PREP_WC = 24 * 2 * 32;
constexpr int PREP_MW = 64;
constexpr int PREP_N = PREP_TR + PREP_KF + PREP_WC + PREP_MW;

DEV void prep_job(const Params& P, int layer, int job, char* smem) {
  const int tid = g_tid();
  if (job < PREP_TR) {
    int j = job;
    if (j < 448) { transpose_tile(P.w_in + (size_t)layer * DM * INW, DM, INW, P.wt_in, 0, j / 28, j % 28, smem); return; }
    j -= 448;
    if (j < 256) { transpose_tile(P.w_out + (size_t)layer * DM * DM, DM, DM, P.wt_out, 0, j / 16, j % 16, smem); return; }
    j -= 256;
    if (j < 36) { transpose_tile(P.w_glu + (size_t)layer * 384 * 384, 384, 384, P.wt_glu, 0, j / 6, j % 6, smem); return; }
    j -= 36;
    if (j < 704) { transpose_tile(P.w_gate + (size_t)layer * DM * DFF, DM, DFF, P.wt_gu, 1, j / 44, j % 44, smem); return; }
    j -= 704;
    if (j < 704) { transpose_tile(P.w_up + (size_t)layer * DM * DFF, DM, DFF, P.wt_gu, 2, j / 44, j % 44, smem); return; }
    j -= 704;
    transpose_tile(P.w_down + (size_t)layer * DFF * DM, DFF, DM, P.wt_dn, 0, j / 16, j % 16, smem);
    return;
  }
  job -= PREP_TR;
  float* sf = (float*)smem;
  if (job < PREP_KF) {
    const int g = job / 63, delta = job % 63 - 31;
    const int ad = delta < 0 ? -delta : delta;
    float* sQ = sf;
    float* sCQ = sf + 256;
    if (tid < 128) {
      int dir = tid >> 6, p = tid & 63;
      int ix = ((layer * 2 + dir) * 24 + g) * 64 + p;
      float are = P.a_re[ix], aim = P.a_im[ix], dt = expf(P.log_dt[(layer * 2 + dir) * 24 + g]);
      float pr, pi, fr, fi;
      lam_pow(are, aim, dt, ad, pr, pi);
      zoh_factor(are, aim, dt, fr, fi);
      sQ[(dir * 64 + p) * 2 + 0] = pr * fr - pi * fi;
      sQ[(dir * 64 + p) * 2 + 1] = pr * fi + pi * fr;
    }
    __syncthreads();
#pragma unroll
    for (int i = 0; i < 8; ++i) {
      int e = tid + 256 * i;
      int dir = e >> 10, h = (e >> 6) & 15, p = e & 63;
      size_t ci = ((size_t)(((layer * 2 + dir) * 24 + g) * 16 + h)) * 64 + p;
      float cr = P.c_re[ci], cim = P.c_im[ci];
      float qr = sQ[(dir * 64 + p) * 2], qi = sQ[(dir * 64 + p) * 2 + 1];
      sCQ[e * 2 + 0] = cr * qr - cim * qi;
      sCQ[e * 2 + 1] = cr * qi + cim * qr;
    }
    __syncthreads();
    const int h = tid >> 4, hp = tid & 15;
    float val = 0.f;
#pragma unroll
    for (int dir = 0; dir < 2; ++dir) {
      bool need = dir == 0 ? (delta >= 0) : (delta <= 0);
      if (need) {
        const float* br = P.b_re + ((size_t)(((layer * 2 + dir) * 24 + g) * 64)) * 16 + hp;
        const float* bi = P.b_im + ((size_t)(((layer * 2 + dir) * 24 + g) * 64)) * 16 + hp;
        const float* cq = sCQ + ((dir * 16 + h) * 64) * 2;
        for (int p = 0; p < 64; ++p) val += cq[p * 2] * br[p * 16] - cq[p * 2 + 1] * bi[p * 16];
      }
    }
    if (delta == 0 && h == hp) val += P.ssm_d[layer * 384 + g * 16 + h];
    const u16 bv = f2bf(val);
    int t0 = delta > 0 ? delta : 0, t1 = delta < 0 ? 31 + delta : 31;
    for (int t = t0; t <= t1; ++t) {
      int s = t - delta;
      P.A_out[((size_t)(g * 512 + t * 16 + h)) * 768 + s * 16 + hp] = bv;
    }
    __syncthreads();
    return;
  }
  job -= PREP_KF;
  if (job < PREP_WC) {
    const int j = job & 31, dir = (job >> 5) & 1, g = job >> 6;
    float* sP = sf;
    if (tid < 128) {
      int which = tid >> 6, p = tid & 63;
      int ix = ((layer * 2 + dir) * 24 + g) * 64 + p;
      float are = P.a_re[ix], aim = P.a_im[ix], dt = expf(P.log_dt[(layer * 2 + dir) * 24 + g]);
      float pr, pi;
      if (which == 0) {
        lam_pow(are, aim, dt, dir == 0 ? j + 1 : 32 - j, pr, pi);
        sP[p * 2] = pr;
        sP[p * 2 + 1] = pi;
        if (j == 0) {
          float tr, ti;
          lam_pow(are, aim, dt, 32, tr, ti);
          P.lamT[((dir * 24 + g) * 64 + p) * 2] = tr;
          P.lamT[((dir * 24 + g) * 64 + p) * 2 + 1] = ti;
        }
      } else {
        float fr, fi;
        lam_pow(are, aim, dt, dir == 0 ? 31 - j : j, pr, pi);
        zoh_factor(are, aim, dt, fr, fi);
        sP[128 + p * 2] = pr * fr - pi * fi;
        sP[128 + p * 2 + 1] = pr * fi + pi * fr;
      }
    }
    __syncthreads();
#pragma unroll
    for (int i = 0; i < 8; ++i) {
      int e = tid + 256 * i;
      {
        int h = e >> 7, pc = e & 127, p = pc >> 1, ri = pc & 1;
        size_t ci = ((size_t)(((layer * 2 + dir) * 24 + g) * 16 + h)) * 64 + p;
        float cr = P.c_re[ci], cim = P.c_im[ci];
        float pr = sP[p * 2], pi = sP[p * 2 + 1];
        float v = ri == 0 ? (cr * pr - cim * pi) : -(cr * pi + cim * pr);
        P.A_out[((size_t)(g * 512 + j * 16 + h)) * 768 + 512 + dir * 128 + pc] = f2bf(v);
      }
      {
        int prow = e >> 4, h = e & 15, p = prow >> 1, ri = prow & 1;
        size_t bi_ = ((size_t)(((layer * 2 + dir) * 24 + g) * 64 + p)) * 16 + h;
        float br = P.b_re[bi_], bim = P.b_im[bi_];
        float pr = sP[128 + p * 2], pi = sP[128 + p * 2 + 1];
        float v = ri == 0 ? (pr * br - pi * bim) : (pr * bim + pi * br);
        P.A_end[((size_t)(g * 256 + dir * 128 + prow)) * 512 + j * 16 + h] = f2bf(v);
      }
    }
    __syncthreads();
    return;
  }
  job -= PREP_WC;
  {
    const int jb = job & 7, g = (job >> 3) & 3, ri = job >> 5;
    const float* wf = P.w_fourier + (size_t)layer * 256 * 256;
    const int n = tid;
    for (int jj = 0; jj < 8; ++jj) {
      int j = jb * 8 + jj;
      float sum = 0.f;
      for (int m = 0; m < 64; ++m) {
        float fr = (float)((m * j) & 63) * (1.f / 64.f);
        float tr = ri ? hw_sin_rev(fr) : hw_cos_rev(fr);
        sum += tr * wf[(size_t)(g * 64 + m) * 256 + n];
      }
      P.MWt[(size_t)n * 512 + ri * 256 + g * 64 + j] = f2bf(sum);
    }
  }
}

constexpr int CONST_MOD = 384, CONST_D128 = 16, CONST_D256 = 64, CONST_T = 1024;
constexpr int CONST_N = CONST_MOD + CONST_D128 + CONST_D256 + CONST_T;

DEV void const_job(const Params& P, int job, char* smem) {
  const int tid = g_tid();
  if (job < CONST_MOD) {
    const int layer = job / 192, cb = job % 192;
    float* sv = (float*)smem;
    float* red = sv + 3 * 1024;
    for (int i = tid; i < 3 * 1024; i += 256) {
      int v = i >> 10, k = i & 1023;
      float cv = v < 2 ? P.c[v * 1024 + k] : P.c_ctx[k];
      sv[i] = cv / (1.f + __expf(-cv));
    }
    __syncthreads();
    const int kg = tid >> 5, cl = tid & 31;
    const int n = cb * 32 + cl;
    const float* W = P.w_mod + (size_t)layer * DM * 6144 + n;
    float a0 = 0.f, a1 = 0.f, a2 = 0.f;
#pragma unroll 8
    for (int k = kg * 128; k < kg * 128 + 128; ++k) {
      float wv = W[(size_t)k * 6144];
      a0 += sv[k] * wv;
      a1 += sv[1024 + k] * wv;
      a2 += sv[2048 + k] * wv;
    }
    red[(kg * 3 + 0) * 32 + cl] = a0;
    red[(kg * 3 + 1) * 32 + cl] = a1;
    red[(kg * 3 + 2) * 32 + cl] = a2;
    __syncthreads();
    if (tid < 96) {
      int v = tid >> 5, c2 = tid & 31;
      float s = P.b_mod[layer * 6144 + cb * 32 + c2];
      for (int q = 0; q < 8; ++q) s += red[(q * 3 + v) * 32 + c2];
      P.mod[(layer * 3 + v) * 6144 + cb * 32 + c2] = s;
    }
    __syncthreads();
    return;
  }
  job -= CONST_MOD;
  if (job < CONST_D128) {
#pragma unroll
    for (int i = 0; i < 8; ++i) {
      int idx = job * 2048 + tid + 256 * i;
      int row = idx >> 7, r = idx & 127;
      int k1 = row >> 1, ri = row & 1;
      float fr = (float)((k1 * r) & 127) * (1.f / 128.f);
      P.D128[idx] = f2bf(ri ? -hw_sin_rev(fr) : hw_cos_rev(fr));
    }
    return;
  }
  job -= CONST_D128;
  if (job < CONST_D256) {
#pragma unroll
    for (int i = 0; i < 8; ++i) {
      int idx = job * 2048 + tid + 256 * i;
      int row = idx >> 8, l = idx & 255;
      int k = row >> 1, ri = row & 1;
      float fr = (float)((k * l) & 255) * (1.f / 256.f);
      P.D256[idx] = f2bf(ri ? -hw_sin_rev(fr) : hw_cos_rev(fr));
    }
    return;
  }
  job -= CONST_D256;
  {
#pragma unroll
    for (int i = 0; i < 8; ++i) {
      int idx = job * 2048 + tid + 256 * i;
      int k1 = idx >> 14, row = (idx >> 7) & 127, col = idx & 127;
      int k2 = row >> 1, ri = row & 1, cc = col >> 1, rj = col & 1;
      float fr = (float)((cc * (k1 + 128 * k2)) & 8191) * (1.f / 8192.f);
      float cs = hw_cos_rev(fr), sn = hw_sin_rev(fr);
      float v = (ri == rj) ? cs : (ri == 0 ? sn : -sn);
      P.Tmat[idx] = f2bf(v);
    }
  }
}

DEV float4 ld4(const float* p) { return *(const float4*)p; }
DEV float4 ldbf4(const u16* p) {
  uint2 v = *(const uint2*)p;
  return make_float4(bf2f((u16)(v.x & 0xffff)), bf2f((u16)(v.x >> 16)), bf2f((u16)(v.y & 0xffff)), bf2f((u16)(v.y >> 16)));
}
DEV float sq4(float4 v) { return v.x * v.x + v.y * v.y + v.z * v.z + v.w * v.w; }

DEV void rowop(const Params& P, int kind, int layer, int m, int lane) {
  const bool last = layer == 1;
  if (kind == 2 && last && m >= NLAT) return;
  const int mi = m < NLAT ? (m >> 13) : 2;
  float* resid = m < NLAT ? P.out + (size_t)m * DM : P.xctx + (size_t)(m - NLAT) * DM;
  const float* xin;
  if (kind == 0 || (kind == 1 && layer == 0))
    xin = m < NLAT ? P.x + (size_t)m * DM : P.ctx + (size_t)(m - NLAT) * DM;
  else
    xin = resid;
  const float* modv = P.mod + (size_t)(layer * 3 + mi) * 6144;
  float4 v[4];
#pragma unroll
  for (int i = 0; i < 4; ++i) v[i] = ld4(xin + i * 256 + lane * 4);
  if (kind != 0) {
    const float* gpost = (kind == 1 ? P.g_post_mix : P.g_post_ffn) + layer * DM;
    const float* gate = modv + (kind == 1 ? 2048 : 5120);
    float4 o[4];
    float ss = 0.f;
#pragma unroll
    for (int i = 0; i < 4; ++i) {
      o[i] = ldbf4(P.obuf + (size_t)m * DM + i * 256 + lane * 4);
      ss += sq4(o[i]);
    }
    ss = wave_sum(ss);
    float rinv = rsqrtf(ss * (1.f / DM) + EPS);
#pragma unroll
    for (int i = 0; i < 4; ++i) {
      float4 gp = ld4(gpost + i * 256 + lane * 4), gt = ld4(gate + i * 256 + lane * 4);
      v[i].x += gt.x * (o[i].x * rinv * gp.x);
      v[i].y += gt.y * (o[i].y * rinv * gp.y);
      v[i].z += gt.z * (o[i].z * rinv * gp.z);
      v[i].w += gt.w * (o[i].w * rinv * gp.w);
    }
    if (kind == 2 && last) {
#pragma unroll
      for (int i = 0; i < 4; ++i) *(float4*)(P.out + (size_t)m * DM + i * 256 + lane * 4) = v[i];
      return;
    }
#pragma unroll
    for (int i = 0; i < 4; ++i) *(float4*)(resid + i * 256 + lane * 4) = v[i];
  }
  const int la = kind == 2 ? layer + 1 : layer;
  const float* gpre = (kind == 1 ? P.g_pre_ffn : P.g_pre_mix) + la * DM;
  const float* mv = P.mod + (size_t)(la * 3 + mi) * 6144;
  const float* sh = mv + (kind == 1 ? 3072 : 0);
  const float* sc = mv + (kind == 1 ? 4096 : 1024);
  float ss = 0.f;
#pragma unroll
  for (int i = 0; i < 4; ++i) ss += sq4(v[i]);
  ss = wave_sum(ss);
  float rinv = rsqrtf(ss * (1.f / DM) + EPS);
#pragma unroll
  for (int i = 0; i < 4; ++i) {
    int col = i * 256 + lane * 4;
    float4 gp = ld4(gpre + col), s1 = ld4(sc + col), s0 = ld4(sh + col);
    store_bf4(P.abuf + (size_t)m * DM + col, v[i].x * rinv * gp.x * (1.f + s1.x) + s0.x,
              v[i].y * rinv * gp.y * (1.f + s1.y) + s0.y, v[i].z * rinv * gp.z * (1.f + s1.z) + s0.z,
              v[i].w * rinv * gp.w * (1.f + s1.w) + s0.w);
  }
}

DEV void attn_wave(const Params& P, int layer, bool isctx, int b, int h, int r, int cgp, int lane) {
  const int qi = lane & 15, g = lane >> 4;
  int mq, c = 0, cs = 0, cb = 0, rs = 0;
  if (!isctx) {
    c = cgp * 16 + qi;
    mq = b * SEQ + r * 64 + c;
    cs = c - 8;
    cs = cs < 0 ? 0 : (cs > 48 ? 48 : cs);
    cb = cgp == 0 ? 0 : (cgp == 1 ? 8 : (cgp == 2 ? 24 : 32));
    rs = r - 4;
    rs = rs < 0 ? 0 : (rs > 120 ? 120 : rs);
  } else {
    mq = NLAT + b * LCX + cgp * 16 + qi;
  }
  const u16* qp = P.qbuf + (size_t)mq * 384 + h * 64 + g * 8;
  const bf16x8 qf0 = *(const bf16x8*)qp, qf1 = *(const bf16x8*)(qp + 32);
  f32x4 o[4];
#pragma unroll
  for (int d = 0; d < 4; ++d) o[d] = f32x4{0.f, 0.f, 0.f, 0.f};
  float mrun = -1e30f, lrun = 0.f;
  const float* rp = P.rpb + (size_t)(layer * 6 + h) * 465;
  const int nblk = isctx ? 8 : 16;
  for (int kb = 0; kb < nblk; ++kb) {
    const bool win = (!isctx) && kb < 8;
    size_t krow0;
    const u16* vbase;
    int vld;
    if (win) {
      int tok0 = (rs + kb) * 64 + cb;
      krow0 = (size_t)b * SEQ + tok0;
      vbase = P.vT + ((size_t)(b * 384 + h * 64)) * SEQ + tok0;
      vld = SEQ;
    } else {
      int kc = (isctx ? kb : kb - 8) * 32;
      krow0 = (size_t)NLAT + b * LCX + kc;
      vbase = P.vTc + ((size_t)(b * 384 + h * 64)) * LCX + kc;
      vld = LCX;
    }
    f32x4 s[2];
#pragma unroll
    for (int t = 0; t < 2; ++t) {
      const u16* kp = P.kbuf + (krow0 + t * 16 + qi) * 384 + h * 64 + g * 8;
      bf16x8 k0 = *(const bf16x8*)kp, k1 = *(const bf16x8*)(kp + 32);
      f32x4 z = {0.f, 0.f, 0.f, 0.f};
      z = __builtin_amdgcn_mfma_f32_16x16x32_bf16(k0, qf0, z, 0, 0, 0);
      s[t] = __builtin_amdgcn_mfma_f32_16x16x32_bf16(k1, qf1, z, 0, 0, 0);
    }
    if (win) {
      const int dr = rs + kb - r + 7;
#pragma unroll
      for (int t = 0; t < 2; ++t)
#pragma unroll
        for (int i = 0; i < 4; ++i) {
          int keycol = cb + t * 16 + g * 4 + i;
          bool valid = keycol >= cs && keycol < cs + 16;
          int dc = keycol - c + 15;
          dc = dc < 0 ? 0 : (dc > 30 ? 30 : dc);
          float bias = rp[dr * 31 + dc];
          s[t][i] = valid ? s[t][i] + bias : -1e30f;
        }
    }
    float mx = fmaxf(fmaxf(fmaxf(s[0][0], s[0][1]), fmaxf(s[0][2], s[0][3])),
                     fmaxf(fmaxf(s[1][0], s[1][1]), fmaxf(s[1][2], s[1][3])));
    mx = fmaxf(mx, __shfl_xor(mx, 16));
    mx = fmaxf(mx, __shfl_xor(mx, 32));
    const float mnew = fmaxf(mrun, mx);
    const float alpha = __expf(mrun - mnew);
    mrun = mnew;
    float p[8], psum = 0.f;
#pragma unroll
    for (int t = 0; t < 2; ++t)
#pragma unroll
      for (int i = 0; i < 4; ++i) {
        p[t * 4 + i] = __expf(s[t][i] - mnew);
        psum += p[t * 4 + i];
      }
    lrun = lrun * alpha + psum;
    bf16x8 pf;
#pragma unroll
    for (int e = 0; e < 8; ++e) pf[e] = (short)f2bf(p[e]);
#pragma unroll
    for (int d = 0; d < 4; ++d) {
      o[d] *= alpha;
      const u16* vp = vbase + (size_t)(d * 16 + qi) * vld + g * 4;
      uint2 v0 = *(const uint2*)vp, v1 = *(const uint2*)(vp + 16);
      union { uint4 u; bf16x8 v; } cv;
      cv.u = make_uint4(v0.x, v0.y, v1.x, v1.y);
      o[d] = __builtin_amdgcn_mfma_f32_16x16x32_bf16(cv.v, pf, o[d], 0, 0, 0);
    }
  }
  float l = lrun + __shfl_xor(lrun, 16);
  l += __shfl_xor(l, 32);
  const float inv = 1.f / l;
#pragma unroll
  for (int d = 0; d < 4; ++d)
    store_bf4(P.ycat + (size_t)mq * DM + 640 + h * 64 + d * 16 + g * 4, o[d][0] * inv, o[d][1] * inv, o[d][2] * inv,
              o[d][3] * inv);
}

DEV void carry_job(const Params& P, int job) {
  const int idx = job * 256 + g_tid();
  const int p = idx & 63;
  int combo = idx >> 6;
  const int g = combo % 24;
  combo /= 24;
  const int dir = combo & 1, b = combo >> 1;
  const float lr = P.lamT[((dir * 24 + g) * 64 + p) * 2], li = P.lamT[((dir * 24 + g) * 64 + p) * 2 + 1];
  float cr = 0.f, ci = 0.f;
  auto step = [&](int chunk) {
    size_t row = (size_t)(g * NCH + chunk);
    *(unsigned*)(P.UB + row * 768 + 512 + dir * 128 + p * 2) = pack2(cr, ci);
    const float2 e = *(const float2*)(P.E + row * 256 + dir * 128 + p * 2);
    float nr = lr * cr - li * ci + e.x, ni = lr * ci + li * cr + e.y;
    cr = nr;
    ci = ni;
  };
  if (dir == 0) {
    for (int cc = 0; cc < 8; ++cc) step(512 + b * 8 + cc);
    for (int cc = 0; cc < 256; ++cc) step(b * 256 + cc);
  } else {
    for (int cc = 7; cc >= 0; --cc) step(512 + b * 8 + cc);
    for (int cc = 255; cc >= 0; --cc) step(b * 256 + cc);
  }
}

DEV void run_phase(const Params& P, int ph, int bid, int nblk, char* smem) {
  const int lane = g_tid() & 63, w = g_tid() >> 6;
  if (ph == 0) {
    for (int job = bid; job < CONST_N + PREP_N; job += nblk) {
      if (job < CONST_N) const_job(P, job, smem);
      else prep_job(P, 0, job - CONST_N, smem);
    }
    return;
  }
  if (ph == 1) {
    for (int job = bid; job < MR / 4; job += nblk) rowop(P, 0, 0, job * 4 + w, lane);
    return;
  }
  const int layer = (ph - 2) / 10, sub = (ph - 2) % 10;
  switch (sub) {
    case 0: {
      EpiInproj epi{P};
      for (int job = bid; job < 14 * 132; job += nblk) {
        int mt = job / 14, nt = job % 14;
        gemm_tile<false>(P.wt_in, DM, P.abuf, DM, DM, nt * 128, mt * 128, MR, smem, epi);
      }
    } break;
    case 1: {
      const int J0 = 1536, J1 = J0 + 48, J2 = J1 + 240, J3 = J2 + 512, J4 = J3 + 16;
      for (int job = bid; job < J4; job += nblk) {
        if (job < J0) {
          int r = job & 127, bh = job >> 7;
          attn_wave(P, layer, false, bh / 6, bh % 6, r, w, lane);
        } else if (job < J1) {
          int j = job - J0;
          int qb = j & 3, bh = j >> 2;
          attn_wave(P, layer, true, bh / 6, bh % 6, 0, qb * 4 + w, lane);
        } else if (job < J2) {
          int j = job - J1;
          int g = j / 10, t = j % 10;
          EpiSsmEnd epi{P.E + (size_t)g * NCH * 256};
          gemm_tile<false>(P.A_end + (size_t)g * 256 * 512, 512, P.UB + (size_t)g * NCH * 768, 768, 512, (t & 1) * 128,
                           (t >> 1) * 128, NCH, smem, epi);
        } else if (job < J3) {
          int j = job - J2;
          int b = j >> 8, t = j & 255;
          EpiFnetA epi{P.A1 + (size_t)b * 128 * 128 * 256};
          gemm_tile<true>(P.D128, 128, P.fbuf + (size_t)b * SEQ * 256, 64 * 256, 128, (t & 1) * 128, (t >> 1) * 128,
                          64 * 256, smem, epi);
        } else {
          int j = job - J3;
          int b = j >> 3, t = j & 7;
          EpiFnetCtx epi{P.Gbuf + (size_t)(NLAT + b * LCX) * 512};
          gemm_tile<true>(P.D256, 256, P.fbuf + (size_t)(NLAT + b * LCX) * 256, 256, 256, (t & 3) * 128, (t >> 2) * 128,
                          256, smem, epi);
        }
      }
    } break;
    case 2: {
      for (int job = bid; job < 24 + 512; job += nblk) {
        if (job < 24) carry_job(P, job);
        else {
          int j = job - 24;
          int bk = j >> 1, t = j & 1;
          int k1 = bk & 127, b = bk >> 7;
          EpiFnetC epi{P.Gbuf + (size_t)(b * SEQ + k1) * 512};
          gemm_tile<true>(P.Tmat + (size_t)k1 * 128 * 128, 128, P.A1 + (size_t)bk * 128 * 256, 256, 128, 0, t * 128, 256,
                          smem, epi);
        }
      }
    } break;
    case 3: {
      for (int job = bid; job < 480 + 264; job += nblk) {
        if (job < 480) {
          int g = job / 20, t = job % 20;
          EpiSsmOut epi{P.zbuf, g};
          gemm_tile<false>(P.A_out + (size_t)g * 512 * 768, 768, P.UB + (size_t)g * NCH * 768, 768, 768, (t & 3) * 128,
                           (t >> 2) * 128, NCH, smem, epi);
        } else {
          int j = job - 480;
          EpiStoreBf epi{P.ycat, DM, 384};
          gemm_tile<false>(P.MWt, 512, P.Gbuf, 512, 512, (j & 1) * 128, (j >> 1) * 128, MR, smem, epi);
        }
      }
    } break;
    case 4: {
      EpiGlu epi{P.zbuf, P.ycat};
      for (int job = bid; job < 3 * 132; job += nblk)
        gemm_tile<false>(P.wt_glu, 384, P.zbuf, 384, 384, (job % 3) * 128, (job / 3) * 128, MR, smem, epi);
    } break;
    case 5: {
      EpiStoreBf epi{P.obuf, DM, 0};
      for (int job = bid; job < 8 * 132; job += nblk)
        gemm_tile<false>(P.wt_out, DM, P.ycat, DM, DM, (job & 7) * 128, (job >> 3) * 128, MR, smem, epi);
    } break;
    case 6: {
      for (int job = bid; job < MR / 4; job += nblk) rowop(P, 1, layer, job * 4 + w, lane);
    } break;
    case 7: {
      EpiGateUp epi{P.hidden};
      for (int job = bid; job < 44 * 132; job += nblk)
        gemm_tile<false>(P.wt_gu, DM, P.abuf, DM, DM, (job % 44) * 128, (job / 44) * 128, MR, smem, epi);
    } break;
    case 8: {
      EpiStoreBf epi{P.obuf, DM, 0};
      for (int job = bid; job < 8 * 132; job += nblk)
        gemm_tile<false>(P.wt_dn, DFF, P.hidden, DFF, DFF, (job & 7) * 128, (job >> 3) * 128, MR, smem, epi);
    } break;
    case 9: {
      const int nrow = MR / 4;
      const int total = nrow + (layer == 0 ? PREP_N : 0);
      for (int job = bid; job < total; job += nblk) {
        if (job < nrow) rowop(P, 2, layer, job * 4 + w, lane);
        else prep_job(P, 1, job - nrow, smem);
      }
    } break;
  }
}

#if MK_MULTI
__global__ void __launch_bounds__(256) phase_kernel(Params P, int ph) {
  __shared__ __attribute__((aligned(16))) char smem[65536];
  run_phase(P, ph, blockIdx.x, gridDim.x, smem);
}
#else
__global__ void __launch_bounds__(256, 2) fwd_megakernel(Params P) {
  __shared__ __attribute__((aligned(16))) char smem[65536];
  cg::grid_group grid = cg::this_grid();
  for (int ph = 0; ph < NPH; ++ph) {
    int bid = blockIdx.x;
    asm volatile("" : "+s"(bid));
    run_phase(P, ph, bid, gridDim.x, smem);
    if (ph + 1 < NPH) grid.sync();
  }
}
#endif

extern "C" void kernel_launch(void* const* d_in, const int* in_sizes, int n_in, void* d_out, int out_size, void* d_ws,
                              size_t ws_size, hipStream_t stream) {
  Params p{};
  const float* const* in = (const float* const*)d_in;
  p.x = in[0]; p.c = in[1]; p.ctx = in[2]; p.c_ctx = in[3]; p.w_mod = in[4]; p.b_mod = in[5];
  p.g_pre_mix = in[6]; p.g_post_mix = in[7]; p.w_in = in[8]; p.a_re = in[9]; p.a_im = in[10]; p.log_dt = in[11];
  p.b_re = in[12]; p.b_im = in[13]; p.c_re = in[14]; p.c_im = in[15]; p.ssm_d = in[16]; p.w_glu = in[17];
  p.w_fourier = in[18]; p.rpb = in[19]; p.w_out = in[20]; p.g_pre_ffn = in[21]; p.g_post_ffn = in[22];
  p.w_gate = in[23]; p.w_up = in[24]; p.w_down = in[25];
  p.out = (float*)d_out;
  char* ws = (char*)d_ws;
  size_t off = 0;
  auto alloc = [&](size_t bytes) { char* r = ws + off; off += (bytes + 255) & ~(size_t)255; return r; };
  p.wt_in = (u16*)alloc((size_t)INW * DM * 2);
  p.wt_out = (u16*)alloc((size_t)DM * DM * 2);
  p.wt_glu = (u16*)alloc((size_t)384 * 384 * 2);
  p.wt_gu = (u16*)alloc((size_t)2 * DFF * DM * 2);
  p.wt_dn = (u16*)alloc((size_t)DM * DFF * 2);
  p.A_out = (u16*)alloc((size_t)24 * 512 * 768 * 2);
  p.A_end = (u16*)alloc((size_t)24 * 256 * 512 * 2);
  p.D128 = (u16*)alloc(256 * 128 * 2);
  p.D256 = (u16*)alloc(512 * 256 * 2);
  p.Tmat = (u16*)alloc((size_t)128 * 128 * 128 * 2);
  p.MWt = (u16*)alloc(256 * 512 * 2);
  p.lamT = (float*)alloc(2 * 24 * 64 * 2 * 4);
  p.mod = (float*)alloc(2 * 3 * 6144 * 4);
  p.abuf = (u16*)alloc((size_t)MR * DM * 2);
  p.xctx = (float*)alloc((size_t)NCTX * DM * 4);
  char* R = ws + off;
  size_t roff = 0;
  auto ralloc = [&](size_t bytes) { char* r = R + roff; roff += (bytes + 255) & ~(size_t)255; return r; };
  p.ycat = (u16*)ralloc((size_t)MR * DM * 2);
  p.UB = (u16*)ralloc((size_t)24 * NCH * 768 * 2);
  p.fbuf = (u16*)ralloc((size_t)MR * 256 * 2);
  p.qbuf = (u16*)ralloc((size_t)MR * 384 * 2);
  p.kbuf = (u16*)ralloc((size_t)MR * 384 * 2);
  p.vT = (u16*)ralloc((size_t)2 * 384 * SEQ * 2);
  p.vTc = (u16*)ralloc((size_t)2 * 384 * LCX * 2);
  p.E = (float*)ralloc((size_t)24 * NCH * 256 * 4);
  p.A1 = (u16*)ralloc((size_t)2 * 128 * 128 * 256 * 2);
  p.Gbuf = (u16*)ralloc((size_t)MR * 512 * 2);
  p.zbuf = p.qbuf;
  p.hidden = (u16*)R;
  const size_t hid_bytes = (((size_t)MR * DFF * 2) + 255) & ~(size_t)255;
  p.obuf = (u16*)(R + hid_bytes);
  size_t rneed = hid_bytes + (size_t)MR * DM * 2;
  if (rneed > roff) roff = rneed;
  if (off + roff > ws_size) {
    fprintf(stderr, "workspace too small: need %zu have %zu\n", off + roff, ws_size);
    return;
  }
#if MK_MULTI
  for (int ph = 0; ph < NPH; ++ph) phase_kernel<<<dim3(1024), dim3(256), 0, stream>>>(p, ph);
#else
  static int grid_blocks = 0;
  if (!grid_blocks) {
    int dev = 0, cus = 0, per_cu = 0;
    hipGetDevice(&dev);
    hipDeviceGetAttribute(&cus, hipDeviceAttributeMultiprocessorCount, dev);
    hipOccupancyMaxActiveBlocksPerMultiprocessor(&per_cu, fwd_megakernel, 256, 0);
    if (per_cu > 2) per_cu = 2;
    grid_blocks = cus * per_cu;
  }
  void* args[] = {&p};
  hipError_t e = hipLaunchCooperativeKernel((void*)fwd_megakernel, dim3(grid_blocks), dim3(256), args, 0, stream);
  if (e != hipSuccess) fprintf(stderr, "cooperative launch failed: %s (grid %d)\n", hipGetErrorString(e), grid_blocks);
#endif
}
```

```cpp
#include <hip/hip_runtime.h>
#include <hip/hip_bf16.h>
#include <hip/hip_cooperative_groups.h>
#include <cstdio>
#include <cstdint>
namespace cg = cooperative_groups;

#ifndef MK_MULTI
#define MK_MULTI 0
#endif

typedef __attribute__((ext_vector_type(8))) short bf16x8;
typedef __attribute__((ext_vector_type(4))) float f32x4;
typedef __attribute__((ext_vector_type(16))) float f32x16;
typedef unsigned short u16;

#define DEV __device__ __forceinline__

constexpr int DM = 1024, SEQ = 8192, LCX = 256;
constexpr int NLAT = 2 * SEQ, NCTX = 2 * LCX, MR = NLAT + NCTX;
constexpr int INW = 1792, DFF = 2816;
constexpr int TCH = 32, NCH = MR / TCH;
constexpr int NPH = 22;
constexpr float EPS = 1e-6f;

struct Params {
  const float *x, *c, *ctx, *c_ctx, *w_mod, *b_mod, *g_pre_mix, *g_post_mix, *w_in;
  const float *a_re, *a_im, *log_dt, *b_re, *b_im, *c_re, *c_im, *ssm_d, *w_glu, *w_fourier, *rpb, *w_out;
  const float *g_pre_ffn, *g_post_ffn, *w_gate, *w_up, *w_down;
  float* out;
  u16 *wt_in, *wt_out, *wt_glu, *wt_gu, *wt_dn, *A_out, *A_end, *D128, *D256, *Tmat, *MWt;
  float *lamT, *mod, *xctx, *E, *Ktau;
  u16 *abuf, *UB, *fbuf, *qbuf, *kbuf, *vT, *vTc, *zbuf, *A1, *Gbuf, *ycat, *obuf, *hidden;
};

DEV int g_tid() { int t = threadIdx.x; asm volatile("" : "+v"(t)); return t; }
DEV u16 f2bf(float f) { unsigned u = __float_as_uint(f); u += 0x7fffu + ((u >> 16) & 1u); return (u16)(u >> 16); }
DEV float bf2f(u16 h) { return __uint_as_float(((unsigned)h) << 16); }
DEV unsigned pack2(float a, float b) { return (unsigned)f2bf(a) | ((unsigned)f2bf(b) << 16); }
DEV void store_bf4(u16* p, float a, float b, float c, float d) { uint2 v; v.x = pack2(a, b); v.y = pack2(c, d); *(uint2*)p = v; }
DEV float wave_sum(float v) {
#pragma unroll
  for (int o = 32; o >= 1; o >>= 1) v += __shfl_xor(v, o);
  return v;
}
DEV float hw_sin_rev(float r) { return __builtin_amdgcn_sinf(r); }
DEV float hw_cos_rev(float r) { return __builtin_amdgcn_cosf(r); }

template <int BMODE, class Epi>
DEV void gemm_tile(const u16* A, int lda, const u16* B, int ldb, int K, int n0, int m0, int mmax, char* smem,
                   const Epi& epi) {
  const int tid = g_tid(), lane = tid & 63, w = tid >> 6;
  const int wn = w & 1, wm = w >> 1;
  f32x16 acc[2][2];
#pragma unroll
  for (int i = 0; i < 2; ++i)
#pragma unroll
    for (int j = 0; j < 2; ++j)
#pragma unroll
      for (int r = 0; r < 16; ++r) acc[i][j][r] = 0.f;
  uint4 ra[4], rb[4];
  auto gload = [&](int k0) {
#pragma unroll
    for (int i = 0; i < 4; ++i) {
      int id = tid + 256 * i;
      int r = id >> 3, ch = id & 7;
      ra[i] = *(const uint4*)(A + (size_t)(n0 + r) * lda + k0 + ch * 8);
      if (BMODE == 0) {
        int m = m0 + r;
        m = m < mmax ? m : mmax - 1;
        rb[i] = *(const uint4*)(B + (size_t)m * ldb + k0 + ch * 8);
      } else if (BMODE == 2) {
        int k = k0 + ch * 8;
        rb[i] = *(const uint4*)(B + ((size_t)(k >> 4) * MR + (m0 + r)) * 16 + (k & 15));
      } else {
        int kk = id >> 4, nch = id & 15;
        rb[i] = *(const uint4*)(B + (size_t)(k0 + kk) * ldb + m0 + nch * 8);
      }
    }
  };
  auto sstore = [&](int buf) {
    char* sa = smem + buf * 32768;
    char* sb = sa + 16384;
#pragma unroll
    for (int i = 0; i < 4; ++i) {
      int id = tid + 256 * i;
      int r = id >> 3, ch = id & 7;
      *(uint4*)(sa + r * 128 + ((ch ^ (r & 7)) << 4)) = ra[i];
      if (BMODE != 1) {
        *(uint4*)(sb + r * 128 + ((ch ^ (r & 7)) << 4)) = rb[i];
      } else {
        int kk = id >> 4, nch = id & 15;
#pragma unroll
        for (int e = 0; e < 8; ++e) {
          unsigned wd = (e >> 1) == 0 ? rb[i].x : (e >> 1) == 1 ? rb[i].y : (e >> 1) == 2 ? rb[i].z : rb[i].w;
          u16 v = (u16)((e & 1) ? (wd >> 16) : (wd & 0xffffu));
          int n = nch * 8 + e;
          *(u16*)(sb + n * 128 + ((((kk >> 3) ^ (n & 7)) << 4) + (kk & 7) * 2)) = v;
        }
      }
    }
  };
  const int nk = K >> 6;
  gload(0);
  sstore(0);
  __syncthreads();
  for (int kt = 0; kt < nk; ++kt) {
    if (kt + 1 < nk) gload((kt + 1) << 6);
    const char* sa = smem + (kt & 1) * 32768;
    const char* sb = sa + 16384;
#pragma unroll
    for (int ks = 0; ks < 4; ++ks) {
      bf16x8 af[2], bfr[2];
      const int ch = ks * 2 + (lane >> 5);
#pragma unroll
      for (int i = 0; i < 2; ++i) {
        int row = wn * 64 + i * 32 + (lane & 31);
        af[i] = *(const bf16x8*)(sa + row * 128 + ((ch ^ (row & 7)) << 4));
      }
#pragma unroll
      for (int j = 0; j < 2; ++j) {
        int row = wm * 64 + j * 32 + (lane & 31);
        bfr[j] = *(const bf16x8*)(sb + row * 128 + ((ch ^ (row & 7)) << 4));
      }
#pragma unroll
      for (int i = 0; i < 2; ++i)
#pragma unroll
        for (int j = 0; j < 2; ++j)
          acc[i][j] = __builtin_amdgcn_mfma_f32_32x32x16_bf16(af[i], bfr[j], acc[i][j], 0, 0, 0);
    }
    if (kt + 1 < nk) sstore((kt + 1) & 1);
    __syncthreads();
  }
  epi(acc, n0 + wn * 64, m0 + wm * 64, lane);
}

template <class F>
DEV void for_quads(f32x16 (&acc)[2][2], int nW, int mW, int lane, F f) {
#pragma unroll
  for (int i = 0; i < 2; ++i)
#pragma unroll
    for (int j = 0; j < 2; ++j)
#pragma unroll
      for (int q = 0; q < 4; ++q) {
        int nf = nW + i * 32 + 8 * q + 4 * (lane >> 5);
        int m = mW + j * 32 + (lane & 31);
        f(nf, m, acc[i][j][4 * q], acc[i][j][4 * q + 1], acc[i][j][4 * q + 2], acc[i][j][4 * q + 3]);
      }
}

struct EpiInproj {
  const Params& P;
  DEV void operator()(f32x16 (&acc)[2][2], int nW, int mW, int lane) const {
    const int hi = lane >> 5;
#pragma unroll
    for (int i = 0; i < 2; ++i) {
      const int nt = nW + i * 32;
#pragma unroll
      for (int j = 0; j < 2; ++j) {
        const int m = mW + j * 32 + (lane & 31);
        f32x16 a = acc[i][j];
        if (nt < 384) {
#pragma unroll
          for (int q = 0; q < 4; ++q) {
            int nf = nt + 8 * q + 4 * hi;
            int g = nf >> 4, h = nf & 15;
            u16* dst = P.UB + ((size_t)(g * NCH + (m >> 5))) * 768 + (m & 31) * 16 + h;
            store_bf4(dst, a[4 * q], a[4 * q + 1], a[4 * q + 2], a[4 * q + 3]);
          }
        } else if (nt < 640) {
#pragma unroll
          for (int q = 0; q < 4; ++q) {
            int nf = nt + 8 * q + 4 * hi - 384;
            store_bf4(P.fbuf + (size_t)m * 256 + nf, a[4 * q], a[4 * q + 1], a[4 * q + 2], a[4 * q + 3]);
          }
        } else if (nt < 1408) {
          const bool isq = nt < 1024;
          const int off = nt - (isq ? 640 : 1024);
          if (m < NLAT) {
            const int l = m & (SEQ - 1);
            const float pos = (off & 32) ? (float)(l & 63) : (float)(l >> 6);
#pragma unroll
            for (int e = 0; e < 8; ++e) {
              int fl = 8 * (e >> 2) + 4 * hi + (e & 3);
              float freq = exp2f(-(float)fl * (13.287712379549449f / 16.f));
              float rev = pos * freq * 0.15915494309189535f;
              float sn = hw_sin_rev(rev), cs = hw_cos_rev(rev);
              float x1 = a[e], x2 = a[e + 8];
              a[e] = x1 * cs - x2 * sn;
              a[e + 8] = x2 * cs + x1 * sn;
            }
          }
          const float sc = isq ? 0.125f : 1.f;
          u16* base = (isq ? P.qbuf : P.kbuf) + (size_t)m * 384 + off;
#pragma unroll
          for (int q = 0; q < 4; ++q)
            store_bf4(base + 8 * q + 4 * hi, a[4 * q] * sc, a[4 * q + 1] * sc, a[4 * q + 2] * sc, a[4 * q + 3] * sc);
        } else {
#pragma unroll
          for (int r = 0; r < 16; ++r) {
            int feat = nt - 1408 + (r & 3) + 8 * (r >> 2) + 4 * hi;
            if (m < NLAT)
              P.vT[((size_t)((m >> 13) * 384 + feat)) * SEQ + (m & (SEQ - 1))] = f2bf(a[r]);
            else
              P.vTc[((size_t)(((m - NLAT) >> 8) * 384 + feat)) * LCX + ((m - NLAT) & 255)] = f2bf(a[r]);
          }
        }
      }
    }
  }
};

struct EpiSsmEnd {
  float* Eg;
  DEV void operator()(f32x16 (&acc)[2][2], int nW, int mW, int lane) const {
    for_quads(acc, nW, mW, lane, [&](int nf, int m, float a, float b, float c, float d) {
      if (m < NCH) *(float4*)(Eg + (size_t)m * 256 + nf) = make_float4(a, b, c, d);
    });
  }
};

DEV float gelu_tanh(float x) {
  float u = 0.7978845608028654f * (x + 0.044715f * x * x * x);
  float t = 1.f - 2.f / (1.f + __expf(2.f * u));
  return 0.5f * x * (1.f + t);
}

struct EpiSsmOut {
  u16* zb;
  int g;
  DEV void operator()(f32x16 (&acc)[2][2], int nW, int mW, int lane) const {
    for_quads(acc, nW, mW, lane, [&](int nf, int m, float a, float b, float c, float d) {
      if (m < NCH) {
        int t = nf >> 4, h = nf & 15;
        store_bf4(zb + ((size_t)g * MR + m * TCH + t) * 16 + h, gelu_tanh(a), gelu_tanh(b), gelu_tanh(c),
                  gelu_tanh(d));
      }
    });
  }
};

struct EpiGlu {
  const u16* zb;
  u16* yc;
  DEV void operator()(f32x16 (&acc)[2][2], int nW, int mW, int lane) const {
    for_quads(acc, nW, mW, lane, [&](int nf, int m, float a, float b, float c, float d) {
      uint2 zz = *(const uint2*)(zb + ((size_t)(nf >> 4) * MR + m) * 16 + (nf & 15));
      float z0 = bf2f((u16)(zz.x & 0xffff)), z1 = bf2f((u16)(zz.x >> 16));
      float z2 = bf2f((u16)(zz.y & 0xffff)), z3 = bf2f((u16)(zz.y >> 16));
      store_bf4(yc + (size_t)m * 1024 + nf, z0 / (1.f + __expf(-a)), z1 / (1.f + __expf(-b)), z2 / (1.f + __expf(-c)),
                z3 / (1.f + __expf(-d)));
    });
  }
};

struct EpiFnetA {
  u16* A1b;
  DEV void operator()(f32x16 (&acc)[2][2], int nW, int mW, int lane) const {
    for_quads(acc, nW, mW, lane, [&](int nf, int m, float a, float b, float c, float d) {
      int k1 = nf >> 1;
      int cc = m >> 8, j = m & 255;
      u16* p = A1b + ((size_t)(k1 * 128 + cc * 2)) * 256 + j;
      p[0] = f2bf(a);
      p[256] = f2bf(b);
      p[128 * 256] = f2bf(c);
      p[128 * 256 + 256] = f2bf(d);
    });
  }
};

struct EpiFnetCtx {
  u16* Gb;
  DEV void operator()(f32x16 (&acc)[2][2], int nW, int mW, int lane) const {
    for_quads(acc, nW, mW, lane, [&](int nf, int m, float a, float b, float c, float d) {
      int k = nf >> 1;
      const float s = 1.f / 128.f;
      u16* p = Gb + (size_t)k * 512 + m;
      p[0] = f2bf(a * s);
      p[256] = f2bf(b * s);
      p[512] = f2bf(c * s);
      p[512 + 256] = f2bf(d * s);
    });
  }
};

struct EpiFnetC {
  u16* Gb;
  DEV void operator()(f32x16 (&acc)[2][2], int nW, int mW, int lane) const {
    for_quads(acc, nW, mW, lane, [&](int nf, int m, float a, float b, float c, float d) {
      int k2 = nf >> 1;
      const float s = 0.0013810679320049757f;
      u16* p = Gb + (size_t)k2 * 128 * 512 + m;
      p[0] = f2bf(a * s);
      p[256] = f2bf(b * s);
      p[128 * 512] = f2bf(c * s);
      p[128 * 512 + 256] = f2bf(d * s);
    });
  }
};

struct EpiStoreBf {
  u16* dst;
  int ld, coff;
  DEV void operator()(f32x16 (&acc)[2][2], int nW, int mW, int lane) const {
    for_quads(acc, nW, mW, lane, [&](int nf, int m, float a, float b, float c, float d) {
      store_bf4(dst + (size_t)m * ld + coff + nf, a, b, c, d);
    });
  }
};

struct EpiGateUp {
  u16* hid;
  DEV void operator()(f32x16 (&acc)[2][2], int nW, int mW, int lane) const {
    const int hi = lane >> 5;
#pragma unroll
    for (int j = 0; j < 2; ++j) {
      const int m = mW + j * 32 + (lane & 31);
#pragma unroll
      for (int q = 0; q < 4; ++q) {
        float o[4];
#pragma unroll
        for (int e = 0; e < 4; ++e) {
          float g = acc[0][j][4 * q + e], u = acc[1][j][4 * q + e];
          o[e] = g / (1.f + __expf(-g)) * u;
        }
        int col = (nW >> 6) * 32 + 8 * q + 4 * hi;
        store_bf4(hid + (size_t)m * DFF + col, o[0], o[1], o[2], o[3]);
      }
    }
  }
};

DEV void transpose_tile(const float* src, int K, int N, u16* dst, int mode, int kt, int nt, char* smem) {
  float* s = (float*)smem;
  const int tid = g_tid();
  const int k0 = kt * 64, n0 = nt * 64;
#pragma unroll
  for (int i = 0; i < 4; ++i) {
    int id = tid + 256 * i;
    int kk = id >> 4, c4 = id & 15;
    float4 v = *(const float4*)(src + (size_t)(k0 + kk) * N + n0 + c4 * 4);
    s[kk * 65 + c4 * 4 + 0] = v.x;
    s[kk * 65 + c4 * 4 + 1] = v.y;
    s[kk * 65 + c4 * 4 + 2] = v.z;
    s[kk * 65 + c4 * 4 + 3] = v.w;
  }
  __syncthreads();
#pragma unroll
  for (int i = 0; i < 2; ++i) {
    int id = tid + 256 * i;
    int nn = id >> 3, kc = id & 7;
    int n = n0 + nn;
    int row = mode == 0 ? n : (64 * (n >> 5) + (n & 31) + (mode == 2 ? 32 : 0));
    uint4 o;
    o.x = pack2(s[(kc * 8 + 0) * 65 + nn], s[(kc * 8 + 1) * 65 + nn]);
    o.y = pack2(s[(kc * 8 + 2) * 65 + nn], s[(kc * 8 + 3) * 65 + nn]);
    o.z = pack2(s[(kc * 8 + 4) * 65 + nn], s[(kc * 8 + 5) * 65 + nn]);
    o.w = pack2(s[(kc * 8 + 6) * 65 + nn], s[(kc * 8 + 7) * 65 + nn]);
    *(uint4*)(dst + (size_t)row * K + k0 + kc * 8) = o;
  }
  __syncthreads();
}

DEV void lam_pow(float are, float aim, float dt, int n, float& pr, float& pi) {
  float mag = expf((float)n * are * dt);
  double rev = (double)n * (double)aim * (double)dt * 0.15915494309189535;
  rev -= rint(rev);
  float fr = (float)rev;
  pr = mag * hw_cos_rev(fr);
  pi = mag * hw_sin_rev(fr);
}
DEV void zoh_factor(float are, float aim, float dt, float& fr, float& fi) {
  float lr, li;
  lam_pow(are, aim, dt, 1, lr, li);
  float nr = lr - 1.f, ni = li;
  float d2 = are * are + aim * aim;
  fr = (nr * are + ni * aim) / d2;
  fi = (ni * are - nr * aim) / d2;
}

constexpr int PREP_TR = 2852;
constexpr int PREP_KF = 24 * 63;
constexpr int PREP_WC = 24 * 2 * 32;
constexpr int PREP_WE = 24 * 2 * 8;
constexpr int PREP_MW = 64;
constexpr int PREP_N = PREP_TR + PREP_KF + PREP_WC + PREP_WE + PREP_MW;
constexpr int EXPAND_N = 24 * 32;

DEV void prep_job(const Params& P, int layer, int job, char* smem) {
  const int tid = g_tid();
  if (job < PREP_TR) {
    int j = job;
    if (j < 448) { transpose_tile(P.w_in + (size_t)layer * DM * INW, DM, INW, P.wt_in, 0, j / 28, j % 28, smem); return; }
    j -= 448;
    if (j < 256) { transpose_tile(P.w_out + (size_t)layer * DM * DM, DM, DM, P.wt_out, 0, j / 16, j % 16, smem); return; }
    j -= 256;
    if (j < 36) { transpose_tile(P.w_glu + (size_t)layer * 384 * 384, 384, 384, P.wt_glu, 0, j / 6, j % 6, smem); return; }
    j -= 36;
    if (j < 704) { transpose_tile(P.w_gate + (size_t)layer * DM * DFF, DM, DFF, P.wt_gu, 1, j / 44, j % 44, smem); return; }
    j -= 704;
    if (j < 704) { transpose_tile(P.w_up + (size_t)layer * DM * DFF, DM, DFF, P.wt_gu, 2, j / 44, j % 44, smem); return; }
    j -= 704;
    transpose_tile(P.w_down + (size_t)layer * DFF * DM, DFF, DM, P.wt_dn, 0, j / 16, j % 16, smem);
    return;
  }
  job -= PREP_TR;
  float* sf = (float*)smem;
  if (job < PREP_KF) {
    const int g = job / 63, delta = job % 63 - 31;
    const int ad = delta < 0 ? -delta : delta;
    float* sQ = sf;
    float* sCQ = sf + 256;
    if (tid < 128) {
      int dir = tid >> 6, p = tid & 63;
      int ix = ((layer * 2 + dir) * 24 + g) * 64 + p;
      float are = P.a_re[ix], aim = P.a_im[ix], dt = expf(P.log_dt[(layer * 2 + dir) * 24 + g]);
      float pr, pi, fr, fi;
      lam_pow(are, aim, dt, ad, pr, pi);
      zoh_factor(are, aim, dt, fr, fi);
      sQ[(dir * 64 + p) * 2 + 0] = pr * fr - pi * fi;
      sQ[(dir * 64 + p) * 2 + 1] = pr * fi + pi * fr;
    }
    __syncthreads();
#pragma unroll
    for (int i = 0; i < 8; ++i) {
      int e = tid + 256 * i;
      int dir = e >> 10, h = (e >> 6) & 15, p = e & 63;
      size_t ci = ((size_t)(((layer * 2 + dir) * 24 + g) * 16 + h)) * 64 + p;
      float cr = P.c_re[ci], cim = P.c_im[ci];
      float qr = sQ[(dir * 64 + p) * 2], qi = sQ[(dir * 64 + p) * 2 + 1];
      sCQ[e * 2 + 0] = cr * qr - cim * qi;
      sCQ[e * 2 + 1] = cr * qi + cim * qr;
    }
    __syncthreads();
    const int h = tid >> 4, hp = tid & 15;
    float val = 0.f;
#pragma unroll
    for (int dir = 0; dir < 2; ++dir) {
      bool need = dir == 0 ? (delta >= 0) : (delta <= 0);
      if (need) {
        const float* br = P.b_re + ((size_t)(((layer * 2 + dir) * 24 + g) * 64)) * 16 + hp;
        const float* bi = P.b_im + ((size_t)(((layer * 2 + dir) * 24 + g) * 64)) * 16 + hp;
        const float* cq = sCQ + ((dir * 16 + h) * 64) * 2;
        for (int p = 0; p < 64; ++p) val += cq[p * 2] * br[p * 16] - cq[p * 2 + 1] * bi[p * 16];
      }
    }
    if (delta == 0 && h == hp) val += P.ssm_d[layer * 384 + g * 16 + h];
    P.Ktau[(size_t)job * 256 + tid] = val;
    __syncthreads();
    return;
  }
  job -= PREP_KF;
  if (job < PREP_WC) {
    const int j = job & 31, dir = (job >> 5) & 1, g = job >> 6;
    float* sP = sf;
    if (tid < 64) {
      int p = tid;
      int ix = ((layer * 2 + dir) * 24 + g) * 64 + p;
      float are = P.a_re[ix], aim = P.a_im[ix], dt = expf(P.log_dt[(layer * 2 + dir) * 24 + g]);
      float pr, pi;
      lam_pow(are, aim, dt, dir == 0 ? j + 1 : 32 - j, pr, pi);
      sP[p * 2] = pr;
      sP[p * 2 + 1] = pi;
      if (j == 0) {
        float tr, ti;
        lam_pow(are, aim, dt, 32, tr, ti);
        P.lamT[((dir * 24 + g) * 64 + p) * 2] = tr;
        P.lamT[((dir * 24 + g) * 64 + p) * 2 + 1] = ti;
      }
    }
    __syncthreads();
#pragma unroll
    for (int i = 0; i < 8; ++i) {
      int e = tid + 256 * i;
      int h = e >> 7, pc = e & 127, p = pc >> 1, ri = pc & 1;
      size_t ci = ((size_t)(((layer * 2 + dir) * 24 + g) * 16 + h)) * 64 + p;
      float cr = P.c_re[ci], cim = P.c_im[ci];
      float pr = sP[p * 2], pi = sP[p * 2 + 1];
      float v = ri == 0 ? (cr * pr - cim * pi) : -(cr * pi + cim * pr);
      P.A_out[((size_t)(g * 512 + j * 16 + h)) * 768 + 512 + dir * 128 + pc] = f2bf(v);
    }
    __syncthreads();
    return;
  }
  job -= PREP_WC;
  if (job < PREP_WE) {
    const int jq = job & 7, dir = (job >> 3) & 1, g = job >> 4;
    float* sP = sf;
    {
      int jj = tid >> 6, p = tid & 63;
      int j = jq * 4 + jj;
      int ix = ((layer * 2 + dir) * 24 + g) * 64 + p;
      float are = P.a_re[ix], aim = P.a_im[ix], dt = expf(P.log_dt[(layer * 2 + dir) * 24 + g]);
      float pr, pi, fr, fi;
      lam_pow(are, aim, dt, dir == 0 ? 31 - j : j, pr, pi);
      zoh_factor(are, aim, dt, fr, fi);
      sP[(jj * 64 + p) * 2] = pr * fr - pi * fi;
      sP[(jj * 64 + p) * 2 + 1] = pr * fi + pi * fr;
    }
    __syncthreads();
    {
      const int prow = tid >> 1, half = tid & 1, p = prow >> 1, ri = prow & 1;
      const size_t bbase = ((size_t)(((layer * 2 + dir) * 24 + g) * 64 + p)) * 16;
      u16* dst = P.A_end + ((size_t)(g * 256 + dir * 128 + prow)) * 512 + jq * 64 + half * 32;
#pragma unroll
      for (int q = 0; q < 2; ++q) {
        int jj = half * 2 + q;
        float pr = sP[(jj * 64 + p) * 2], pi = sP[(jj * 64 + p) * 2 + 1];
        unsigned pk[8];
#pragma unroll
        for (int h2 = 0; h2 < 8; ++h2) {
          float b0r = P.b_re[bbase + 2 * h2], b0i = P.b_im[bbase + 2 * h2];
          float b1r = P.b_re[bbase + 2 * h2 + 1], b1i = P.b_im[bbase + 2 * h2 + 1];
          float v0 = ri == 0 ? (pr * b0r - pi * b0i) : (pr * b0i + pi * b0r);
          float v1 = ri == 0 ? (pr * b1r - pi * b1i) : (pr * b1i + pi * b1r);
          pk[h2] = pack2(v0, v1);
        }
        *(uint4*)(dst + q * 16) = make_uint4(pk[0], pk[1], pk[2], pk[3]);
        *(uint4*)(dst + q * 16 + 8) = make_uint4(pk[4], pk[5], pk[6], pk[7]);
      }
    }
    __syncthreads();
    return;
  }
  job -= PREP_WE;
  {
    const int nb = job & 7, g = (job >> 3) & 3, ri = job >> 5;
    const float* wf = P.w_fourier + (size_t)layer * 256 * 256;
    const int n = nb * 32 + (tid >> 3), jg = tid & 7;
    unsigned pk[4];
#pragma unroll
    for (int jp = 0; jp < 4; ++jp) {
      float sum2[2];
#pragma unroll
      for (int q = 0; q < 2; ++q) {
        int j = jg * 8 + jp * 2 + q;
        float sum = 0.f;
        for (int m = 0; m < 64; ++m) {
          float fr = (float)((m * j) & 63) * (1.f / 64.f);
          float tr = ri ? hw_sin_rev(fr) : hw_cos_rev(fr);
          sum += tr * wf[(size_t)(g * 64 + m) * 256 + n];
        }
        sum2[q] = sum;
      }
      pk[jp] = pack2(sum2[0], sum2[1]);
    }
    *(uint4*)(P.MWt + (size_t)n * 512 + ri * 256 + g * 64 + jg * 8) = make_uint4(pk[0], pk[1], pk[2], pk[3]);
  }
}

DEV void expand_job(const Params& P, int job) {
  const int tid = g_tid();
  const int g = job >> 5, t = job & 31;
  const int h = tid >> 4, cgp = tid & 15;
  u16* dst = P.A_out + ((size_t)(g * 512 + t * 16 + h)) * 768 + cgp * 32;
#pragma unroll
  for (int q = 0; q < 2; ++q) {
    int sidx = cgp * 2 + q;
    int dI = t - sidx + 31;
    const float4* src = (const float4*)(P.Ktau + ((size_t)(g * 63 + dI)) * 256 + h * 16);
    float4 a = src[0], b = src[1], c = src[2], d = src[3];
    *(uint4*)(dst + q * 16) = make_uint4(pack2(a.x, a.y), pack2(a.z, a.w), pack2(b.x, b.y), pack2(b.z, b.w));
    *(uint4*)(dst + q * 16 + 8) = make_uint4(pack2(c.x, c.y), pack2(c.z, c.w), pack2(d.x, d.y), pack2(d.z, d.w));
  }
}

constexpr int CONST_MOD = 384, CONST_D128 = 16, CONST_D256 = 64, CONST_T = 1024;
constexpr int CONST_N = CONST_MOD + CONST_D128 + CONST_D256 + CONST_T;

DEV void const_job(const Params& P, int job, char* smem) {
  const int tid = g_tid();
  if (job < CONST_MOD) {
    const int layer = job / 192, cb = job % 192;
    float* sv = (float*)smem;
    float* red = sv + 3 * 1024;
    for (int i = tid; i < 3 * 1024; i += 256) {
      int v = i >> 10, k = i & 1023;
      float cv = v < 2 ? P.c[v * 1024 + k] : P.c_ctx[k];
      sv[i] = cv / (1.f + __expf(-cv));
    }
    __syncthreads();
    const int kg = tid >> 5, cl = tid & 31;
    const int n = cb * 32 + cl;
    const float* W = P.w_mod + (size_t)layer * DM * 6144 + n;
    float a0 = 0.f, a1 = 0.f, a2 = 0.f;
#pragma unroll 8
    for (int k = kg * 128; k < kg * 128 + 128; ++k) {
      float wv = W[(size_t)k * 6144];
      a0 += sv[k] * wv;
      a1 += sv[1024 + k] * wv;
      a2 += sv[2048 + k] * wv;
    }
    red[(kg * 3 + 0) * 32 + cl] = a0;
    red[(kg * 3 + 1) * 32 + cl] = a1;
    red[(kg * 3 + 2) * 32 + cl] = a2;
    __syncthreads();
    if (tid < 96) {
      int v = tid >> 5, c2 = tid & 31;
      float s = P.b_mod[layer * 6144 + cb * 32 + c2];
      for (int q = 0; q < 8; ++q) s += red[(q * 3 + v) * 32 + c2];
      P.mod[(layer * 3 + v) * 6144 + cb * 32 + c2] = s;
    }
    __syncthreads();
    return;
  }
  job -= CONST_MOD;
  if (job < CONST_D128) {
#pragma unroll
    for (int i = 0; i < 8; ++i) {
      int idx = job * 2048 + tid + 256 * i;
      int row = idx >> 7, r = idx & 127;
      int k1 = row >> 1, ri = row & 1;
      float fr = (float)((k1 * r) & 127) * (1.f / 128.f);
      P.D128[idx] = f2bf(ri ? -hw_sin_rev(fr) : hw_cos_rev(fr));
    }
    return;
  }
  job -= CONST_D128;
  if (job < CONST_D256) {
#pragma unroll
    for (int i = 0; i < 8; ++i) {
      int idx = job * 2048 + tid + 256 * i;
      int row = idx >> 8, l = idx & 255;
      int k = row >> 1, ri = row & 1;
      float fr = (float)((k * l) & 255) * (1.f / 256.f);
      P.D256[idx] = f2bf(ri ? -hw_sin_rev(fr) : hw_cos_rev(fr));
    }
    return;
  }
  job -= CONST_D256;
  {
#pragma unroll
    for (int i = 0; i < 8; ++i) {
      int idx = job * 2048 + tid + 256 * i;
      int k1 = idx >> 14, row = (idx >> 7) & 127, col = idx & 127;
      int k2 = row >> 1, ri = row & 1, cc = col >> 1, rj = col & 1;
      float fr = (float)((cc * (k1 + 128 * k2)) & 8191) * (1.f / 8192.f);
      float cs = hw_cos_rev(fr), sn = hw_sin_rev(fr);
      float v = (ri == rj) ? cs : (ri == 0 ? sn : -sn);
      P.Tmat[idx] = f2bf(v);
    }
  }
}

DEV float4 ld4(const float* p) { return *(const float4*)p; }
DEV float4 ldbf4(const u16* p) {
  uint2 v = *(const uint2*)p;
  return make_float4(bf2f((u16)(v.x & 0xffff)), bf2f((u16)(v.x >> 16)), bf2f((u16)(v.y & 0xffff)), bf2f((u16)(v.y >> 16)));
}
DEV float sq4(float4 v) { return v.x * v.x + v.y * v.y + v.z * v.z + v.w * v.w; }

DEV void rowop(const Params& P, int kind, int layer, int m, int lane) {
  const bool last = layer == 1;
  if (kind == 2 && last && m >= NLAT) return;
  const int mi = m < NLAT ? (m >> 13) : 2;
  float* resid = m < NLAT ? P.out + (size_t)m * DM : P.xctx + (size_t)(m - NLAT) * DM;
  const float* xin;
  if (kind == 0 || (kind == 1 && layer == 0))
    xin = m < NLAT ? P.x + (size_t)m * DM : P.ctx + (size_t)(m - NLAT) * DM;
  else
    xin = resid;
  const float* modv = P.mod + (size_t)(layer * 3 + mi) * 6144;
  float4 v[4];
#pragma unroll
  for (int i = 0; i < 4; ++i) v[i] = ld4(xin + i * 256 + lane * 4);
  if (kind != 0) {
    const float* gpost = (kind == 1 ? P.g_post_mix : P.g_post_ffn) + layer * DM;
    const float* gate = modv + (kind == 1 ? 2048 : 5120);
    float4 o[4];
    float ss = 0.f;
#pragma unroll
    for (int i = 0; i < 4; ++i) {
      o[i] = ldbf4(P.obuf + (size_t)m * DM + i * 256 + lane * 4);
      ss += sq4(o[i]);
    }
    ss = wave_sum(ss);
    float rinv = rsqrtf(ss * (1.f / DM) + EPS);
#pragma unroll
    for (int i = 0; i < 4; ++i) {
      float4 gp = ld4(gpost + i * 256 + lane * 4), gt = ld4(gate + i * 256 + lane * 4);
      v[i].x += gt.x * (o[i].x * rinv * gp.x);
      v[i].y += gt.y * (o[i].y * rinv * gp.y);
      v[i].z += gt.z * (o[i].z * rinv * gp.z);
      v[i].w += gt.w * (o[i].w * rinv * gp.w);
    }
    if (kind == 2 && last) {
#pragma unroll
      for (int i = 0; i < 4; ++i) *(float4*)(P.out + (size_t)m * DM + i * 256 + lane * 4) = v[i];
      return;
    }
#pragma unroll
    for (int i = 0; i < 4; ++i) *(float4*)(resid + i * 256 + lane * 4) = v[i];
  }
  const int la = kind == 2 ? layer + 1 : layer;
  const float* gpre = (kind == 1 ? P.g_pre_ffn : P.g_pre_mix) + la * DM;
  const float* mv = P.mod + (size_t)(la * 3 + mi) * 6144;
  const float* sh = mv + (kind == 1 ? 3072 : 0);
  const float* sc = mv + (kind == 1 ? 4096 : 1024);
  float ss = 0.f;
#pragma unroll
  for (int i = 0; i < 4; ++i) ss += sq4(v[i]);
  ss = wave_sum(ss);
  float rinv = rsqrtf(ss * (1.f / DM) + EPS);
#pragma unroll
  for (int i = 0; i < 4; ++i) {
    int col = i * 256 + lane * 4;
    float4 gp = ld4(gpre + col), s1 = ld4(sc + col), s0 = ld4(sh + col);
    store_bf4(P.abuf + (size_t)m * DM + col, v[i].x * rinv * gp.x * (1.f + s1.x) + s0.x,
              v[i].y * rinv * gp.y * (1.f + s1.y) + s0.y, v[i].z * rinv * gp.z * (1.f + s1.z) + s0.z,
              v[i].w * rinv * gp.w * (1.f + s1.w) + s0.w);
  }
}

DEV void attn_wave(const Params& P, int layer, bool isctx, int b, int h, int r, int cgp, int lane) {
  const int qi = lane & 15, g = lane >> 4;
  int mq, c = 0, cs = 0, cb = 0, rs = 0;
  if (!isctx) {
    c = cgp * 16 + qi;
    mq = b * SEQ + r * 64 + c;
    cs = c - 8;
    cs = cs < 0 ? 0 : (cs > 48 ? 48 : cs);
    cb = cgp == 0 ? 0 : (cgp == 1 ? 8 : (cgp == 2 ? 24 : 32));
    rs = r - 4;
    rs = rs < 0 ? 0 : (rs > 120 ? 120 : rs);
  } else {
    mq = NLAT + b * LCX + cgp * 16 + qi;
  }
  const u16* qp = P.qbuf + (size_t)mq * 384 + h * 64 + g * 8;
  const bf16x8 qf0 = *(const bf16x8*)qp, qf1 = *(const bf16x8*)(qp + 32);
  f32x4 o[4];
#pragma unroll
  for (int d = 0; d < 4; ++d) o[d] = f32x4{0.f, 0.f, 0.f, 0.f};
  float mrun = -1e30f, lrun = 0.f;
  const float* rp = P.rpb + (size_t)(layer * 6 + h) * 465;
  const int nblk = isctx ? 8 : 16;
  for (int kb = 0; kb < nblk; ++kb) {
    const bool win = (!isctx) && kb < 8;
    size_t krow0;
    const u16* vbase;
    int vld;
    if (win) {
      int tok0 = (rs + kb) * 64 + cb;
      krow0 = (size_t)b * SEQ + tok0;
      vbase = P.vT + ((size_t)(b * 384 + h * 64)) * SEQ + tok0;
      vld = SEQ;
    } else {
      int kc = (isctx ? kb : kb - 8) * 32;
      krow0 = (size_t)NLAT + b * LCX + kc;
      vbase = P.vTc + ((size_t)(b * 384 + h * 64)) * LCX + kc;
      vld = LCX;
    }
    f32x4 s[2];
#pragma unroll
    for (int t = 0; t < 2; ++t) {
      const u16* kp = P.kbuf + (krow0 + t * 16 + qi) * 384 + h * 64 + g * 8;
      bf16x8 k0 = *(const bf16x8*)kp, k1 = *(const bf16x8*)(kp + 32);
      f32x4 z = {0.f, 0.f, 0.f, 0.f};
      z = __builtin_amdgcn_mfma_f32_16x16x32_bf16(k0, qf0, z, 0, 0, 0);
      s[t] = __builtin_amdgcn_mfma_f32_16x16x32_bf16(k1, qf1, z, 0, 0, 0);
    }
    if (win) {
      const int dr = rs + kb - r + 7;
#pragma unroll
      for (int t = 0; t < 2; ++t)
#pragma unroll
        for (int i = 0; i < 4; ++i) {
          int keycol = cb + t * 16 + g * 4 + i;
          bool valid = keycol >= cs && keycol < cs + 16;
          int dc = keycol - c + 15;
          dc = dc < 0 ? 0 : (dc > 30 ? 30 : dc);
          float bias = rp[dr * 31 + dc];
          s[t][i] = valid ? s[t][i] + bias : -1e30f;
        }
    }
    float mx = fmaxf(fmaxf(fmaxf(s[0][0], s[0][1]), fmaxf(s[0][2], s[0][3])),
                     fmaxf(fmaxf(s[1][0], s[1][1]), fmaxf(s[1][2], s[1][3])));
    mx = fmaxf(mx, __shfl_xor(mx, 16));
    mx = fmaxf(mx, __shfl_xor(mx, 32));
    const float mnew = fmaxf(mrun, mx);
    const float alpha = __expf(mrun - mnew);
    mrun = mnew;
    float p[8], psum = 0.f;
#pragma unroll
    for (int t = 0; t < 2; ++t)
#pragma unroll
      for (int i = 0; i < 4; ++i) {
        p[t * 4 + i] = __expf(s[t][i] - mnew);
        psum += p[t * 4 + i];
      }
    lrun = lrun * alpha + psum;
    bf16x8 pf;
#pragma unroll
    for (int e = 0; e < 8; ++e) pf[e] = (short)f2bf(p[e]);
#pragma unroll
    for (int d = 0; d < 4; ++d) {
      o[d] *= alpha;
      const u16* vp = vbase + (size_t)(d * 16 + qi) * vld + g * 4;
      uint2 v0 = *(const uint2*)vp, v1 = *(const uint2*)(vp + 16);
      union { uint4 u; bf16x8 v; } cv;
      cv.u = make_uint4(v0.x, v0.y, v1.x, v1.y);
      o[d] = __builtin_amdgcn_mfma_f32_16x16x32_bf16(cv.v, pf, o[d], 0, 0, 0);
    }
  }
  float l = lrun + __shfl_xor(lrun, 16);
  l += __shfl_xor(l, 32);
  const float inv = 1.f / l;
#pragma unroll
  for (int d = 0; d < 4; ++d)
    store_bf4(P.ycat + (size_t)mq * DM + 640 + h * 64 + d * 16 + g * 4, o[d][0] * inv, o[d][1] * inv, o[d][2] * inv,
              o[d][3] * inv);
}

DEV void carry_job(const Params& P, int job) {
  const int idx = job * 256 + g_tid();
  const int p = idx & 63;
  int combo = idx >> 6;
  const int g = combo % 24;
  combo /= 24;
  const int dir = combo & 1, b = combo >> 1;
  const float lr = P.lamT[((dir * 24 + g) * 64 + p) * 2], li = P.lamT[((dir * 24 + g) * 64 + p) * 2 + 1];
  float cr = 0.f, ci = 0.f;
  auto step = [&](int chunk) {
    size_t row = (size_t)(g * NCH + chunk);
    *(unsigned*)(P.UB + row * 768 + 512 + dir * 128 + p * 2) = pack2(cr, ci);
    const float2 e = *(const float2*)(P.E + row * 256 + dir * 128 + p * 2);
    float nr = lr * cr - li * ci + e.x, ni = lr * ci + li * cr + e.y;
    cr = nr;
    ci = ni;
  };
  if (dir == 0) {
    for (int cc = 0; cc < 8; ++cc) step(512 + b * 8 + cc);
    for (int cc = 0; cc < 256; ++cc) step(b * 256 + cc);
  } else {
    for (int cc = 7; cc >= 0; --cc) step(512 + b * 8 + cc);
    for (int cc = 255; cc >= 0; --cc) step(b * 256 + cc);
  }
}

DEV void run_phase(const Params& P, int ph, int bid, int nblk, char* smem) {
  const int lane = g_tid() & 63, w = g_tid() >> 6;
  if (ph == 0) {
    for (int job = bid; job < CONST_N + PREP_N; job += nblk) {
      if (job < CONST_N) const_job(P, job, smem);
      else prep_job(P, 0, job - CONST_N, smem);
    }
    return;
  }
  if (ph == 1) {
    for (int job = bid; job < MR / 4 + EXPAND_N; job += nblk) {
      if (job < MR / 4) rowop(P, 0, 0, job * 4 + w, lane);
      else expand_job(P, job - MR / 4);
    }
    return;
  }
  const int layer = (ph - 2) / 10, sub = (ph - 2) % 10;
  switch (sub) {
    case 0: {
      EpiInproj epi{P};
      const int nexp = layer == 1 ? EXPAND_N : 0;
      for (int job = bid; job < 14 * 132 + nexp; job += nblk) {
        if (job >= 14 * 132) { expand_job(P, job - 14 * 132); continue; }
        int mt = job / 14, nt = job % 14;
        gemm_tile<0>(P.wt_in, DM, P.abuf, DM, DM, nt * 128, mt * 128, MR, smem, epi);
      }
    } break;
    case 1: {
      const int J0 = 1536, J1 = J0 + 48, J2 = J1 + 240, J3 = J2 + 512, J4 = J3 + 16;
      for (int job = bid; job < J4; job += nblk) {
        if (job < J0) {
          int r = job & 127, bh = job >> 7;
          attn_wave(P, layer, false, bh / 6, bh % 6, r, w, lane);
        } else if (job < J1) {
          int j = job - J0;
          int qb = j & 3, bh = j >> 2;
          attn_wave(P, layer, true, bh / 6, bh % 6, 0, qb * 4 + w, lane);
        } else if (job < J2) {
          int j = job - J1;
          int g = j / 10, t = j % 10;
          EpiSsmEnd epi{P.E + (size_t)g * NCH * 256};
          gemm_tile<0>(P.A_end + (size_t)g * 256 * 512, 512, P.UB + (size_t)g * NCH * 768, 768, 512, (t & 1) * 128,
                           (t >> 1) * 128, NCH, smem, epi);
        } else if (job < J3) {
          int j = job - J2;
          int b = j >> 8, t = j & 255;
          EpiFnetA epi{P.A1 + (size_t)b * 128 * 128 * 256};
          gemm_tile<1>(P.D128, 128, P.fbuf + (size_t)b * SEQ * 256, 64 * 256, 128, (t & 1) * 128, (t >> 1) * 128,
                          64 * 256, smem, epi);
        } else {
          int j = job - J3;
          int b = j >> 3, t = j & 7;
          EpiFnetCtx epi{P.Gbuf + (size_t)(NLAT + b * LCX) * 512};
          gemm_tile<1>(P.D256, 256, P.fbuf + (size_t)(NLAT + b * LCX) * 256, 256, 256, (t & 3) * 128, (t >> 2) * 128,
                          256, smem, epi);
        }
      }
    } break;
    case 2: {
      for (int job = bid; job < 24 + 512; job += nblk) {
        if (job < 24) carry_job(P, job);
        else {
          int j = job - 24;
          int bk = j >> 1, t = j & 1;
          int k1 = bk & 127, b = bk >> 7;
          EpiFnetC epi{P.Gbuf + (size_t)(b * SEQ + k1) * 512};
          gemm_tile<1>(P.Tmat + (size_t)k1 * 128 * 128, 128, P.A1 + (size_t)bk * 128 * 256, 256, 128, 0, t * 128, 256,
                          smem, epi);
        }
      }
    } break;
    case 3: {
      for (int job = bid; job < 480 + 264; job += nblk) {
        if (job < 480) {
          int g = job / 20, t = job % 20;
          EpiSsmOut epi{P.zbuf, g};
          gemm_tile<0>(P.A_out + (size_t)g * 512 * 768, 768, P.UB + (size_t)g * NCH * 768, 768, 768, (t & 3) * 128,
                           (t >> 2) * 128, NCH, smem, epi);
        } else {
          int j = job - 480;
          EpiStoreBf epi{P.ycat, DM, 384};
          gemm_tile<0>(P.MWt, 512, P.Gbuf, 512, 512, (j & 1) * 128, (j >> 1) * 128, MR, smem, epi);
        }
      }
    } break;
    case 4: {
      EpiGlu epi{P.zbuf, P.ycat};
      for (int job = bid; job < 3 * 132; job += nblk)
        gemm_tile<2>(P.wt_glu, 384, P.zbuf, 384, 384, (job % 3) * 128, (job / 3) * 128, MR, smem, epi);
    } break;
    case 5: {
      EpiStoreBf epi{P.obuf, DM, 0};
      for (int job = bid; job < 8 * 132; job += nblk)
        gemm_tile<0>(P.wt_out, DM, P.ycat, DM, DM, (job & 7) * 128, (job >> 3) * 128, MR, smem, epi);
    } break;
    case 6: {
      for (int job = bid; job < MR / 4; job += nblk) rowop(P, 1, layer, job * 4 + w, lane);
    } break;
    case 7: {
      EpiGateUp epi{P.hidden};
      for (int job = bid; job < 44 * 132; job += nblk)
        gemm_tile<0>(P.wt_gu, DM, P.abuf, DM, DM, (job % 44) * 128, (job / 44) * 128, MR, smem, epi);
    } break;
    case 8: {
      EpiStoreBf epi{P.obuf, DM, 0};
      for (int job = bid; job < 8 * 132; job += nblk)
        gemm_tile<0>(P.wt_dn, DFF, P.hidden, DFF, DFF, (job & 7) * 128, (job >> 3) * 128, MR, smem, epi);
    } break;
    case 9: {
      const int nrow = MR / 4;
      const int total = nrow + (layer == 0 ? PREP_N : 0);
      for (int job = bid; job < total; job += nblk) {
        if (job < nrow) rowop(P, 2, layer, job * 4 + w, lane);
        else prep_job(P, 1, job - nrow, smem);
      }
    } break;
  }
}

#if MK_MULTI
__global__ void __launch_bounds__(256) phase_kernel(Params P, int ph) {
  __shared__ __attribute__((aligned(16))) char smem[65536];
  run_phase(P, ph, blockIdx.x, gridDim.x, smem);
}
#else
DEV void grid_barrier(unsigned* bar, unsigned target) {
  asm volatile("s_waitcnt vmcnt(0)" ::: "memory");
  __syncthreads();
  if (threadIdx.x == 0) {
    __builtin_amdgcn_fence(__ATOMIC_RELEASE, "agent");
    asm volatile("s_waitcnt vmcnt(0)" ::: "memory");
    __hip_atomic_fetch_add(bar, 1u, __ATOMIC_RELAXED, __HIP_MEMORY_SCOPE_AGENT);
    while (__hip_atomic_load(bar, __ATOMIC_RELAXED, __HIP_MEMORY_SCOPE_AGENT) < target) __builtin_amdgcn_s_sleep(2);
    __builtin_amdgcn_fence(__ATOMIC_ACQUIRE, "agent");
    asm volatile("s_waitcnt vmcnt(0)" ::: "memory");
  }
  __syncthreads();
  __builtin_amdgcn_fence(__ATOMIC_ACQUIRE, "agent");
}

__global__ void __launch_bounds__(256) fwd_megakernel(Params P, unsigned* bar) {
  __shared__ __attribute__((aligned(16))) char smem[65536];
  cg::grid_group grid = cg::this_grid();
  grid.sync();
  for (int ph = 0; ph < NPH; ++ph) {
    int bid = blockIdx.x;
    asm volatile("" : "+s"(bid));
    run_phase(P, ph, bid, gridDim.x, smem);
    if (ph + 1 < NPH) grid_barrier(bar, (unsigned)(ph + 1) * gridDim.x);
  }
}
#endif

extern "C" void kernel_launch(void* const* d_in, const int* in_sizes, int n_in, void* d_out, int out_size, void* d_ws,
                              size_t ws_size, hipStream_t stream) {
  Params p{};
  const float* const* in = (const float* const*)d_in;
  p.x = in[0]; p.c = in[1]; p.ctx = in[2]; p.c_ctx = in[3]; p.w_mod = in[4]; p.b_mod = in[5];
  p.g_pre_mix = in[6]; p.g_post_mix = in[7]; p.w_in = in[8]; p.a_re = in[9]; p.a_im = in[10]; p.log_dt = in[11];
  p.b_re = in[12]; p.b_im = in[13]; p.c_re = in[14]; p.c_im = in[15]; p.ssm_d = in[16]; p.w_glu = in[17];
  p.w_fourier = in[18]; p.rpb = in[19]; p.w_out = in[20]; p.g_pre_ffn = in[21]; p.g_post_ffn = in[22];
  p.w_gate = in[23]; p.w_up = in[24]; p.w_down = in[25];
  p.out = (float*)d_out;
  char* ws = (char*)d_ws;
  size_t off = 0;
  auto alloc = [&](size_t bytes) { char* r = ws + off; off += (bytes + 255) & ~(size_t)255; return r; };
  p.wt_in = (u16*)alloc((size_t)INW * DM * 2);
  p.wt_out = (u16*)alloc((size_t)DM * DM * 2);
  p.wt_glu = (u16*)alloc((size_t)384 * 384 * 2);
  p.wt_gu = (u16*)alloc((size_t)2 * DFF * DM * 2);
  p.wt_dn = (u16*)alloc((size_t)DM * DFF * 2);
  p.A_out = (u16*)alloc((size_t)24 * 512 * 768 * 2);
  p.A_end = (u16*)alloc((size_t)24 * 256 * 512 * 2);
  p.D128 = (u16*)alloc(256 * 128 * 2);
  p.D256 = (u16*)alloc(512 * 256 * 2);
  p.Tmat = (u16*)alloc((size_t)128 * 128 * 128 * 2);
  p.MWt = (u16*)alloc(256 * 512 * 2);
  p.lamT = (float*)alloc(2 * 24 * 64 * 2 * 4);
  p.Ktau = (float*)alloc((size_t)24 * 63 * 256 * 4);
  p.mod = (float*)alloc(2 * 3 * 6144 * 4);
  p.abuf = (u16*)alloc((size_t)MR * DM * 2);
  p.xctx = (float*)alloc((size_t)NCTX * DM * 4);
  unsigned* bar = (unsigned*)alloc(256);
  char* R = ws + off;
  size_t roff = 0;
  auto ralloc = [&](size_t bytes) { char* r = R + roff; roff += (bytes + 255) & ~(size_t)255; return r; };
  p.ycat = (u16*)ralloc((size_t)MR * DM * 2);
  p.UB = (u16*)ralloc((size_t)24 * NCH * 768 * 2);
  p.fbuf = (u16*)ralloc((size_t)MR * 256 * 2);
  p.qbuf = (u16*)ralloc((size_t)MR * 384 * 2);
  p.kbuf = (u16*)ralloc((size_t)MR * 384 * 2);
  p.vT = (u16*)ralloc((size_t)2 * 384 * SEQ * 2);
  p.vTc = (u16*)ralloc((size_t)2 * 384 * LCX * 2);
  p.E = (float*)ralloc((size_t)24 * NCH * 256 * 4);
  p.A1 = (u16*)ralloc((size_t)2 * 128 * 128 * 256 * 2);
  p.Gbuf = (u16*)ralloc((size_t)MR * 512 * 2);
  p.zbuf = p.qbuf;
  p.hidden = (u16*)R;
  const size_t hid_bytes = (((size_t)MR * DFF * 2) + 255) & ~(size_t)255;
  p.obuf = (u16*)(R + hid_bytes);
  size_t rneed = hid_bytes + (size_t)MR * DM * 2;
  if (rneed > roff) roff = rneed;
  if (off + roff > ws_size) {
    fprintf(stderr, "workspace too small: need %zu have %zu\n", off + roff, ws_size);
    return;
  }
#if MK_MULTI
  for (int ph = 0; ph < NPH; ++ph) phase_kernel<<<dim3(1024), dim3(256), 0, stream>>>(p, ph);
#else
  static int grid_blocks = 0;
  if (!grid_blocks) {
    int dev = 0, cus = 0, per_cu = 0;
    hipGetDevice(&dev);
    hipDeviceGetAttribute(&cus, hipDeviceAttributeMultiprocessorCount, dev);
    hipOccupancyMaxActiveBlocksPerMultiprocessor(&per_cu, fwd_megakernel, 256, 0);
    if (per_cu > 2) per_cu = 2;
    grid_blocks = cus * per_cu;
  }
  hipMemsetAsync(bar, 0, 256, stream);
  void* args[] = {&p, &bar};
  hipError_t e = hipLaunchCooperativeKernel((void*)fwd_megakernel, dim3(grid_blocks), dim3(256), args, 0, stream);
  if (e != hipSuccess) fprintf(stderr, "cooperative launch failed: %s (grid %d)\n", hipGetErrorString(e), grid_blocks);
#endif
}
```

```cpp
#include <hip/hip_runtime.h>
#include <hip/hip_bf16.h>
#include <hip/hip_cooperative_groups.h>
#include <cstdio>
#include <cstdint>
namespace cg = cooperative_groups;

#ifndef MK_MULTI
#define MK_MULTI 0
#endif

typedef __attribute__((ext_vector_type(8))) short bf16x8;
typedef __attribute__((ext_vector_type(4))) float f32x4;
typedef __attribute__((ext_vector_type(16))) float f32x16;
typedef unsigned short u16;

#define DEV __device__ __forceinline__

constexpr int DM = 1024, SEQ = 8192, LCX = 256;
constexpr int NLAT = 2 * SEQ, NCTX = 2 * LCX, MR = NLAT + NCTX;
constexpr int INW = 1792, DFF = 2816;
constexpr int TCH = 32, NCH = MR / TCH;
constexpr int NPH = 22;
constexpr float EPS = 1e-6f;

struct Params {
  const float *x, *c, *ctx, *c_ctx, *w_mod, *b_mod, *g_pre_mix, *g_post_mix, *w_in;
  const float *a_re, *a_im, *log_dt, *b_re, *b_im, *c_re, *c_im, *ssm_d, *w_glu, *w_fourier, *rpb, *w_out;
  const float *g_pre_ffn, *g_post_ffn, *w_gate, *w_up, *w_down;
  float* out;
  u16 *wt_in, *wt_out, *wt_glu, *wt_gu, *wt_dn, *A_out, *A_end, *D128, *D256, *Tmat, *MWt;
  float *lamT, *mod, *xctx, *E, *Ktau;
  u16 *abuf, *UB, *fbuf, *qbuf, *kbuf, *vT, *vTc, *zbuf, *A1, *Gbuf, *ycat, *obuf, *hidden;
};

DEV int g_tid() { int t = threadIdx.x; asm volatile("" : "+v"(t)); return t; }
DEV u16 f2bf(float f) { unsigned u = __float_as_uint(f); u += 0x7fffu + ((u >> 16) & 1u); return (u16)(u >> 16); }
DEV float bf2f(u16 h) { return __uint_as_float(((unsigned)h) << 16); }
DEV unsigned pack2(float a, float b) { return (unsigned)f2bf(a) | ((unsigned)f2bf(b) << 16); }
DEV void store_bf4(u16* p, float a, float b, float c, float d) { uint2 v; v.x = pack2(a, b); v.y = pack2(c, d); *(uint2*)p = v; }
DEV float wave_sum(float v) {
#pragma unroll
  for (int o = 32; o >= 1; o >>= 1) v += __shfl_xor(v, o);
  return v;
}
DEV float hw_sin_rev(float r) { return __builtin_amdgcn_sinf(r); }
DEV float hw_cos_rev(float r) { return __builtin_amdgcn_cosf(r); }

template <int BMODE, class Epi>
DEV void gemm_tile(const u16* A, int lda, const u16* B, int ldb, int K, int n0, int m0, int mmax, char* smem,
                   const Epi& epi) {
  const int tid = g_tid(), lane = tid & 63, w = tid >> 6;
  const int wn = w & 1, wm = w >> 1;
  f32x16 acc[2][2];
#pragma unroll
  for (int i = 0; i < 2; ++i)
#pragma unroll
    for (int j = 0; j < 2; ++j)
#pragma unroll
      for (int r = 0; r < 16; ++r) acc[i][j][r] = 0.f;
  uint4 ra[4], rb[4];
  auto gload = [&](int k0) {
#pragma unroll
    for (int i = 0; i < 4; ++i) {
      int id = tid + 256 * i;
      int r = id >> 3, ch = id & 7;
      ra[i] = *(const uint4*)(A + (size_t)(n0 + r) * lda + k0 + ch * 8);
      if (BMODE == 0) {
        int m = m0 + r;
        m = m < mmax ? m : mmax - 1;
        rb[i] = *(const uint4*)(B + (size_t)m * ldb + k0 + ch * 8);
      } else if (BMODE == 2) {
        int k = k0 + ch * 8;
        rb[i] = *(const uint4*)(B + ((size_t)(k >> 4) * MR + (m0 + r)) * 16 + (k & 15));
      } else {
        int kk = id >> 4, nch = id & 15;
        rb[i] = *(const uint4*)(B + (size_t)(k0 + kk) * ldb + m0 + nch * 8);
      }
    }
  };
  auto sstore = [&](int buf) {
    char* sa = smem + buf * 32768;
    char* sb = sa + 16384;
#pragma unroll
    for (int i = 0; i < 4; ++i) {
      int id = tid + 256 * i;
      int r = id >> 3, ch = id & 7;
      *(uint4*)(sa + r * 128 + ((ch ^ (r & 7)) << 4)) = ra[i];
      if (BMODE != 1) {
        *(uint4*)(sb + r * 128 + ((ch ^ (r & 7)) << 4)) = rb[i];
      } else {
        int kk = id >> 4, nch = id & 15;
#pragma unroll
        for (int e = 0; e < 8; ++e) {
          unsigned wd = (e >> 1) == 0 ? rb[i].x : (e >> 1) == 1 ? rb[i].y : (e >> 1) == 2 ? rb[i].z : rb[i].w;
          u16 v = (u16)((e & 1) ? (wd >> 16) : (wd & 0xffffu));
          int n = nch * 8 + e;
          *(u16*)(sb + n * 128 + ((((kk >> 3) ^ (n & 7)) << 4) + (kk & 7) * 2)) = v;
        }
      }
    }
  };
  const int nk = K >> 6;
  gload(0);
  sstore(0);
  __syncthreads();
  for (int kt = 0; kt < nk; ++kt) {
    if (kt + 1 < nk) gload((kt + 1) << 6);
    const char* sa = smem + (kt & 1) * 32768;
    const char* sb = sa + 16384;
#pragma unroll
    for (int ks = 0; ks < 4; ++ks) {
      bf16x8 af[2], bfr[2];
      const int ch = ks * 2 + (lane >> 5);
#pragma unroll
      for (int i = 0; i < 2; ++i) {
        int row = wn * 64 + i * 32 + (lane & 31);
        af[i] = *(const bf16x8*)(sa + row * 128 + ((ch ^ (row & 7)) << 4));
      }
#pragma unroll
      for (int j = 0; j < 2; ++j) {
        int row = wm * 64 + j * 32 + (lane & 31);
        bfr[j] = *(const bf16x8*)(sb + row * 128 + ((ch ^ (row & 7)) << 4));
      }
#pragma unroll
      for (int i = 0; i < 2; ++i)
#pragma unroll
        for (int j = 0; j < 2; ++j)
          acc[i][j] = __builtin_amdgcn_mfma_f32_32x32x16_bf16(af[i], bfr[j], acc[i][j], 0, 0, 0);
    }
    if (kt + 1 < nk) sstore((kt + 1) & 1);
    __syncthreads();
  }
  epi(acc, n0 + wn * 64, m0 + wm * 64, lane);
}

template <class F>
DEV void for_quads(f32x16 (&acc)[2][2], int nW, int mW, int lane, F f) {
#pragma unroll
  for (int i = 0; i < 2; ++i)
#pragma unroll
    for (int j = 0; j < 2; ++j)
#pragma unroll
      for (int q = 0; q < 4; ++q) {
        int nf = nW + i * 32 + 8 * q + 4 * (lane >> 5);
        int m = mW + j * 32 + (lane & 31);
        f(nf, m, acc[i][j][4 * q], acc[i][j][4 * q + 1], acc[i][j][4 * q + 2], acc[i][j][4 * q + 3]);
      }
}

struct EpiInproj {
  const Params& P;
  DEV void operator()(f32x16 (&acc)[2][2], int nW, int mW, int lane) const {
    const int hi = lane >> 5;
#pragma unroll
    for (int i = 0; i < 2; ++i) {
      const int nt = nW + i * 32;
#pragma unroll
      for (int j = 0; j < 2; ++j) {
        const int m = mW + j * 32 + (lane & 31);
        f32x16 a = acc[i][j];
        if (nt < 384) {
#pragma unroll
          for (int q = 0; q < 4; ++q) {
            int nf = nt + 8 * q + 4 * hi;
            int g = nf >> 4, h = nf & 15;
            u16* dst = P.UB + ((size_t)(g * NCH + (m >> 5))) * 768 + (m & 31) * 16 + h;
            store_bf4(dst, a[4 * q], a[4 * q + 1], a[4 * q + 2], a[4 * q + 3]);
          }
        } else if (nt < 640) {
#pragma unroll
          for (int q = 0; q < 4; ++q) {
            int nf = nt + 8 * q + 4 * hi - 384;
            store_bf4(P.fbuf + (size_t)m * 256 + nf, a[4 * q], a[4 * q + 1], a[4 * q + 2], a[4 * q + 3]);
          }
        } else if (nt < 1408) {
          const bool isq = nt < 1024;
          const int off = nt - (isq ? 640 : 1024);
          if (m < NLAT) {
            const int l = m & (SEQ - 1);
            const float pos = (off & 32) ? (float)(l & 63) : (float)(l >> 6);
#pragma unroll
            for (int e = 0; e < 8; ++e) {
              int fl = 8 * (e >> 2) + 4 * hi + (e & 3);
              float freq = exp2f(-(float)fl * (13.287712379549449f / 16.f));
              float rev = pos * freq * 0.15915494309189535f;
              float sn = hw_sin_rev(rev), cs = hw_cos_rev(rev);
              float x1 = a[e], x2 = a[e + 8];
              a[e] = x1 * cs - x2 * sn;
              a[e + 8] = x2 * cs + x1 * sn;
            }
          }
          const float sc = isq ? 0.125f : 1.f;
          u16* base = (isq ? P.qbuf : P.kbuf) + (size_t)m * 384 + off;
#pragma unroll
          for (int q = 0; q < 4; ++q)
            store_bf4(base + 8 * q + 4 * hi, a[4 * q] * sc, a[4 * q + 1] * sc, a[4 * q + 2] * sc, a[4 * q + 3] * sc);
        } else {
#pragma unroll
          for (int r = 0; r < 16; ++r) {
            int feat = nt - 1408 + (r & 3) + 8 * (r >> 2) + 4 * hi;
            if (m < NLAT)
              P.vT[((size_t)((m >> 13) * 384 + feat)) * SEQ + (m & (SEQ - 1))] = f2bf(a[r]);
            else
              P.vTc[((size_t)(((m - NLAT) >> 8) * 384 + feat)) * LCX + ((m - NLAT) & 255)] = f2bf(a[r]);
          }
        }
      }
    }
  }
};

struct EpiSsmEnd {
  float* Eg;
  DEV void operator()(f32x16 (&acc)[2][2], int nW, int mW, int lane) const {
    for_quads(acc, nW, mW, lane, [&](int nf, int m, float a, float b, float c, float d) {
      if (m < NCH) *(float4*)(Eg + (size_t)m * 256 + nf) = make_float4(a, b, c, d);
    });
  }
};

DEV float gelu_tanh(float x) {
  float u = 0.7978845608028654f * (x + 0.044715f * x * x * x);
  float t = 1.f - 2.f / (1.f + __expf(2.f * u));
  return 0.5f * x * (1.f + t);
}

struct EpiSsmOut {
  u16* zb;
  int g;
  DEV void operator()(f32x16 (&acc)[2][2], int nW, int mW, int lane) const {
    for_quads(acc, nW, mW, lane, [&](int nf, int m, float a, float b, float c, float d) {
      if (m < NCH) {
        int t = nf >> 4, h = nf & 15;
        store_bf4(zb + ((size_t)g * MR + m * TCH + t) * 16 + h, gelu_tanh(a), gelu_tanh(b), gelu_tanh(c),
                  gelu_tanh(d));
      }
    });
  }
};

struct EpiGlu {
  const u16* zb;
  u16* yc;
  DEV void operator()(f32x16 (&acc)[2][2], int nW, int mW, int lane) const {
    for_quads(acc, nW, mW, lane, [&](int nf, int m, float a, float b, float c, float d) {
      uint2 zz = *(const uint2*)(zb + ((size_t)(nf >> 4) * MR + m) * 16 + (nf & 15));
      float z0 = bf2f((u16)(zz.x & 0xffff)), z1 = bf2f((u16)(zz.x >> 16));
      float z2 = bf2f((u16)(zz.y & 0xffff)), z3 = bf2f((u16)(zz.y >> 16));
      store_bf4(yc + (size_t)m * 1024 + nf, z0 / (1.f + __expf(-a)), z1 / (1.f + __expf(-b)), z2 / (1.f + __expf(-c)),
                z3 / (1.f + __expf(-d)));
    });
  }
};

struct EpiFnetA {
  u16* A1b;
  DEV void operator()(f32x16 (&acc)[2][2], int nW, int mW, int lane) const {
    for_quads(acc, nW, mW, lane, [&](int nf, int m, float a, float b, float c, float d) {
      int k1 = nf >> 1;
      int cc = m >> 8, j = m & 255;
      u16* p = A1b + ((size_t)(k1 * 128 + cc * 2)) * 256 + j;
      p[0] = f2bf(a);
      p[256] = f2bf(b);
      p[128 * 256] = f2bf(c);
      p[128 * 256 + 256] = f2bf(d);
    });
  }
};

struct EpiFnetCtx {
  u16* Gb;
  DEV void operator()(f32x16 (&acc)[2][2], int nW, int mW, int lane) const {
    for_quads(acc, nW, mW, lane, [&](int nf, int m, float a, float b, float c, float d) {
      int k = nf >> 1;
      const float s = 1.f / 128.f;
      u16* p = Gb + (size_t)k * 512 + m;
      p[0] = f2bf(a * s);
      p[256] = f2bf(b * s);
      p[512] = f2bf(c * s);
      p[512 + 256] = f2bf(d * s);
    });
  }
};

struct EpiFnetC {
  u16* Gb;
  DEV void operator()(f32x16 (&acc)[2][2], int nW, int mW, int lane) const {
    for_quads(acc, nW, mW, lane, [&](int nf, int m, float a, float b, float c, float d) {
      int k2 = nf >> 1;
      const float s = 0.0013810679320049757f;
      u16* p = Gb + (size_t)k2 * 128 * 512 + m;
      p[0] = f2bf(a * s);
      p[256] = f2bf(b * s);
      p[128 * 512] = f2bf(c * s);
      p[128 * 512 + 256] = f2bf(d * s);
    });
  }
};

struct EpiStoreBf {
  u16* dst;
  int ld, coff;
  DEV void operator()(f32x16 (&acc)[2][2], int nW, int mW, int lane) const {
    for_quads(acc, nW, mW, lane, [&](int nf, int m, float a, float b, float c, float d) {
      store_bf4(dst + (size_t)m * ld + coff + nf, a, b, c, d);
    });
  }
};

struct EpiGateUp {
  u16* hid;
  DEV void operator()(f32x16 (&acc)[2][2], int nW, int mW, int lane) const {
    const int hi = lane >> 5;
#pragma unroll
    for (int j = 0; j < 2; ++j) {
      const int m = mW + j * 32 + (lane & 31);
#pragma unroll
      for (int q = 0; q < 4; ++q) {
        float o[4];
#pragma unroll
        for (int e = 0; e < 4; ++e) {
          float g = acc[0][j][4 * q + e], u = acc[1][j][4 * q + e];
          o[e] = g / (1.f + __expf(-g)) * u;
        }
        int col = (nW >> 6) * 32 + 8 * q + 4 * hi;
        store_bf4(hid + (size_t)m * DFF + col, o[0], o[1], o[2], o[3]);
      }
    }
  }
};

DEV void transpose_tile(const float* src, int K, int N, u16* dst, int mode, int kt, int nt, char* smem) {
  float* s = (float*)smem;
  const int tid = g_tid();
  const int k0 = kt * 64, n0 = nt * 64;
#pragma unroll
  for (int i = 0; i < 4; ++i) {
    int id = tid + 256 * i;
    int kk = id >> 4, c4 = id & 15;
    float4 v = *(const float4*)(src + (size_t)(k0 + kk) * N + n0 + c4 * 4);
    s[kk * 65 + c4 * 4 + 0] = v.x;
    s[kk * 65 + c4 * 4 + 1] = v.y;
    s[kk * 65 + c4 * 4 + 2] = v.z;
    s[kk * 65 + c4 * 4 + 3] = v.w;
  }
  __syncthreads();
#pragma unroll
  for (int i = 0; i < 2; ++i) {
    int id = tid + 256 * i;
    int nn = id >> 3, kc = id & 7;
    int n = n0 + nn;
    int row = mode == 0 ? n : (64 * (n >> 5) + (n & 31) + (mode == 2 ? 32 : 0));
    uint4 o;
    o.x = pack2(s[(kc * 8 + 0) * 65 + nn], s[(kc * 8 + 1) * 65 + nn]);
    o.y = pack2(s[(kc * 8 + 2) * 65 + nn], s[(kc * 8 + 3) * 65 + nn]);
    o.z = pack2(s[(kc * 8 + 4) * 65 + nn], s[(kc * 8 + 5) * 65 + nn]);
    o.w = pack2(s[(kc * 8 + 6) * 65 + nn], s[(kc * 8 + 7) * 65 + nn]);
    *(uint4*)(dst + (size_t)row * K + k0 + kc * 8) = o;
  }
  __syncthreads();
}

DEV void lam_pow(float are, float aim, float dt, int n, float& pr, float& pi) {
  float mag = expf((float)n * are * dt);
  double rev = (double)n * (double)aim * (double)dt * 0.15915494309189535;
  rev -= rint(rev);
  float fr = (float)rev;
  pr = mag * hw_cos_rev(fr);
  pi = mag * hw_sin_rev(fr);
}
DEV void zoh_factor(float are, float aim, float dt, float& fr, float& fi) {
  float lr, li;
  lam_pow(are, aim, dt, 1, lr, li);
  float nr = lr - 1.f, ni = li;
  float d2 = are * are + aim * aim;
  fr = (nr * are + ni * aim) / d2;
  fi = (ni * are - nr * aim) / d2;
}

constexpr int PREP_TR = 2852;
constexpr int PREP_KF = 24 * 63;
constexpr int PREP_WC = 24 * 2 * 32;
constexpr int PREP_WE = 24 * 2 * 8;
constexpr int PREP_MW = 64;
constexpr int PREP_N = PREP_TR + PREP_KF + PREP_WC + PREP_WE + PREP_MW;
constexpr int EXPAND_N = 24 * 32;

DEV void prep_job(const Params& P, int layer, int job, char* smem) {
  const int tid = g_tid();
  if (job < PREP_TR) {
    int j = job;
    if (j < 448) { transpose_tile(P.w_in + (size_t)layer * DM * INW, DM, INW, P.wt_in, 0, j / 28, j % 28, smem); return; }
    j -= 448;
    if (j < 256) { transpose_tile(P.w_out + (size_t)layer * DM * DM, DM, DM, P.wt_out, 0, j / 16, j % 16, smem); return; }
    j -= 256;
    if (j < 36) { transpose_tile(P.w_glu + (size_t)layer * 384 * 384, 384, 384, P.wt_glu, 0, j / 6, j % 6, smem); return; }
    j -= 36;
    if (j < 704) { transpose_tile(P.w_gate + (size_t)layer * DM * DFF, DM, DFF, P.wt_gu, 1, j / 44, j % 44, smem); return; }
    j -= 704;
    if (j < 704) { transpose_tile(P.w_up + (size_t)layer * DM * DFF, DM, DFF, P.wt_gu, 2, j / 44, j % 44, smem); return; }
    j -= 704;
    transpose_tile(P.w_down + (size_t)layer * DFF * DM, DFF, DM, P.wt_dn, 0, j / 16, j % 16, smem);
    return;
  }
  job -= PREP_TR;
  float* sf = (float*)smem;
  if (job < PREP_KF) {
    const int g = job / 63, delta = job % 63 - 31;
    const int ad = delta < 0 ? -delta : delta;
    float* sQ = sf;
    float* sCQ = sf + 256;
    if (tid < 128) {
      int dir = tid >> 6, p = tid & 63;
      int ix = ((layer * 2 + dir) * 24 + g) * 64 + p;
      float are = P.a_re[ix], aim = P.a_im[ix], dt = expf(P.log_dt[(layer * 2 + dir) * 24 + g]);
      float pr, pi, fr, fi;
      lam_pow(are, aim, dt, ad, pr, pi);
      zoh_factor(are, aim, dt, fr, fi);
      sQ[(dir * 64 + p) * 2 + 0] = pr * fr - pi * fi;
      sQ[(dir * 64 + p) * 2 + 1] = pr * fi + pi * fr;
    }
    __syncthreads();
#pragma unroll
    for (int i = 0; i < 8; ++i) {
      int e = tid + 256 * i;
      int dir = e >> 10, h = (e >> 6) & 15, p = e & 63;
      size_t ci = ((size_t)(((layer * 2 + dir) * 24 + g) * 16 + h)) * 64 + p;
      float cr = P.c_re[ci], cim = P.c_im[ci];
      float qr = sQ[(dir * 64 + p) * 2], qi = sQ[(dir * 64 + p) * 2 + 1];
      sCQ[e * 2 + 0] = cr * qr - cim * qi;
      sCQ[e * 2 + 1] = cr * qi + cim * qr;
    }
    __syncthreads();
    const int h = tid >> 4, hp = tid & 15;
    float val = 0.f;
#pragma unroll
    for (int dir = 0; dir < 2; ++dir) {
      bool need = dir == 0 ? (delta >= 0) : (delta <= 0);
      if (need) {
        const float* br = P.b_re + ((size_t)(((layer * 2 + dir) * 24 + g) * 64)) * 16 + hp;
        const float* bi = P.b_im + ((size_t)(((layer * 2 + dir) * 24 + g) * 64)) * 16 + hp;
        const float* cq = sCQ + ((dir * 16 + h) * 64) * 2;
        for (int p = 0; p < 64; ++p) val += cq[p * 2] * br[p * 16] - cq[p * 2 + 1] * bi[p * 16];
      }
    }
    if (delta == 0 && h == hp) val += P.ssm_d[layer * 384 + g * 16 + h];
    P.Ktau[(size_t)job * 256 + tid] = val;
    __syncthreads();
    return;
  }
  job -= PREP_KF;
  if (job < PREP_WC) {
    const int j = job & 31, dir = (job >> 5) & 1, g = job >> 6;
    float* sP = sf;
    if (tid < 64) {
      int p = tid;
      int ix = ((layer * 2 + dir) * 24 + g) * 64 + p;
      float are = P.a_re[ix], aim = P.a_im[ix], dt = expf(P.log_dt[(layer * 2 + dir) * 24 + g]);
      float pr, pi;
      lam_pow(are, aim, dt, dir == 0 ? j + 1 : 32 - j, pr, pi);
      sP[p * 2] = pr;
      sP[p * 2 + 1] = pi;
      if (j == 0) {
        float tr, ti;
        lam_pow(are, aim, dt, 32, tr, ti);
        P.lamT[((dir * 24 + g) * 64 + p) * 2] = tr;
        P.lamT[((dir * 24 + g) * 64 + p) * 2 + 1] = ti;
      }
    }
    __syncthreads();
#pragma unroll
    for (int i = 0; i < 8; ++i) {
      int e = tid + 256 * i;
      int h = e >> 7, pc = e & 127, p = pc >> 1, ri = pc & 1;
      size_t ci = ((size_t)(((layer * 2 + dir) * 24 + g) * 16 + h)) * 64 + p;
      float cr = P.c_re[ci], cim = P.c_im[ci];
      float pr = sP[p * 2], pi = sP[p * 2 + 1];
      float v = ri == 0 ? (cr * pr - cim * pi) : -(cr * pi + cim * pr);
      P.A_out[((size_t)(g * 512 + j * 16 + h)) * 768 + 512 + dir * 128 + pc] = f2bf(v);
    }
    __syncthreads();
    return;
  }
  job -= PREP_WC;
  if (job < PREP_WE) {
    const int jq = job & 7, dir = (job >> 3) & 1, g = job >> 4;
    float* sP = sf;
    {
      int jj = tid >> 6, p = tid & 63;
      int j = jq * 4 + jj;
      int ix = ((layer * 2 + dir) * 24 + g) * 64 + p;
      float are = P.a_re[ix], aim = P.a_im[ix], dt = expf(P.log_dt[(layer * 2 + dir) * 24 + g]);
      float pr, pi, fr, fi;
      lam_pow(are, aim, dt, dir == 0 ? 31 - j : j, pr, pi);
      zoh_factor(are, aim, dt, fr, fi);
      sP[(jj * 64 + p) * 2] = pr * fr - pi * fi;
      sP[(jj * 64 + p) * 2 + 1] = pr * fi + pi * fr;
    }
    __syncthreads();
    {
      const int prow = tid >> 1, half = tid & 1, p = prow >> 1, ri = prow & 1;
      const size_t bbase = ((size_t)(((layer * 2 + dir) * 24 + g) * 64 + p)) * 16;
      u16* dst = P.A_end + ((size_t)(g * 256 + dir * 128 + prow)) * 512 + jq * 64 + half * 32;
#pragma unroll
      for (int q = 0; q < 2; ++q) {
        int jj = half * 2 + q;
        float pr = sP[(jj * 64 + p) * 2], pi = sP[(jj * 64 + p) * 2 + 1];
        unsigned pk[8];
#pragma unroll
        for (int h2 = 0; h2 < 8; ++h2) {
          float b0r = P.b_re[bbase + 2 * h2], b0i = P.b_im[bbase + 2 * h2];
          float b1r = P.b_re[bbase + 2 * h2 + 1], b1i = P.b_im[bbase + 2 * h2 + 1];
          float v0 = ri == 0 ? (pr * b0r - pi * b0i) : (pr * b0i + pi * b0r);
          float v1 = ri == 0 ? (pr * b1r - pi * b1i) : (pr * b1i + pi * b1r);
          pk[h2] = pack2(v0, v1);
        }
        *(uint4*)(dst + q * 16) = make_uint4(pk[0], pk[1], pk[2], pk[3]);
        *(uint4*)(dst + q * 16 + 8) = make_uint4(pk[4], pk[5], pk[6], pk[7]);
      }
    }
    __syncthreads();
    return;
  }
  job -= PREP_WE;
  {
    const int nb = job & 7, g = (job >> 3) & 3, ri = job >> 5;
    const float* wf = P.w_fourier + (size_t)layer * 256 * 256;
    const int n = nb * 32 + (tid >> 3), jg = tid & 7;
    unsigned pk[4];
#pragma unroll
    for (int jp = 0; jp < 4; ++jp) {
      float sum2[2];
#pragma unroll
      for (int q = 0; q < 2; ++q) {
        int j = jg * 8 + jp * 2 + q;
        float sum = 0.f;
        for (int m = 0; m < 64; ++m) {
          float fr = (float)((m * j) & 63) * (1.f / 64.f);
          float tr = ri ? hw_sin_rev(fr) : hw_cos_rev(fr);
          sum += tr * wf[(size_t)(g * 64 + m) * 256 + n];
        }
        sum2[q] = sum;
      }
      pk[jp] = pack2(sum2[0], sum2[1]);
    }
    *(uint4*)(P.MWt + (size_t)n * 512 + ri * 256 + g * 64 + jg * 8) = make_uint4(pk[0], pk[1], pk[2], pk[3]);
  }
}

DEV void expand_job(const Params& P, int job) {
  const int tid = g_tid();
  const int g = job >> 5, t = job & 31;
  const int h = tid >> 4, cgp = tid & 15;
  u16* dst = P.A_out + ((size_t)(g * 512 + t * 16 + h)) * 768 + cgp * 32;
#pragma unroll
  for (int q = 0; q < 2; ++q) {
    int sidx = cgp * 2 + q;
    int dI = t - sidx + 31;
    const float4* src = (const float4*)(P.Ktau + ((size_t)(g * 63 + dI)) * 256 + h * 16);
    float4 a = src[0], b = src[1], c = src[2], d = src[3];
    *(uint4*)(dst + q * 16) = make_uint4(pack2(a.x, a.y), pack2(a.z, a.w), pack2(b.x, b.y), pack2(b.z, b.w));
    *(uint4*)(dst + q * 16 + 8) = make_uint4(pack2(c.x, c.y), pack2(c.z, c.w), pack2(d.x, d.y), pack2(d.z, d.w));
  }
}

constexpr int CONST_MOD = 384, CONST_D128 = 16, CONST_D256 = 64, CONST_T = 1024;
constexpr int CONST_N = CONST_MOD + CONST_D128 + CONST_D256 + CONST_T;

DEV void const_job(const Params& P, int job, char* smem) {
  const int tid = g_tid();
  if (job < CONST_MOD) {
    const int layer = job / 192, cb = job % 192;
    float* sv = (float*)smem;
    float* red = sv + 3 * 1024;
    for (int i = tid; i < 3 * 1024; i += 256) {
      int v = i >> 10, k = i & 1023;
      float cv = v < 2 ? P.c[v * 1024 + k] : P.c_ctx[k];
      sv[i] = cv / (1.f + __expf(-cv));
    }
    __syncthreads();
    const int kg = tid >> 5, cl = tid & 31;
    const int n = cb * 32 + cl;
    const float* W = P.w_mod + (size_t)layer * DM * 6144 + n;
    float a0 = 0.f, a1 = 0.f, a2 = 0.f;
#pragma unroll 8
    for (int k = kg * 128; k < kg * 128 + 128; ++k) {
      float wv = W[(size_t)k * 6144];
      a0 += sv[k] * wv;
      a1 += sv[1024 + k] * wv;
      a2 += sv[2048 + k] * wv;
    }
    red[(kg * 3 + 0) * 32 + cl] = a0;
    red[(kg * 3 + 1) * 32 + cl] = a1;
    red[(kg * 3 + 2) * 32 + cl] = a2;
    __syncthreads();
    if (tid < 96) {
      int v = tid >> 5, c2 = tid & 31;
      float s = P.b_mod[layer * 6144 + cb * 32 + c2];
      for (int q = 0; q < 8; ++q) s += red[(q * 3 + v) * 32 + c2];
      P.mod[(layer * 3 + v) * 6144 + cb * 32 + c2] = s;
    }
    __syncthreads();
    return;
  }
  job -= CONST_MOD;
  if (job < CONST_D128) {
#pragma unroll
    for (int i = 0; i < 8; ++i) {
      int idx = job * 2048 + tid + 256 * i;
      int row = idx >> 7, r = idx & 127;
      int k1 = row >> 1, ri = row & 1;
      float fr = (float)((k1 * r) & 127) * (1.f / 128.f);
      P.D128[idx] = f2bf(ri ? -hw_sin_rev(fr) : hw_cos_rev(fr));
    }
    return;
  }
  job -= CONST_D128;
  if (job < CONST_D256) {
#pragma unroll
    for (int i = 0; i < 8; ++i) {
      int idx = job * 2048 + tid + 256 * i;
      int row = idx >> 8, l = idx & 255;
      int k = row >> 1, ri = row & 1;
      float fr = (float)((k * l) & 255) * (1.f / 256.f);
      P.D256[idx] = f2bf(ri ? -hw_sin_rev(fr) : hw_cos_rev(fr));
    }
    return;
  }
  job -= CONST_D256;
  {
#pragma unroll
    for (int i = 0; i < 8; ++i) {
      int idx = job * 2048 + tid + 256 * i;
      int k1 = idx >> 14, row = (idx >> 7) & 127, col = idx & 127;
      int k2 = row >> 1, ri = row & 1, cc = col >> 1, rj = col & 1;
      float fr = (float)((cc * (k1 + 128 * k2)) & 8191) * (1.f / 8192.f);
      float cs = hw_cos_rev(fr), sn = hw_sin_rev(fr);
      float v = (ri == rj) ? cs : (ri == 0 ? sn : -sn);
      P.Tmat[idx] = f2bf(v);
    }
  }
}

DEV float4 ld4(const float* p) { return *(const float4*)p; }
DEV float4 ldbf4(const u16* p) {
  uint2 v = *(const uint2*)p;
  return make_float4(bf2f((u16)(v.x & 0xffff)), bf2f((u16)(v.x >> 16)), bf2f((u16)(v.y & 0xffff)), bf2f((u16)(v.y >> 16)));
}
DEV float sq4(float4 v) { return v.x * v.x + v.y * v.y + v.z * v.z + v.w * v.w; }

DEV void rowop(const Params& P, int kind, int layer, int m, int lane) {
  const bool last = layer == 1;
  if (kind == 2 && last && m >= NLAT) return;
  const int mi = m < NLAT ? (m >> 13) : 2;
  float* resid = m < NLAT ? P.out + (size_t)m * DM : P.xctx + (size_t)(m - NLAT) * DM;
  const float* xin;
  if (kind == 0 || (kind == 1 && layer == 0))
    xin = m < NLAT ? P.x + (size_t)m * DM : P.ctx + (size_t)(m - NLAT) * DM;
  else
    xin = resid;
  const float* modv = P.mod + (size_t)(layer * 3 + mi) * 6144;
  float4 v[4];
#pragma unroll
  for (int i = 0; i < 4; ++i) v[i] = ld4(xin + i * 256 + lane * 4);
  if (kind != 0) {
    const float* gpost = (kind == 1 ? P.g_post_mix : P.g_post_ffn) + layer * DM;
    const float* gate = modv + (kind == 1 ? 2048 : 5120);
    float4 o[4];
    float ss = 0.f;
#pragma unroll
    for (int i = 0; i < 4; ++i) {
      o[i] = ldbf4(P.obuf + (size_t)m * DM + i * 256 + lane * 4);
      ss += sq4(o[i]);
    }
    ss = wave_sum(ss);
    float rinv = rsqrtf(ss * (1.f / DM) + EPS);
#pragma unroll
    for (int i = 0; i < 4; ++i) {
      float4 gp = ld4(gpost + i * 256 + lane * 4), gt = ld4(gate + i * 256 + lane * 4);
      v[i].x += gt.x * (o[i].x * rinv * gp.x);
      v[i].y += gt.y * (o[i].y * rinv * gp.y);
      v[i].z += gt.z * (o[i].z * rinv * gp.z);
      v[i].w += gt.w * (o[i].w * rinv * gp.w);
    }
    if (kind == 2 && last) {
#pragma unroll
      for (int i = 0; i < 4; ++i) *(float4*)(P.out + (size_t)m * DM + i * 256 + lane * 4) = v[i];
      return;
    }
#pragma unroll
    for (int i = 0; i < 4; ++i) *(float4*)(resid + i * 256 + lane * 4) = v[i];
  }
  const int la = kind == 2 ? layer + 1 : layer;
  const float* gpre = (kind == 1 ? P.g_pre_ffn : P.g_pre_mix) + la * DM;
  const float* mv = P.mod + (size_t)(la * 3 + mi) * 6144;
  const float* sh = mv + (kind == 1 ? 3072 : 0);
  const float* sc = mv + (kind == 1 ? 4096 : 1024);
  float ss = 0.f;
#pragma unroll
  for (int i = 0; i < 4; ++i) ss += sq4(v[i]);
  ss = wave_sum(ss);
  float rinv = rsqrtf(ss * (1.f / DM) + EPS);
#pragma unroll
  for (int i = 0; i < 4; ++i) {
    int col = i * 256 + lane * 4;
    float4 gp = ld4(gpre + col), s1 = ld4(sc + col), s0 = ld4(sh + col);
    store_bf4(P.abuf + (size_t)m * DM + col, v[i].x * rinv * gp.x * (1.f + s1.x) + s0.x,
              v[i].y * rinv * gp.y * (1.f + s1.y) + s0.y, v[i].z * rinv * gp.z * (1.f + s1.z) + s0.z,
              v[i].w * rinv * gp.w * (1.f + s1.w) + s0.w);
  }
}

DEV void attn_wave(const Params& P, int layer, bool isctx, int b, int h, int r, int cgp, int lane) {
  const int qi = lane & 15, g = lane >> 4;
  int mq, c = 0, cs = 0, cb = 0, rs = 0;
  if (!isctx) {
    c = cgp * 16 + qi;
    mq = b * SEQ + r * 64 + c;
    cs = c - 8;
    cs = cs < 0 ? 0 : (cs > 48 ? 48 : cs);
    cb = cgp == 0 ? 0 : (cgp == 1 ? 8 : (cgp == 2 ? 24 : 32));
    rs = r - 4;
    rs = rs < 0 ? 0 : (rs > 120 ? 120 : rs);
  } else {
    mq = NLAT + b * LCX + cgp * 16 + qi;
  }
  const u16* qp = P.qbuf + (size_t)mq * 384 + h * 64 + g * 8;
  const bf16x8 qf0 = *(const bf16x8*)qp, qf1 = *(const bf16x8*)(qp + 32);
  f32x4 o[4];
#pragma unroll
  for (int d = 0; d < 4; ++d) o[d] = f32x4{0.f, 0.f, 0.f, 0.f};
  float mrun = -1e30f, lrun = 0.f;
  const float* rp = P.rpb + (size_t)(layer * 6 + h) * 465;
  const int nblk = isctx ? 8 : 16;
  for (int kb = 0; kb < nblk; ++kb) {
    const bool win = (!isctx) && kb < 8;
    size_t krow0;
    const u16* vbase;
    int vld;
    if (win) {
      int tok0 = (rs + kb) * 64 + cb;
      krow0 = (size_t)b * SEQ + tok0;
      vbase = P.vT + ((size_t)(b * 384 + h * 64)) * SEQ + tok0;
      vld = SEQ;
    } else {
      int kc = (isctx ? kb : kb - 8) * 32;
      krow0 = (size_t)NLAT + b * LCX + kc;
      vbase = P.vTc + ((size_t)(b * 384 + h * 64)) * LCX + kc;
      vld = LCX;
    }
    f32x4 s[2];
#pragma unroll
    for (int t = 0; t < 2; ++t) {
      const u16* kp = P.kbuf + (krow0 + t * 16 + qi) * 384 + h * 64 + g * 8;
      bf16x8 k0 = *(const bf16x8*)kp, k1 = *(const bf16x8*)(kp + 32);
      f32x4 z = {0.f, 0.f, 0.f, 0.f};
      z = __builtin_amdgcn_mfma_f32_16x16x32_bf16(k0, qf0, z, 0, 0, 0);
      s[t] = __builtin_amdgcn_mfma_f32_16x16x32_bf16(k1, qf1, z, 0, 0, 0);
    }
    if (win) {
      const int dr = rs + kb - r + 7;
#pragma unroll
      for (int t = 0; t < 2; ++t)
#pragma unroll
        for (int i = 0; i < 4; ++i) {
          int keycol = cb + t * 16 + g * 4 + i;
          bool valid = keycol >= cs && keycol < cs + 16;
          int dc = keycol - c + 15;
          dc = dc < 0 ? 0 : (dc > 30 ? 30 : dc);
          float bias = rp[dr * 31 + dc];
          s[t][i] = valid ? s[t][i] + bias : -1e30f;
        }
    }
    float mx = fmaxf(fmaxf(fmaxf(s[0][0], s[0][1]), fmaxf(s[0][2], s[0][3])),
                     fmaxf(fmaxf(s[1][0], s[1][1]), fmaxf(s[1][2], s[1][3])));
    mx = fmaxf(mx, __shfl_xor(mx, 16));
    mx = fmaxf(mx, __shfl_xor(mx, 32));
    const float mnew = fmaxf(mrun, mx);
    const float alpha = __expf(mrun - mnew);
    mrun = mnew;
    float p[8], psum = 0.f;
#pragma unroll
    for (int t = 0; t < 2; ++t)
#pragma unroll
      for (int i = 0; i < 4; ++i) {
        p[t * 4 + i] = __expf(s[t][i] - mnew);
        psum += p[t * 4 + i];
      }
    lrun = lrun * alpha + psum;
    bf16x8 pf;
#pragma unroll
    for (int e = 0; e < 8; ++e) pf[e] = (short)f2bf(p[e]);
#pragma unroll
    for (int d = 0; d < 4; ++d) {
      o[d] *= alpha;
      const u16* vp = vbase + (size_t)(d * 16 + qi) * vld + g * 4;
      uint2 v0 = *(const uint2*)vp, v1 = *(const uint2*)(vp + 16);
      union { uint4 u; bf16x8 v; } cv;
      cv.u = make_uint4(v0.x, v0.y, v1.x, v1.y);
      o[d] = __builtin_amdgcn_mfma_f32_16x16x32_bf16(cv.v, pf, o[d], 0, 0, 0);
    }
  }
  float l = lrun + __shfl_xor(lrun, 16);
  l += __shfl_xor(l, 32);
  const float inv = 1.f / l;
#pragma unroll
  for (int d = 0; d < 4; ++d)
    store_bf4(P.ycat + (size_t)mq * DM + 640 + h * 64 + d * 16 + g * 4, o[d][0] * inv, o[d][1] * inv, o[d][2] * inv,
              o[d][3] * inv);
}

DEV void carry_wave(const Params& P, int wjob, int lane) {
  const int pg = wjob & 7;
  int combo = wjob >> 3;
  const int g = combo % 24;
  combo /= 24;
  const int dir = combo & 1, b = combo >> 1;
  const int p = pg * 8 + (lane & 7), seg = lane >> 3;
  const float lr = P.lamT[((dir * 24 + g) * 64 + p) * 2], li = P.lamT[((dir * 24 + g) * 64 + p) * 2 + 1];
  auto chunk_of = [&](int n) {
    if (n < 8) return 512 + b * 8 + (dir ? 7 - n : n);
    int c = n - 8;
    return b * 256 + (dir ? 255 - c : c);
  };
  float2 e[33];
  float cr = 0.f, ci = 0.f;
#pragma unroll
  for (int i = 0; i < 33; ++i) {
    size_t row = (size_t)(g * NCH + chunk_of(seg * 33 + i));
    e[i] = *(const float2*)(P.E + row * 256 + dir * 128 + p * 2);
  }
#pragma unroll
  for (int i = 0; i < 33; ++i) {
    float nr = lr * cr - li * ci + e[i].x, ni = lr * ci + li * cr + e[i].y;
    cr = nr;
    ci = ni;
  }
  float sr = lr, si = li;
#pragma unroll
  for (int k = 0; k < 5; ++k) {
    float t = sr * sr - si * si;
    si = 2.f * sr * si;
    sr = t;
  }
  const float l33r = sr * lr - si * li, l33i = sr * li + si * lr;
  float stR = 0.f, stI = 0.f;
#pragma unroll
  for (int k = 1; k < 8; ++k) {
    int src = (lane - 8) & 63;
    float pr_ = __shfl(stR, src), pi_ = __shfl(stI, src), er = __shfl(cr, src), ei = __shfl(ci, src);
    if (seg == k) {
      stR = l33r * pr_ - l33i * pi_ + er;
      stI = l33r * pi_ + l33i * pr_ + ei;
    }
  }
  cr = stR;
  ci = stI;
#pragma unroll
  for (int i = 0; i < 33; ++i) {
    size_t row = (size_t)(g * NCH + chunk_of(seg * 33 + i));
    *(unsigned*)(P.UB + row * 768 + 512 + dir * 128 + p * 2) = pack2(cr, ci);
    float nr = lr * cr - li * ci + e[i].x, ni = lr * ci + li * cr + e[i].y;
    cr = nr;
    ci = ni;
  }
}

DEV void run_phase(const Params& P, int ph, int bid, int nblk, char* smem) {
  const int lane = g_tid() & 63, w = g_tid() >> 6;
  if (ph == 0) {
    for (int job = bid; job < CONST_N + PREP_N; job += nblk) {
      if (job < CONST_N) const_job(P, job, smem);
      else prep_job(P, 0, job - CONST_N, smem);
    }
    return;
  }
  if (ph == 1) {
    for (int job = bid; job < MR / 4 + EXPAND_N; job += nblk) {
      if (job < MR / 4) rowop(P, 0, 0, job * 4 + w, lane);
      else expand_job(P, job - MR / 4);
    }
    return;
  }
  const int layer = (ph - 2) / 10, sub = (ph - 2) % 10;
  switch (sub) {
    case 0: {
      EpiInproj epi{P};
      const int nexp = layer == 1 ? EXPAND_N : 0;
      for (int job = bid; job < 14 * 132 + nexp; job += nblk) {
        if (job >= 14 * 132) { expand_job(P, job - 14 * 132); continue; }
        int mt = job / 14, nt = job % 14;
        gemm_tile<0>(P.wt_in, DM, P.abuf, DM, DM, nt * 128, mt * 128, MR, smem, epi);
      }
    } break;
    case 1: {
      const int J0 = 1536, J1 = J0 + 48, J2 = J1 + 240, J3 = J2 + 512, J4 = J3 + 16;
      for (int job = bid; job < J4; job += nblk) {
        if (job < J0) {
          int r = job & 127, bh = job >> 7;
          attn_wave(P, layer, false, bh / 6, bh % 6, r, w, lane);
        } else if (job < J1) {
          int j = job - J0;
          int qb = j & 3, bh = j >> 2;
          attn_wave(P, layer, true, bh / 6, bh % 6, 0, qb * 4 + w, lane);
        } else if (job < J2) {
          int j = job - J1;
          int g = j / 10, t = j % 10;
          EpiSsmEnd epi{P.E + (size_t)g * NCH * 256};
          gemm_tile<0>(P.A_end + (size_t)g * 256 * 512, 512, P.UB + (size_t)g * NCH * 768, 768, 512, (t & 1) * 128,
                           (t >> 1) * 128, NCH, smem, epi);
        } else if (job < J3) {
          int j = job - J2;
          int b = j >> 8, t = j & 255;
          EpiFnetA epi{P.A1 + (size_t)b * 128 * 128 * 256};
          gemm_tile<1>(P.D128, 128, P.fbuf + (size_t)b * SEQ * 256, 64 * 256, 128, (t & 1) * 128, (t >> 1) * 128,
                          64 * 256, smem, epi);
        } else {
          int j = job - J3;
          int b = j >> 3, t = j & 7;
          EpiFnetCtx epi{P.Gbuf + (size_t)(NLAT + b * LCX) * 512};
          gemm_tile<1>(P.D256, 256, P.fbuf + (size_t)(NLAT + b * LCX) * 256, 256, 256, (t & 3) * 128, (t >> 2) * 128,
                          256, smem, epi);
        }
      }
    } break;
    case 2: {
      for (int job = bid; job < 192; job += nblk) carry_wave(P, job * 4 + w, lane);
    } break;
    case 3: {
      for (int job = bid; job < 480 + 512; job += nblk) {
        if (job < 480) {
          int g = job / 20, t = job % 20;
          EpiSsmOut epi{P.zbuf, g};
          gemm_tile<0>(P.A_out + (size_t)g * 512 * 768, 768, P.UB + (size_t)g * NCH * 768, 768, 768, (t & 3) * 128,
                       (t >> 2) * 128, NCH, smem, epi);
        } else {
          int j = job - 480;
          int bk = j >> 1, t = j & 1;
          int k1 = bk & 127, b = bk >> 7;
          EpiFnetC epi{P.Gbuf + (size_t)(b * SEQ + k1) * 512};
          gemm_tile<1>(P.Tmat + (size_t)k1 * 128 * 128, 128, P.A1 + (size_t)bk * 128 * 256, 256, 128, 0, t * 128, 256,
                       smem, epi);
        }
      }
    } break;
    case 4: {
      for (int job = bid; job < 396 + 264; job += nblk) {
        if (job < 396) {
          EpiGlu epi{P.zbuf, P.ycat};
          gemm_tile<2>(P.wt_glu, 384, P.zbuf, 384, 384, (job % 3) * 128, (job / 3) * 128, MR, smem, epi);
        } else {
          int j = job - 396;
          EpiStoreBf epi{P.ycat, DM, 384};
          gemm_tile<0>(P.MWt, 512, P.Gbuf, 512, 512, (j & 1) * 128, (j >> 1) * 128, MR, smem, epi);
        }
      }
    } break;
    case 5: {
      EpiStoreBf epi{P.obuf, DM, 0};
      for (int job = bid; job < 8 * 132; job += nblk)
        gemm_tile<0>(P.wt_out, DM, P.ycat, DM, DM, (job & 7) * 128, (job >> 3) * 128, MR, smem, epi);
    } break;
    case 6: {
      for (int job = bid; job < MR / 4; job += nblk) rowop(P, 1, layer, job * 4 + w, lane);
    } break;
    case 7: {
      EpiGateUp epi{P.hidden};
      for (int job = bid; job < 44 * 132; job += nblk)
        gemm_tile<0>(P.wt_gu, DM, P.abuf, DM, DM, (job % 44) * 128, (job / 44) * 128, MR, smem, epi);
    } break;
    case 8: {
      EpiStoreBf epi{P.obuf, DM, 0};
      for (int job = bid; job < 8 * 132; job += nblk)
        gemm_tile<0>(P.wt_dn, DFF, P.hidden, DFF, DFF, (job & 7) * 128, (job >> 3) * 128, MR, smem, epi);
    } break;
    case 9: {
      const int nrow = MR / 4;
      const int total = nrow + (layer == 0 ? PREP_N : 0);
      for (int job = bid; job < total; job += nblk) {
        if (job < nrow) rowop(P, 2, layer, job * 4 + w, lane);
        else prep_job(P, 1, job - nrow, smem);
      }
    } break;
  }
}

#if MK_MULTI
__global__ void __launch_bounds__(256, 2) phase_kernel(Params P, int ph) {
  __shared__ __attribute__((aligned(16))) char smem[65536];
  run_phase(P, ph, blockIdx.x, gridDim.x, smem);
}
#else
#define XB_XCNT(j) (64 * (j))
#define XB_XSUB(j) (1024 + 64 * (j))
#define XB_XGEN(j) (2048 + 64 * (j))
#define XB_TOP 3072
#define XB_TOPGEN 3136
#define XB_WORDS 3200
DEV unsigned xb_ld(unsigned* p) { return __hip_atomic_load(p, __ATOMIC_RELAXED, __HIP_MEMORY_SCOPE_AGENT); }
DEV unsigned xb_add(unsigned* p, unsigned v) { return __hip_atomic_fetch_add(p, v, __ATOMIC_RELAXED, __HIP_MEMORY_SCOPE_AGENT); }

DEV void grid_barrier(unsigned* bar, unsigned k, unsigned xcc, unsigned nloc, unsigned nx) {
  asm volatile("s_waitcnt vmcnt(0)" ::: "memory");
  __syncthreads();
  if (threadIdx.x == 0) {
    const unsigned old = xb_add(&bar[XB_XSUB(xcc)], 1u);
    if (old + 1u == k * nloc) {
      __builtin_amdgcn_fence(__ATOMIC_RELEASE, "agent");
      asm volatile("s_waitcnt vmcnt(0)" ::: "memory");
      const unsigned og = xb_add(&bar[XB_TOP], 1u);
      if (og + 1u == k * nx) xb_add(&bar[XB_TOPGEN], 1u);
      else
        while (xb_ld(&bar[XB_TOPGEN]) < k) __builtin_amdgcn_s_sleep(4);
      __builtin_amdgcn_fence(__ATOMIC_ACQUIRE, "agent");
      xb_add(&bar[XB_XGEN(xcc)], 1u);
      asm volatile("s_waitcnt vmcnt(0)" ::: "memory");
    } else {
      while (xb_ld(&bar[XB_XGEN(xcc)]) < k) __builtin_amdgcn_s_sleep(8);
      __builtin_amdgcn_fence(__ATOMIC_ACQUIRE, "agent");
      asm volatile("s_waitcnt vmcnt(0)" ::: "memory");
    }
  }
  __syncthreads();
}

__global__ void __launch_bounds__(256) fwd_megakernel(Params P, unsigned* bar) {
  __shared__ __attribute__((aligned(16))) char smem[65536];
  cg::grid_group grid = cg::this_grid();
  const unsigned xcc = (unsigned)__builtin_amdgcn_s_getreg((3 << 11) | 20) & 0xFu;
  if (threadIdx.x == 0) xb_add(&bar[XB_XCNT(xcc)], 1u);
  __threadfence();
  grid.sync();
  unsigned nloc = 0, nx = 0;
#pragma unroll
  for (unsigned j = 0; j < 16; ++j) {
    const unsigned c = xb_ld(&bar[XB_XCNT(j)]);
    nx += c > 0u ? 1u : 0u;
    nloc = j == xcc ? c : nloc;
  }
  nloc = __builtin_amdgcn_readfirstlane(nloc);
  nx = __builtin_amdgcn_readfirstlane(nx);
  for (int ph = 0; ph < NPH; ++ph) {
    int bid = blockIdx.x;
    asm volatile("" : "+s"(bid));
    run_phase(P, ph, bid, gridDim.x, smem);
    if (ph + 1 < NPH) grid_barrier(bar, (unsigned)(ph + 1), xcc, nloc, nx);
  }
}
#endif

extern "C" void kernel_launch(void* const* d_in, const int* in_sizes, int n_in, void* d_out, int out_size, void* d_ws,
                              size_t ws_size, hipStream_t stream) {
  Params p{};
  const float* const* in = (const float* const*)d_in;
  p.x = in[0]; p.c = in[1]; p.ctx = in[2]; p.c_ctx = in[3]; p.w_mod = in[4]; p.b_mod = in[5];
  p.g_pre_mix = in[6]; p.g_post_mix = in[7]; p.w_in = in[8]; p.a_re = in[9]; p.a_im = in[10]; p.log_dt = in[11];
  p.b_re = in[12]; p.b_im = in[13]; p.c_re = in[14]; p.c_im = in[15]; p.ssm_d = in[16]; p.w_glu = in[17];
  p.w_fourier = in[18]; p.rpb = in[19]; p.w_out = in[20]; p.g_pre_ffn = in[21]; p.g_post_ffn = in[22];
  p.w_gate = in[23]; p.w_up = in[24]; p.w_down = in[25];
  p.out = (float*)d_out;
  char* ws = (char*)d_ws;
  size_t off = 0;
  auto alloc = [&](size_t bytes) { char* r = ws + off; off += (bytes + 255) & ~(size_t)255; return r; };
  p.wt_in = (u16*)alloc((size_t)INW * DM * 2);
  p.wt_out = (u16*)alloc((size_t)DM * DM * 2);
  p.wt_glu = (u16*)alloc((size_t)384 * 384 * 2);
  p.wt_gu = (u16*)alloc((size_t)2 * DFF * DM * 2);
  p.wt_dn = (u16*)alloc((size_t)DM * DFF * 2);
  p.A_out = (u16*)alloc((size_t)24 * 512 * 768 * 2);
  p.A_end = (u16*)alloc((size_t)24 * 256 * 512 * 2);
  p.D128 = (u16*)alloc(256 * 128 * 2);
  p.D256 = (u16*)alloc(512 * 256 * 2);
  p.Tmat = (u16*)alloc((size_t)128 * 128 * 128 * 2);
  p.MWt = (u16*)alloc(256 * 512 * 2);
  p.lamT = (float*)alloc(2 * 24 * 64 * 2 * 4);
  p.Ktau = (float*)alloc((size_t)24 * 63 * 256 * 4);
  p.mod = (float*)alloc(2 * 3 * 6144 * 4);
  p.abuf = (u16*)alloc((size_t)MR * DM * 2);
  p.xctx = (float*)alloc((size_t)NCTX * DM * 4);
  unsigned* bar = (unsigned*)alloc(XB_WORDS * 4);
  char* R = ws + off;
  size_t roff = 0;
  auto ralloc = [&](size_t bytes) { char* r = R + roff; roff += (bytes + 255) & ~(size_t)255; return r; };
  p.ycat = (u16*)ralloc((size_t)MR * DM * 2);
  p.UB = (u16*)ralloc((size_t)24 * NCH * 768 * 2);
  p.fbuf = (u16*)ralloc((size_t)MR * 256 * 2);
  p.qbuf = (u16*)ralloc((size_t)MR * 384 * 2);
  p.kbuf = (u16*)ralloc((size_t)MR * 384 * 2);
  p.vT = (u16*)ralloc((size_t)2 * 384 * SEQ * 2);
  p.vTc = (u16*)ralloc((size_t)2 * 384 * LCX * 2);
  p.E = (float*)ralloc((size_t)24 * NCH * 256 * 4);
  p.A1 = (u16*)ralloc((size_t)2 * 128 * 128 * 256 * 2);
  p.Gbuf = (u16*)ralloc((size_t)MR * 512 * 2);
  p.zbuf = p.qbuf;
  p.hidden = (u16*)R;
  const size_t hid_bytes = (((size_t)MR * DFF * 2) + 255) & ~(size_t)255;
  p.obuf = (u16*)(R + hid_bytes);
  size_t rneed = hid_bytes + (size_t)MR * DM * 2;
  if (rneed > roff) roff = rneed;
  if (off + roff > ws_size) {
    fprintf(stderr, "workspace too small: need %zu have %zu\n", off + roff, ws_size);
    return;
  }
#if MK_MULTI
  for (int ph = 0; ph < NPH; ++ph) phase_kernel<<<dim3(1024), dim3(256), 0, stream>>>(p, ph);
#else
  static int grid_blocks = 0;
  if (!grid_blocks) {
    int dev = 0, cus = 0, per_cu = 0;
    hipGetDevice(&dev);
    hipDeviceGetAttribute(&cus, hipDeviceAttributeMultiprocessorCount, dev);
    hipOccupancyMaxActiveBlocksPerMultiprocessor(&per_cu, fwd_megakernel, 256, 0);
    if (per_cu > 2) per_cu = 2;
    grid_blocks = cus * per_cu;
  }
  hipMemsetAsync(bar, 0, XB_WORDS * 4, stream);
  void* args[] = {&p, &bar};
  hipError_t e = hipLaunchCooperativeKernel((void*)fwd_megakernel, dim3(grid_blocks), dim3(256), args, 0, stream);
  if (e != hipSuccess) fprintf(stderr, "cooperative launch failed: %s (grid %d)\n", hipGetErrorString(e), grid_blocks);
#endif
}
```

```cpp
#include <hip/hip_runtime.h>
#include <hip/hip_bf16.h>
#include <hip/hip_cooperative_groups.h>
#include <cstdio>
#include <cstdint>
namespace cg = cooperative_groups;

#ifndef MK_MULTI
#define MK_MULTI 0
#endif

typedef __attribute__((ext_vector_type(8))) short bf16x8;
typedef __attribute__((ext_vector_type(4))) float f32x4;
typedef __attribute__((ext_vector_type(16))) float f32x16;
typedef unsigned short u16;

#define DEV __device__ __forceinline__


constexpr int DM = 1024, SEQ = 8192, LCX = 256;
constexpr int NLAT = 2 * SEQ, NCTX = 2 * LCX, MR = NLAT + NCTX;
constexpr int INW = 1792, DFF = 2816;
constexpr int TCH = 32, NCH = MR / TCH;
constexpr int NPH = 22;
constexpr float EPS = 1e-6f;

constexpr size_t al256(size_t x) { return (x + 255) & ~(size_t)255; }
constexpr size_t O_wt_in = 0;
constexpr size_t O_wt_out = O_wt_in + al256((size_t)INW * DM * 2);
constexpr size_t O_wt_glu = O_wt_out + al256((size_t)DM * DM * 2);
constexpr size_t O_wt_gu = O_wt_glu + al256((size_t)384 * 384 * 2);
constexpr size_t O_wt_dn = O_wt_gu + al256((size_t)2 * DFF * DM * 2);
constexpr size_t O_A_out = O_wt_dn + al256((size_t)DM * DFF * 2);
constexpr size_t O_A_end = O_A_out + al256((size_t)24 * 512 * 768 * 2);
constexpr size_t O_D128 = O_A_end + al256((size_t)24 * 256 * 512 * 2);
constexpr size_t O_D256 = O_D128 + al256(256 * 128 * 2);
constexpr size_t O_Tmat = O_D256 + al256(512 * 256 * 2);
constexpr size_t O_MWt = O_Tmat + al256((size_t)128 * 128 * 128 * 2);
constexpr size_t O_lamT = O_MWt + al256(256 * 512 * 2);
constexpr size_t O_Ktau = O_lamT + al256(2 * 24 * 64 * 2 * 4);
constexpr size_t O_mod = O_Ktau + al256((size_t)24 * 63 * 256 * 4);
constexpr size_t O_abuf = O_mod + al256(2 * 3 * 6144 * 4);
constexpr size_t O_xctx = O_abuf + al256((size_t)MR * DM * 2);
constexpr size_t O_bar = O_xctx + al256((size_t)NCTX * DM * 4);
constexpr size_t O_R = O_bar + al256(16384);
constexpr size_t O_ycat = O_R;
constexpr size_t O_UB = O_ycat + al256((size_t)MR * DM * 2);
constexpr size_t O_fbuf = O_UB + al256((size_t)24 * NCH * 768 * 2);
constexpr size_t O_qbuf = O_fbuf + al256((size_t)MR * 256 * 2);
constexpr size_t O_kbuf = O_qbuf + al256((size_t)MR * 384 * 2);
constexpr size_t O_vT = O_kbuf + al256((size_t)MR * 384 * 2);
constexpr size_t O_vTc = O_vT + al256((size_t)2 * 384 * SEQ * 2);
constexpr size_t O_E = O_vTc + al256((size_t)2 * 384 * LCX * 2);
constexpr size_t O_A1 = O_E + al256((size_t)24 * NCH * 256 * 4);
constexpr size_t O_Gbuf = O_A1 + al256((size_t)2 * 128 * 128 * 256 * 2);
constexpr size_t O_Rend = O_Gbuf + al256((size_t)MR * 512 * 2);
constexpr size_t O_zbuf = O_qbuf;
constexpr size_t O_hidden = O_R;
constexpr size_t O_obuf = O_R + al256((size_t)MR * DFF * 2);
constexpr size_t O_obuf_end = O_obuf + al256((size_t)MR * DM * 2);
constexpr size_t WS_NEED = O_Rend > O_obuf_end ? O_Rend : O_obuf_end;

struct Params {
  const float *x, *c, *ctx, *c_ctx, *w_mod, *b_mod, *g_pre_mix, *g_post_mix, *w_in;
  const float *a_re, *a_im, *log_dt, *b_re, *b_im, *c_re, *c_im, *ssm_d, *w_glu, *w_fourier, *rpb, *w_out;
  const float *g_pre_ffn, *g_post_ffn, *w_gate, *w_up, *w_down;
  float* out;
  char* ws;
  DEV u16* wt_in() const { return (u16*)(ws + O_wt_in); }
  DEV u16* wt_out() const { return (u16*)(ws + O_wt_out); }
  DEV u16* wt_glu() const { return (u16*)(ws + O_wt_glu); }
  DEV u16* wt_gu() const { return (u16*)(ws + O_wt_gu); }
  DEV u16* wt_dn() const { return (u16*)(ws + O_wt_dn); }
  DEV u16* A_out() const { return (u16*)(ws + O_A_out); }
  DEV u16* A_end() const { return (u16*)(ws + O_A_end); }
  DEV u16* D128() const { return (u16*)(ws + O_D128); }
  DEV u16* D256() const { return (u16*)(ws + O_D256); }
  DEV u16* Tmat() const { return (u16*)(ws + O_Tmat); }
  DEV u16* MWt() const { return (u16*)(ws + O_MWt); }
  DEV u16* abuf() const { return (u16*)(ws + O_abuf); }
  DEV u16* UB() const { return (u16*)(ws + O_UB); }
  DEV u16* fbuf() const { return (u16*)(ws + O_fbuf); }
  DEV u16* qbuf() const { return (u16*)(ws + O_qbuf); }
  DEV u16* kbuf() const { return (u16*)(ws + O_kbuf); }
  DEV u16* vT() const { return (u16*)(ws + O_vT); }
  DEV u16* vTc() const { return (u16*)(ws + O_vTc); }
  DEV u16* zbuf() const { return (u16*)(ws + O_zbuf); }
  DEV u16* A1() const { return (u16*)(ws + O_A1); }
  DEV u16* Gbuf() const { return (u16*)(ws + O_Gbuf); }
  DEV u16* ycat() const { return (u16*)(ws + O_ycat); }
  DEV u16* obuf() const { return (u16*)(ws + O_obuf); }
  DEV u16* hidden() const { return (u16*)(ws + O_hidden); }
  DEV float* lamT() const { return (float*)(ws + O_lamT); }
  DEV float* mod() const { return (float*)(ws + O_mod); }
  DEV float* xctx() const { return (float*)(ws + O_xctx); }
  DEV float* E() const { return (float*)(ws + O_E); }
  DEV float* Ktau() const { return (float*)(ws + O_Ktau); }
};

DEV int g_tid() { int t = threadIdx.x; asm volatile("" : "+v"(t)); return t; }
DEV u16 f2bf(float f) { unsigned u = __float_as_uint(f); u += 0x7fffu + ((u >> 16) & 1u); return (u16)(u >> 16); }
DEV float bf2f(u16 h) { return __uint_as_float(((unsigned)h) << 16); }
DEV unsigned pack2(float a, float b) { return (unsigned)f2bf(a) | ((unsigned)f2bf(b) << 16); }
DEV void store_bf4(u16* p, float a, float b, float c, float d) { uint2 v; v.x = pack2(a, b); v.y = pack2(c, d); *(uint2*)p = v; }
DEV float wave_sum(float v) {
#pragma unroll
  for (int o = 32; o >= 1; o >>= 1) v += __shfl_xor(v, o);
  return v;
}
DEV float hw_sin_rev(float r) { return __builtin_amdgcn_sinf(r); }
DEV float hw_cos_rev(float r) { return __builtin_amdgcn_cosf(r); }

template <int BMODE, class Epi>
DEV void gemm_tile(const u16* A, int lda, const u16* B, int ldb, int K, int n0, int m0, int mmax, char* smem,
                   const Epi& epi) {
  const int tid = g_tid(), lane = tid & 63, w = tid >> 6;
  const int wn = w & 1, wm = w >> 1;
  f32x16 acc[2][2];
#pragma unroll
  for (int i = 0; i < 2; ++i)
#pragma unroll
    for (int j = 0; j < 2; ++j)
#pragma unroll
      for (int r = 0; r < 16; ++r) acc[i][j][r] = 0.f;
  uint4 ra[4], rb[4];
  auto gload = [&](int k0) {
#pragma unroll
    for (int i = 0; i < 4; ++i) {
      int id = tid + 256 * i;
      int r = id >> 3, ch = id & 7;
      ra[i] = *(const uint4*)(A + (size_t)(n0 + r) * lda + k0 + ch * 8);
      if (BMODE == 0) {
        int m = m0 + r;
        m = m < mmax ? m : mmax - 1;
        rb[i] = *(const uint4*)(B + (size_t)m * ldb + k0 + ch * 8);
      } else if (BMODE == 2) {
        int k = k0 + ch * 8;
        rb[i] = *(const uint4*)(B + ((size_t)(k >> 4) * MR + (m0 + r)) * 16 + (k & 15));
      } else {
        int kk = id >> 4, nch = id & 15;
        rb[i] = *(const uint4*)(B + (size_t)(k0 + kk) * ldb + m0 + nch * 8);
      }
    }
  };
  auto sstore = [&](int buf) {
    char* sa = smem + buf * 32768;
    char* sb = sa + 16384;
#pragma unroll
    for (int i = 0; i < 4; ++i) {
      int id = tid + 256 * i;
      int r = id >> 3, ch = id & 7;
      *(uint4*)(sa + r * 128 + ((ch ^ (r & 7)) << 4)) = ra[i];
      if (BMODE != 1) {
        *(uint4*)(sb + r * 128 + ((ch ^ (r & 7)) << 4)) = rb[i];
      } else {
        int kk = id >> 4, nch = id & 15;
#pragma unroll
        for (int e = 0; e < 8; ++e) {
          unsigned wd = (e >> 1) == 0 ? rb[i].x : (e >> 1) == 1 ? rb[i].y : (e >> 1) == 2 ? rb[i].z : rb[i].w;
          u16 v = (u16)((e & 1) ? (wd >> 16) : (wd & 0xffffu));
          int n = nch * 8 + e;
          *(u16*)(sb + n * 128 + ((((kk >> 3) ^ (n & 7)) << 4) + (kk & 7) * 2)) = v;
        }
      }
    }
  };
  const int nk = K >> 6;
  gload(0);
  sstore(0);
  __syncthreads();
  for (int kt = 0; kt < nk; ++kt) {
    if (kt + 1 < nk) gload((kt + 1) << 6);
    const char* sa = smem + (kt & 1) * 32768;
    const char* sb = sa + 16384;
#pragma unroll
    for (int ks = 0; ks < 4; ++ks) {
      bf16x8 af[2], bfr[2];
      const int ch = ks * 2 + (lane >> 5);
#pragma unroll
      for (int i = 0; i < 2; ++i) {
        int row = wn * 64 + i * 32 + (lane & 31);
        af[i] = *(const bf16x8*)(sa + row * 128 + ((ch ^ (row & 7)) << 4));
      }
#pragma unroll
      for (int j = 0; j < 2; ++j) {
        int row = wm * 64 + j * 32 + (lane & 31);
        bfr[j] = *(const bf16x8*)(sb + row * 128 + ((ch ^ (row & 7)) << 4));
      }
#pragma unroll
      for (int i = 0; i < 2; ++i)
#pragma unroll
        for (int j = 0; j < 2; ++j)
          acc[i][j] = __builtin_amdgcn_mfma_f32_32x32x16_bf16(af[i], bfr[j], acc[i][j], 0, 0, 0);
    }
    if (kt + 1 < nk) sstore((kt + 1) & 1);
    __syncthreads();
  }
  epi(acc, n0 + wn * 64, m0 + wm * 64, lane);
}

typedef __attribute__((ext_vector_type(4))) unsigned u32x4;
#define BIG_GLOAD(S, K0)                                                       \
  S##a0 = *(const u32x4*)(ga + (K0));                                          \
  S##a1 = *(const u32x4*)(ga + (size_t)64 * lda + (K0));                       \
  S##a2 = *(const u32x4*)(ga + (size_t)128 * lda + (K0));                      \
  S##a3 = *(const u32x4*)(ga + (size_t)192 * lda + (K0));                      \
  S##b0 = *(const u32x4*)(gb + (K0));                                          \
  S##b1 = *(const u32x4*)(gb + (size_t)64 * ldb + (K0));                       \
  if (NJ >= 3) S##b2 = *(const u32x4*)(gb + (size_t)128 * ldb + (K0));         \
  if (NJ == 4) S##b3 = *(const u32x4*)(gb + (size_t)192 * ldb + (K0));
#define BIG_SSTORE(S, BUF)                                                     \
  *(u32x4*)(smem + (BUF) * 32768 + soff) = S##a0;                              \
  *(u32x4*)(smem + (BUF) * 32768 + soff + 4096) = S##a1;                       \
  *(u32x4*)(smem + (BUF) * 32768 + soff + 8192) = S##a2;                       \
  *(u32x4*)(smem + (BUF) * 32768 + soff + 12288) = S##a3;                      \
  *(u32x4*)(smem + (BUF) * 32768 + 16384 + soff) = S##b0;                      \
  *(u32x4*)(smem + (BUF) * 32768 + 16384 + soff + 4096) = S##b1;               \
  if (NJ >= 3) *(u32x4*)(smem + (BUF) * 32768 + 16384 + soff + 8192) = S##b2;  \
  if (NJ == 4) *(u32x4*)(smem + (BUF) * 32768 + 16384 + soff + 12288) = S##b3;
template <int NJ, class Epi>
DEV void gemm_big(const u16* A, int lda, const u16* B, int ldb, int K, int n0, int m0, char* smem, const Epi& epi) {
  const int tid = g_tid(), lane = tid & 63, w = tid >> 6;
  const int wn = w & 1, wm = w >> 1;
  f32x16 acc[4][NJ];
#pragma unroll
  for (int i = 0; i < 4; ++i)
#pragma unroll
    for (int j = 0; j < NJ; ++j)
#pragma unroll
      for (int r = 0; r < 16; ++r) acc[i][j][r] = 0.f;
  u32x4 pa0, pa1, pa2, pa3, pb0, pb1, pb2, pb3, qa0, qa1, qa2, qa3, qb0, qb1, qb2, qb3;
  pb2 = pb3 = qb2 = qb3 = u32x4{0u, 0u, 0u, 0u};
  const int lrow = tid >> 2, lch = tid & 3;
  const u16* ga = A + (size_t)(n0 + lrow) * lda + lch * 8;
  const u16* gb = B + (size_t)(m0 + lrow) * ldb + lch * 8;
  const int soff = lrow * 64 + ((lch ^ ((lrow >> 2) & 3)) << 4);
  const int frow = lane & 31, fhi = lane >> 5;
  const int sw = (frow >> 2) & 3;
  const unsigned lds0 = (unsigned)(uintptr_t)((__attribute__((address_space(3))) char*)smem);
  const unsigned aA0 = lds0 + (wn * 128 + frow) * 64 + (((0 + fhi) ^ sw) << 4);
  const unsigned aA1 = lds0 + (wn * 128 + frow) * 64 + (((2 + fhi) ^ sw) << 4);
  const unsigned aB0 = lds0 + 16384 + (wm * 32 * NJ + frow) * 64 + (((0 + fhi) ^ sw) << 4);
  const unsigned aB1 = lds0 + 16384 + (wm * 32 * NJ + frow) * 64 + (((2 + fhi) ^ sw) << 4);
#define DSR(dst, addr, OFF) asm volatile("ds_read_b128 %0, %1 offset:%2" : "=v"(dst) : "v"(addr), "n"(OFF))
#define BIG_LOADF(F, AA, AB, BUF)                                   \
  DSR(F##a0, AA, (BUF) * 32768);                                     \
  DSR(F##a1, AA, (BUF) * 32768 + 2048);                              \
  DSR(F##a2, AA, (BUF) * 32768 + 4096);                              \
  DSR(F##a3, AA, (BUF) * 32768 + 6144);                              \
  DSR(F##b0, AB, (BUF) * 32768);                                     \
  DSR(F##b1, AB, (BUF) * 32768 + 2048);                              \
  if (NJ >= 3) DSR(F##b2, AB, (BUF) * 32768 + 4096);                 \
  if (NJ == 4) DSR(F##b3, AB, (BUF) * 32768 + 6144);
#define BIG_WAITF(N, F)                                                                                       \
  asm volatile("s_waitcnt lgkmcnt(%8)"                                                                       \
               : "+v"(F##a0), "+v"(F##a1), "+v"(F##a2), "+v"(F##a3), "+v"(F##b0), "+v"(F##b1), "+v"(F##b2), "+v"(F##b3) \
               : "n"(N));
#define BIG_MFMA(F)                                                                                           \
  acc[0][0] = __builtin_amdgcn_mfma_f32_32x32x16_bf16(F##a0, F##b0, acc[0][0], 0, 0, 0);                        \
  acc[0][1] = __builtin_amdgcn_mfma_f32_32x32x16_bf16(F##a0, F##b1, acc[0][1], 0, 0, 0);                        \
  if (NJ >= 3) acc[0][NJ >= 3 ? 2 : 0] = __builtin_amdgcn_mfma_f32_32x32x16_bf16(F##a0, F##b2, acc[0][NJ >= 3 ? 2 : 0], 0, 0, 0); \
  if (NJ == 4) acc[0][NJ - 1] = __builtin_amdgcn_mfma_f32_32x32x16_bf16(F##a0, F##b3, acc[0][NJ - 1], 0, 0, 0);  \
  acc[1][0] = __builtin_amdgcn_mfma_f32_32x32x16_bf16(F##a1, F##b0, acc[1][0], 0, 0, 0);                        \
  acc[1][1] = __builtin_amdgcn_mfma_f32_32x32x16_bf16(F##a1, F##b1, acc[1][1], 0, 0, 0);                        \
  if (NJ >= 3) acc[1][NJ >= 3 ? 2 : 0] = __builtin_amdgcn_mfma_f32_32x32x16_bf16(F##a1, F##b2, acc[1][NJ >= 3 ? 2 : 0], 0, 0, 0); \
  if (NJ == 4) acc[1][NJ - 1] = __builtin_amdgcn_mfma_f32_32x32x16_bf16(F##a1, F##b3, acc[1][NJ - 1], 0, 0, 0);  \
  acc[2][0] = __builtin_amdgcn_mfma_f32_32x32x16_bf16(F##a2, F##b0, acc[2][0], 0, 0, 0);                        \
  acc[2][1] = __builtin_amdgcn_mfma_f32_32x32x16_bf16(F##a2, F##b1, acc[2][1], 0, 0, 0);                        \
  if (NJ >= 3) acc[2][NJ >= 3 ? 2 : 0] = __builtin_amdgcn_mfma_f32_32x32x16_bf16(F##a2, F##b2, acc[2][NJ >= 3 ? 2 : 0], 0, 0, 0); \
  if (NJ == 4) acc[2][NJ - 1] = __builtin_amdgcn_mfma_f32_32x32x16_bf16(F##a2, F##b3, acc[2][NJ - 1], 0, 0, 0);  \
  acc[3][0] = __builtin_amdgcn_mfma_f32_32x32x16_bf16(F##a3, F##b0, acc[3][0], 0, 0, 0);                        \
  acc[3][1] = __builtin_amdgcn_mfma_f32_32x32x16_bf16(F##a3, F##b1, acc[3][1], 0, 0, 0);                        \
  if (NJ >= 3) acc[3][NJ >= 3 ? 2 : 0] = __builtin_amdgcn_mfma_f32_32x32x16_bf16(F##a3, F##b2, acc[3][NJ >= 3 ? 2 : 0], 0, 0, 0); \
  if (NJ == 4) acc[3][NJ - 1] = __builtin_amdgcn_mfma_f32_32x32x16_bf16(F##a3, F##b3, acc[3][NJ - 1], 0, 0, 0);
#define BIG_COMPUTE(BUF)                 \
  BIG_LOADF(f, aA0, aB0, BUF)            \
  BIG_LOADF(h, aA1, aB1, BUF)            \
  BIG_WAITF(NJ + 4, f)                   \
  BIG_MFMA(f)                            \
  BIG_WAITF(0, h)                        \
  BIG_MFMA(h)
  bf16x8 fa0, fa1, fa2, fa3, fb0, fb1, fb2, fb3, ha0, ha1, ha2, ha3, hb0, hb1, hb2, hb3;
  fb2 = fb3 = hb2 = hb3 = bf16x8{0, 0, 0, 0, 0, 0, 0, 0};
  const int nk = K >> 5;
  const int klast = K - 32;
  BIG_GLOAD(p, 0)
  BIG_GLOAD(q, 32)
  BIG_SSTORE(p, 0)
  __syncthreads();
  for (int kt = 0; kt < nk; kt += 2) {
    {
      int k0 = (kt + 2) << 5;
      k0 = k0 > klast ? klast : k0;
      BIG_GLOAD(p, k0)
    }
    BIG_COMPUTE(0)
    BIG_SSTORE(q, 1)
    __syncthreads();
    {
      int k0 = (kt + 3) << 5;
      k0 = k0 > klast ? klast : k0;
      BIG_GLOAD(q, k0)
    }
    BIG_COMPUTE(1)
    BIG_SSTORE(p, 0)
    __syncthreads();
  }
  epi(acc, n0 + wn * 128, m0 + wm * 32 * NJ, lane);
}


template <int NJ, class Epi>
DEV void big_gemm_phase(const u16* A, int lda, const u16* B, int ldb, int K, int NF, int G, int bid, int nblk, char* smem,
                        const Epi& epi) {
  constexpr int TT = 64 * NJ;
  const int NT = MR / TT;
  if (nblk == 256) {
    const int xcd = bid & 7, slot = bid >> 3;
    const int rem = NT % 8;
    const int TPX = NT / 8 + (xcd < rem ? 1 : 0);
    const int t0 = xcd * (NT / 8) + (xcd < rem ? xcd : rem);
    for (int j = slot; j < NF * TPX; j += 32) {
      int f = (j / (G * TPX)) * G + j % G;
      int t = t0 + (j / G) % TPX;
      gemm_big<NJ>(A, lda, B, ldb, K, f * 256, t * TT, smem, epi);
    }
  } else {
    for (int job = bid; job < NF * NT; job += nblk) gemm_big<NJ>(A, lda, B, ldb, K, (job % NF) * 256, (job / NF) * TT, smem, epi);
  }
}

template <int NI, int NJ, class F>
DEV void for_quads(f32x16 (&acc)[NI][NJ], int nW, int mW, int lane, F f) {
#pragma unroll
  for (int i = 0; i < NI; ++i)
#pragma unroll
    for (int j = 0; j < NJ; ++j)
#pragma unroll
      for (int q = 0; q < 4; ++q) {
        int nf = nW + i * 32 + 8 * q + 4 * (lane >> 5);
        int m = mW + j * 32 + (lane & 31);
        f(nf, m, acc[i][j][4 * q], acc[i][j][4 * q + 1], acc[i][j][4 * q + 2], acc[i][j][4 * q + 3]);
      }
}

struct EpiInproj {
  const Params& P;
  template <int NI, int NJ>
  DEV void operator()(f32x16 (&acc)[NI][NJ], int nW, int mW, int lane) const {
    const int hi = lane >> 5;
#pragma unroll
    for (int i = 0; i < NI; ++i) {
      const int nt = nW + i * 32;
#pragma unroll
      for (int j = 0; j < NJ; ++j) {
        const int m = mW + j * 32 + (lane & 31);
        f32x16 a = acc[i][j];
        if (nt < 384) {
#pragma unroll
          for (int q = 0; q < 4; ++q) {
            int nf = nt + 8 * q + 4 * hi;
            int g = nf >> 4, h = nf & 15;
            u16* dst = P.UB() + ((size_t)(g * NCH + (m >> 5))) * 768 + (m & 31) * 16 + h;
            store_bf4(dst, a[4 * q], a[4 * q + 1], a[4 * q + 2], a[4 * q + 3]);
          }
        } else if (nt < 640) {
#pragma unroll
          for (int q = 0; q < 4; ++q) {
            int nf = nt + 8 * q + 4 * hi - 384;
            store_bf4(P.fbuf() + (size_t)m * 256 + nf, a[4 * q], a[4 * q + 1], a[4 * q + 2], a[4 * q + 3]);
          }
        } else if (nt < 1408) {
          const bool isq = nt < 1024;
          const int off = nt - (isq ? 640 : 1024);
          if (m < NLAT) {
            const int l = m & (SEQ - 1);
            const float pos = (off & 32) ? (float)(l & 63) : (float)(l >> 6);
#pragma unroll
            for (int e = 0; e < 8; ++e) {
              int fl = 8 * (e >> 2) + 4 * hi + (e & 3);
              float freq = exp2f(-(float)fl * (13.287712379549449f / 16.f));
              float rev = pos * freq * 0.15915494309189535f;
              float sn = hw_sin_rev(rev), cs = hw_cos_rev(rev);
              float x1 = a[e], x2 = a[e + 8];
              a[e] = x1 * cs - x2 * sn;
              a[e + 8] = x2 * cs + x1 * sn;
            }
          }
          const float sc = isq ? 0.125f : 1.f;
          u16* base = (isq ? P.qbuf() : P.kbuf()) + (size_t)m * 384 + off;
#pragma unroll
          for (int q = 0; q < 4; ++q)
            store_bf4(base + 8 * q + 4 * hi, a[4 * q] * sc, a[4 * q + 1] * sc, a[4 * q + 2] * sc, a[4 * q + 3] * sc);
        } else {
#pragma unroll
          for (int r = 0; r < 16; ++r) {
            int feat = nt - 1408 + (r & 3) + 8 * (r >> 2) + 4 * hi;
            if (m < NLAT)
              P.vT()[((size_t)((m >> 13) * 384 + feat)) * SEQ + (m & (SEQ - 1))] = f2bf(a[r]);
            else
              P.vTc()[((size_t)(((m - NLAT) >> 8) * 384 + feat)) * LCX + ((m - NLAT) & 255)] = f2bf(a[r]);
          }
        }
      }
    }
  }
};

struct EpiSsmEnd {
  float* Eg;
  template <int NI, int NJ>
  DEV void operator()(f32x16 (&acc)[NI][NJ], int nW, int mW, int lane) const {
    for_quads(acc, nW, mW, lane, [&](int nf, int m, float a, float b, float c, float d) {
      if (m < NCH) *(float4*)(Eg + (size_t)m * 256 + nf) = make_float4(a, b, c, d);
    });
  }
};

DEV float gelu_tanh(float x) {
  float u = 0.7978845608028654f * (x + 0.044715f * x * x * x);
  float t = 1.f - 2.f / (1.f + __expf(2.f * u));
  return 0.5f * x * (1.f + t);
}

struct EpiSsmOut {
  u16* zb;
  int g;
  template <int NI, int NJ>
  DEV void operator()(f32x16 (&acc)[NI][NJ], int nW, int mW, int lane) const {
    for_quads(acc, nW, mW, lane, [&](int nf, int m, float a, float b, float c, float d) {
      if (m < NCH) {
        int t = nf >> 4, h = nf & 15;
        store_bf4(zb + ((size_t)g * MR + m * TCH + t) * 16 + h, gelu_tanh(a), gelu_tanh(b), gelu_tanh(c),
                  gelu_tanh(d));
      }
    });
  }
};

struct EpiGlu {
  const u16* zb;
  u16* yc;
  template <int NI, int NJ>
  DEV void operator()(f32x16 (&acc)[NI][NJ], int nW, int mW, int lane) const {
    for_quads(acc, nW, mW, lane, [&](int nf, int m, float a, float b, float c, float d) {
      uint2 zz = *(const uint2*)(zb + ((size_t)(nf >> 4) * MR + m) * 16 + (nf & 15));
      float z0 = bf2f((u16)(zz.x & 0xffff)), z1 = bf2f((u16)(zz.x >> 16));
      float z2 = bf2f((u16)(zz.y & 0xffff)), z3 = bf2f((u16)(zz.y >> 16));
      store_bf4(yc + (size_t)m * 1024 + nf, z0 / (1.f + __expf(-a)), z1 / (1.f + __expf(-b)), z2 / (1.f + __expf(-c)),
                z3 / (1.f + __expf(-d)));
    });
  }
};

struct EpiFnetA {
  u16* A1b;
  template <int NI, int NJ>
  DEV void operator()(f32x16 (&acc)[NI][NJ], int nW, int mW, int lane) const {
    for_quads(acc, nW, mW, lane, [&](int nf, int m, float a, float b, float c, float d) {
      int k1 = nf >> 1;
      int cc = m >> 8, j = m & 255;
      u16* p = A1b + ((size_t)(k1 * 128 + cc * 2)) * 256 + j;
      p[0] = f2bf(a);
      p[256] = f2bf(b);
      p[128 * 256] = f2bf(c);
      p[128 * 256 + 256] = f2bf(d);
    });
  }
};

struct EpiFnetCtx {
  u16* Gb;
  template <int NI, int NJ>
  DEV void operator()(f32x16 (&acc)[NI][NJ], int nW, int mW, int lane) const {
    for_quads(acc, nW, mW, lane, [&](int nf, int m, float a, float b, float c, float d) {
      int k = nf >> 1;
      const float s = 1.f / 128.f;
      u16* p = Gb + (size_t)k * 512 + m;
      p[0] = f2bf(a * s);
      p[256] = f2bf(b * s);
      p[512] = f2bf(c * s);
      p[512 + 256] = f2bf(d * s);
    });
  }
};

struct EpiFnetC {
  u16* Gb;
  template <int NI, int NJ>
  DEV void operator()(f32x16 (&acc)[NI][NJ], int nW, int mW, int lane) const {
    for_quads(acc, nW, mW, lane, [&](int nf, int m, float a, float b, float c, float d) {
      int k2 = nf >> 1;
      const float s = 0.0013810679320049757f;
      u16* p = Gb + (size_t)k2 * 128 * 512 + m;
      p[0] = f2bf(a * s);
      p[256] = f2bf(b * s);
      p[128 * 512] = f2bf(c * s);
      p[128 * 512 + 256] = f2bf(d * s);
    });
  }
};

struct EpiStoreBf {
  u16* dst;
  int ld, coff;
  template <int NI, int NJ>
  DEV void operator()(f32x16 (&acc)[NI][NJ], int nW, int mW, int lane) const {
    for_quads(acc, nW, mW, lane, [&](int nf, int m, float a, float b, float c, float d) {
      store_bf4(dst + (size_t)m * ld + coff + nf, a, b, c, d);
    });
  }
};

struct EpiGateUp {
  u16* hid;
  template <int NI, int NJ>
  DEV void operator()(f32x16 (&acc)[NI][NJ], int nW, int mW, int lane) const {
    const int hi = lane >> 5;
#pragma unroll
    for (int ip = 0; ip < NI / 2; ++ip)
#pragma unroll
      for (int j = 0; j < NJ; ++j) {
        const int m = mW + j * 32 + (lane & 31);
#pragma unroll
        for (int q = 0; q < 4; ++q) {
          float o[4];
#pragma unroll
          for (int e = 0; e < 4; ++e) {
            float g = acc[2 * ip][j][4 * q + e], u = acc[2 * ip + 1][j][4 * q + e];
            o[e] = g / (1.f + __expf(-g)) * u;
          }
          int col = (nW >> 6) * 32 + ip * 32 + 8 * q + 4 * hi;
          store_bf4(hid + (size_t)m * DFF + col, o[0], o[1], o[2], o[3]);
        }
      }
  }
};

DEV void transpose_tile(const float* src, int K, int N, u16* dst, int mode, int kt, int nt, char* smem) {
  float* s = (float*)smem;
  const int tid = g_tid();
  const int k0 = kt * 64, n0 = nt * 64;
#pragma unroll
  for (int i = 0; i < 4; ++i) {
    int id = tid + 256 * i;
    int kk = id >> 4, c4 = id & 15;
    float4 v = *(const float4*)(src + (size_t)(k0 + kk) * N + n0 + c4 * 4);
    s[kk * 65 + c4 * 4 + 0] = v.x;
    s[kk * 65 + c4 * 4 + 1] = v.y;
    s[kk * 65 + c4 * 4 + 2] = v.z;
    s[kk * 65 + c4 * 4 + 3] = v.w;
  }
  __syncthreads();
#pragma unroll
  for (int i = 0; i < 2; ++i) {
    int id = tid + 256 * i;
    int nn = id >> 3, kc = id & 7;
    int n = n0 + nn;
    int row = mode == 0 ? n : (64 * (n >> 5) + (n & 31) + (mode == 2 ? 32 : 0));
    uint4 o;
    o.x = pack2(s[(kc * 8 + 0) * 65 + nn], s[(kc * 8 + 1) * 65 + nn]);
    o.y = pack2(s[(kc * 8 + 2) * 65 + nn], s[(kc * 8 + 3) * 65 + nn]);
    o.z = pack2(s[(kc * 8 + 4) * 65 + nn], s[(kc * 8 + 5) * 65 + nn]);
    o.w = pack2(s[(kc * 8 + 6) * 65 + nn], s[(kc * 8 + 7) * 65 + nn]);
    *(uint4*)(dst + (size_t)row * K + k0 + kc * 8) = o;
  }
  __syncthreads();
}

DEV void lam_pow(float are, float aim, float dt, int n, float& pr, float& pi) {
  float mag = expf((float)n * are * dt);
  double rev = (double)n * (double)aim * (double)dt * 0.15915494309189535;
  rev -= rint(rev);
  float fr = (float)rev;
  pr = mag * hw_cos_rev(fr);
  pi = mag * hw_sin_rev(fr);
}
DEV void zoh_factor(float are, float aim, float dt, float& fr, float& fi) {
  float lr, li;
  lam_pow(are, aim, dt, 1, lr, li);
  float nr = lr - 1.f, ni = li;
  float d2 = are * are + aim * aim;
  fr = (nr * are + ni * aim) / d2;
  fi = (ni * are - nr * aim) / d2;
}

constexpr int PREP_TR = 2852;
constexpr int PREP_KF = 24 * 63;
constexpr int PREP_WC = 24 * 2 * 32;
constexpr int PREP_WE = 24 * 2 * 8;
constexpr int PREP_MW = 64;
constexpr int PREP_N = PREP_TR + PREP_KF + PREP_WC + PREP_WE + PREP_MW;
constexpr int EXPAND_N = 24 * 32;

DEV void prep_job(const Params& P, int layer, int job, char* smem) {
  const int tid = g_tid();
  if (job < PREP_TR) {
    int j = job;
    if (j < 448) { transpose_tile(P.w_in + (size_t)layer * DM * INW, DM, INW, P.wt_in(), 0, j / 28, j % 28, smem); return; }
    j -= 448;
    if (j < 256) { transpose_tile(P.w_out + (size_t)layer * DM * DM, DM, DM, P.wt_out(), 0, j / 16, j % 16, smem); return; }
    j -= 256;
    if (j < 36) { transpose_tile(P.w_glu + (size_t)layer * 384 * 384, 384, 384, P.wt_glu(), 0, j / 6, j % 6, smem); return; }
    j -= 36;
    if (j < 704) { transpose_tile(P.w_gate + (size_t)layer * DM * DFF, DM, DFF, P.wt_gu(), 1, j / 44, j % 44, smem); return; }
    j -= 704;
    if (j < 704) { transpose_tile(P.w_up + (size_t)layer * DM * DFF, DM, DFF, P.wt_gu(), 2, j / 44, j % 44, smem); return; }
    j -= 704;
    transpose_tile(P.w_down + (size_t)layer * DFF * DM, DFF, DM, P.wt_dn(), 0, j / 16, j % 16, smem);
    return;
  }
  job -= PREP_TR;
  float* sf = (float*)smem;
  if (job < PREP_KF) {
    const int g = job / 63, delta = job % 63 - 31;
    const int ad = delta < 0 ? -delta : delta;
    float* sQ = sf;
    float* sCQ = sf + 256;
    if (tid < 128) {
      int dir = tid >> 6, p = tid & 63;
      int ix = ((layer * 2 + dir) * 24 + g) * 64 + p;
      float are = P.a_re[ix], aim = P.a_im[ix], dt = expf(P.log_dt[(layer * 2 + dir) * 24 + g]);
      float pr, pi, fr, fi;
      lam_pow(are, aim, dt, ad, pr, pi);
      zoh_factor(are, aim, dt, fr, fi);
      sQ[(dir * 64 + p) * 2 + 0] = pr * fr - pi * fi;
      sQ[(dir * 64 + p) * 2 + 1] = pr * fi + pi * fr;
    }
    __syncthreads();
#pragma unroll
    for (int i = 0; i < 8; ++i) {
      int e = tid + 256 * i;
      int dir = e >> 10, h = (e >> 6) & 15, p = e & 63;
      size_t ci = ((size_t)(((layer * 2 + dir) * 24 + g) * 16 + h)) * 64 + p;
      float cr = P.c_re[ci], cim = P.c_im[ci];
      float qr = sQ[(dir * 64 + p) * 2], qi = sQ[(dir * 64 + p) * 2 + 1];
      sCQ[e * 2 + 0] = cr * qr - cim * qi;
      sCQ[e * 2 + 1] = cr * qi + cim * qr;
    }
    __syncthreads();
    const int h = tid >> 4, hp = tid & 15;
    float val = 0.f;
#pragma unroll
    for (int dir = 0; dir < 2; ++dir) {
      bool need = dir == 0 ? (delta >= 0) : (delta <= 0);
      if (need) {
        const float* br = P.b_re + ((size_t)(((layer * 2 + dir) * 24 + g) * 64)) * 16 + hp;
        const float* bi = P.b_im + ((size_t)(((layer * 2 + dir) * 24 + g) * 64)) * 16 + hp;
        const float* cq = sCQ + ((dir * 16 + h) * 64) * 2;
#pragma unroll 16
        for (int p = 0; p < 64; ++p) val += cq[p * 2] * br[p * 16] - cq[p * 2 + 1] * bi[p * 16];
      }
    }
    if (delta == 0 && h == hp) val += P.ssm_d[layer * 384 + g * 16 + h];
    P.Ktau()[(size_t)job * 256 + tid] = val;
    __syncthreads();
    return;
  }
  job -= PREP_KF;
  if (job < PREP_WC) {
    const int j = job & 31, dir = (job >> 5) & 1, g = job >> 6;
    float* sP = sf;
    if (tid < 64) {
      int p = tid;
      int ix = ((layer * 2 + dir) * 24 + g) * 64 + p;
      float are = P.a_re[ix], aim = P.a_im[ix], dt = expf(P.log_dt[(layer * 2 + dir) * 24 + g]);
      float pr, pi;
      lam_pow(are, aim, dt, dir == 0 ? j + 1 : 32 - j, pr, pi);
      sP[p * 2] = pr;
      sP[p * 2 + 1] = pi;
      if (j == 0) {
        float tr, ti;
        lam_pow(are, aim, dt, 32, tr, ti);
        P.lamT()[((dir * 24 + g) * 64 + p) * 2] = tr;
        P.lamT()[((dir * 24 + g) * 64 + p) * 2 + 1] = ti;
      }
    }
    __syncthreads();
#pragma unroll
    for (int i = 0; i < 8; ++i) {
      int e = tid + 256 * i;
      int h = e >> 7, pc = e & 127, p = pc >> 1, ri = pc & 1;
      size_t ci = ((size_t)(((layer * 2 + dir) * 24 + g) * 16 + h)) * 64 + p;
      float cr = P.c_re[ci], cim = P.c_im[ci];
      float pr = sP[p * 2], pi = sP[p * 2 + 1];
      float v = ri == 0 ? (cr * pr - cim * pi) : -(cr * pi + cim * pr);
      P.A_out()[((size_t)(g * 512 + j * 16 + h)) * 768 + 512 + dir * 128 + pc] = f2bf(v);
    }
    __syncthreads();
    return;
  }
  job -= PREP_WC;
  if (job < PREP_WE) {
    const int jq = job & 7, dir = (job >> 3) & 1, g = job >> 4;
    float* sP = sf;
    {
      int jj = tid >> 6, p = tid & 63;
      int j = jq * 4 + jj;
      int ix = ((layer * 2 + dir) * 24 + g) * 64 + p;
      float are = P.a_re[ix], aim = P.a_im[ix], dt = expf(P.log_dt[(layer * 2 + dir) * 24 + g]);
      float pr, pi, fr, fi;
      lam_pow(are, aim, dt, dir == 0 ? 31 - j : j, pr, pi);
      zoh_factor(are, aim, dt, fr, fi);
      sP[(jj * 64 + p) * 2] = pr * fr - pi * fi;
      sP[(jj * 64 + p) * 2 + 1] = pr * fi + pi * fr;
    }
    __syncthreads();
    {
      const int prow = tid >> 1, half = tid & 1, p = prow >> 1, ri = prow & 1;
      const size_t bbase = ((size_t)(((layer * 2 + dir) * 24 + g) * 64 + p)) * 16;
      u16* dst = P.A_end() + ((size_t)(g * 256 + dir * 128 + prow)) * 512 + jq * 64 + half * 32;
#pragma unroll
      for (int q = 0; q < 2; ++q) {
        int jj = half * 2 + q;
        float pr = sP[(jj * 64 + p) * 2], pi = sP[(jj * 64 + p) * 2 + 1];
        unsigned pk[8];
#pragma unroll
        for (int h2 = 0; h2 < 8; ++h2) {
          float b0r = P.b_re[bbase + 2 * h2], b0i = P.b_im[bbase + 2 * h2];
          float b1r = P.b_re[bbase + 2 * h2 + 1], b1i = P.b_im[bbase + 2 * h2 + 1];
          float v0 = ri == 0 ? (pr * b0r - pi * b0i) : (pr * b0i + pi * b0r);
          float v1 = ri == 0 ? (pr * b1r - pi * b1i) : (pr * b1i + pi * b1r);
          pk[h2] = pack2(v0, v1);
        }
        *(uint4*)(dst + q * 16) = make_uint4(pk[0], pk[1], pk[2], pk[3]);
        *(uint4*)(dst + q * 16 + 8) = make_uint4(pk[4], pk[5], pk[6], pk[7]);
      }
    }
    __syncthreads();
    return;
  }
  job -= PREP_WE;
  {
    const int nb = job & 7, g = (job >> 3) & 3, ri = job >> 5;
    const float* wf = P.w_fourier + (size_t)layer * 256 * 256;
    const int n = nb * 32 + (tid >> 3), jg = tid & 7;
    unsigned pk[4];
#pragma unroll
    for (int jp = 0; jp < 4; ++jp) {
      float sum2[2];
#pragma unroll
      for (int q = 0; q < 2; ++q) {
        int j = jg * 8 + jp * 2 + q;
        float sum = 0.f;
        for (int m = 0; m < 64; ++m) {
          float fr = (float)((m * j) & 63) * (1.f / 64.f);
          float tr = ri ? hw_sin_rev(fr) : hw_cos_rev(fr);
          sum += tr * wf[(size_t)(g * 64 + m) * 256 + n];
        }
        sum2[q] = sum;
      }
      pk[jp] = pack2(sum2[0], sum2[1]);
    }
    *(uint4*)(P.MWt() + (size_t)n * 512 + ri * 256 + g * 64 + jg * 8) = make_uint4(pk[0], pk[1], pk[2], pk[3]);
  }
}

DEV void expand_job(const Params& P, int job) {
  const int tid = g_tid();
  const int g = job >> 5, t = job & 31;
  const int h = tid >> 4, cgp = tid & 15;
  u16* dst = P.A_out() + ((size_t)(g * 512 + t * 16 + h)) * 768 + cgp * 32;
#pragma unroll
  for (int q = 0; q < 2; ++q) {
    int sidx = cgp * 2 + q;
    int dI = t - sidx + 31;
    const float4* src = (const float4*)(P.Ktau() + ((size_t)(g * 63 + dI)) * 256 + h * 16);
    float4 a = src[0], b = src[1], c = src[2], d = src[3];
    *(uint4*)(dst + q * 16) = make_uint4(pack2(a.x, a.y), pack2(a.z, a.w), pack2(b.x, b.y), pack2(b.z, b.w));
    *(uint4*)(dst + q * 16 + 8) = make_uint4(pack2(c.x, c.y), pack2(c.z, c.w), pack2(d.x, d.y), pack2(d.z, d.w));
  }
}

constexpr int CONST_MOD = 384, CONST_D128 = 16, CONST_D256 = 64, CONST_T = 1024;
constexpr int CONST_N = CONST_MOD + CONST_D128 + CONST_D256 + CONST_T;

DEV void const_job(const Params& P, int job, char* smem) {
  const int tid = g_tid();
  if (job < CONST_MOD) {
    const int layer = job / 192, cb = job % 192;
    float* sv = (float*)smem;
    float* red = sv + 3 * 1024;
    for (int i = tid; i < 3 * 1024; i += 256) {
      int v = i >> 10, k = i & 1023;
      float cv = v < 2 ? P.c[v * 1024 + k] : P.c_ctx[k];
      sv[i] = cv / (1.f + __expf(-cv));
    }
    __syncthreads();
    const int kg = tid >> 5, cl = tid & 31;
    const int n = cb * 32 + cl;
    const float* W = P.w_mod + (size_t)layer * DM * 6144 + n;
    float a0 = 0.f, a1 = 0.f, a2 = 0.f;
#pragma unroll 16
    for (int k = kg * 128; k < kg * 128 + 128; ++k) {
      float wv = W[(size_t)k * 6144];
      a0 += sv[k] * wv;
      a1 += sv[1024 + k] * wv;
      a2 += sv[2048 + k] * wv;
    }
    red[(kg * 3 + 0) * 32 + cl] = a0;
    red[(kg * 3 + 1) * 32 + cl] = a1;
    red[(kg * 3 + 2) * 32 + cl] = a2;
    __syncthreads();
    if (tid < 96) {
      int v = tid >> 5, c2 = tid & 31;
      float s = P.b_mod[layer * 6144 + cb * 32 + c2];
      for (int q = 0; q < 8; ++q) s += red[(q * 3 + v) * 32 + c2];
      P.mod()[(layer * 3 + v) * 6144 + cb * 32 + c2] = s;
    }
    __syncthreads();
    return;
  }
  job -= CONST_MOD;
  if (job < CONST_D128) {
#pragma unroll
    for (int i = 0; i < 8; ++i) {
      int idx = job * 2048 + tid + 256 * i;
      int row = idx >> 7, r = idx & 127;
      int k1 = row >> 1, ri = row & 1;
      float fr = (float)((k1 * r) & 127) * (1.f / 128.f);
      P.D128()[idx] = f2bf(ri ? -hw_sin_rev(fr) : hw_cos_rev(fr));
    }
    return;
  }
  job -= CONST_D128;
  if (job < CONST_D256) {
#pragma unroll
    for (int i = 0; i < 8; ++i) {
      int idx = job * 2048 + tid + 256 * i;
      int row = idx >> 8, l = idx & 255;
      int k = row >> 1, ri = row & 1;
      float fr = (float)((k * l) & 255) * (1.f / 256.f);
      P.D256()[idx] = f2bf(ri ? -hw_sin_rev(fr) : hw_cos_rev(fr));
    }
    return;
  }
  job -= CONST_D256;
  {
#pragma unroll
    for (int i = 0; i < 8; ++i) {
      int idx = job * 2048 + tid + 256 * i;
      int k1 = idx >> 14, row = (idx >> 7) & 127, col = idx & 127;
      int k2 = row >> 1, ri = row & 1, cc = col >> 1, rj = col & 1;
      float fr = (float)((cc * (k1 + 128 * k2)) & 8191) * (1.f / 8192.f);
      float cs = hw_cos_rev(fr), sn = hw_sin_rev(fr);
      float v = (ri == rj) ? cs : (ri == 0 ? sn : -sn);
      P.Tmat()[idx] = f2bf(v);
    }
  }
}

DEV float4 ld4(const float* p) { return *(const float4*)p; }
DEV float4 ldbf4(const u16* p) {
  uint2 v = *(const uint2*)p;
  return make_float4(bf2f((u16)(v.x & 0xffff)), bf2f((u16)(v.x >> 16)), bf2f((u16)(v.y & 0xffff)), bf2f((u16)(v.y >> 16)));
}
DEV float sq4(float4 v) { return v.x * v.x + v.y * v.y + v.z * v.z + v.w * v.w; }

constexpr int NR = 4;
DEV void rowop(const Params& P, int kind, int layer, int m0, int lane) {
  const bool last = layer == 1;
  if (kind == 2 && last && m0 >= NLAT) return;
  const int mi = m0 < NLAT ? (m0 >> 13) : 2;
  float* resid = m0 < NLAT ? P.out + (size_t)m0 * DM : P.xctx() + (size_t)(m0 - NLAT) * DM;
  const float* xin;
  if (kind == 0 || (kind == 1 && layer == 0))
    xin = m0 < NLAT ? P.x + (size_t)m0 * DM : P.ctx + (size_t)(m0 - NLAT) * DM;
  else
    xin = resid;
  const float* modv = P.mod() + (size_t)(layer * 3 + mi) * 6144;
  float4 v[NR][4];
#pragma unroll
  for (int r = 0; r < NR; ++r)
#pragma unroll
    for (int i = 0; i < 4; ++i) v[r][i] = ld4(xin + (size_t)r * DM + i * 256 + lane * 4);
  if (kind != 0) {
    const float* gpost = (kind == 1 ? P.g_post_mix : P.g_post_ffn) + layer * DM;
    const float* gate = modv + (kind == 1 ? 2048 : 5120);
    float4 o[NR][4];
    float ss[NR];
#pragma unroll
    for (int r = 0; r < NR; ++r) {
      ss[r] = 0.f;
#pragma unroll
      for (int i = 0; i < 4; ++i) {
        o[r][i] = ldbf4(P.obuf() + (size_t)(m0 + r) * DM + i * 256 + lane * 4);
        ss[r] += sq4(o[r][i]);
      }
    }
    float rinv[NR];
#pragma unroll
    for (int r = 0; r < NR; ++r) rinv[r] = rsqrtf(wave_sum(ss[r]) * (1.f / DM) + EPS);
#pragma unroll
    for (int i = 0; i < 4; ++i) {
      float4 gp = ld4(gpost + i * 256 + lane * 4), gt = ld4(gate + i * 256 + lane * 4);
#pragma unroll
      for (int r = 0; r < NR; ++r) {
        v[r][i].x += gt.x * (o[r][i].x * rinv[r] * gp.x);
        v[r][i].y += gt.y * (o[r][i].y * rinv[r] * gp.y);
        v[r][i].z += gt.z * (o[r][i].z * rinv[r] * gp.z);
        v[r][i].w += gt.w * (o[r][i].w * rinv[r] * gp.w);
      }
    }
    float* dst = (kind == 2 && last) ? P.out + (size_t)m0 * DM : resid;
#pragma unroll
    for (int r = 0; r < NR; ++r)
#pragma unroll
      for (int i = 0; i < 4; ++i) *(float4*)(dst + (size_t)r * DM + i * 256 + lane * 4) = v[r][i];
    if (kind == 2 && last) return;
  }
  const int la = kind == 2 ? layer + 1 : layer;
  const float* gpre = (kind == 1 ? P.g_pre_ffn : P.g_pre_mix) + la * DM;
  const float* mv = P.mod() + (size_t)(la * 3 + mi) * 6144;
  const float* sh = mv + (kind == 1 ? 3072 : 0);
  const float* sc = mv + (kind == 1 ? 4096 : 1024);
  float rinv2[NR];
#pragma unroll
  for (int r = 0; r < NR; ++r) {
    float ss = 0.f;
#pragma unroll
    for (int i = 0; i < 4; ++i) ss += sq4(v[r][i]);
    rinv2[r] = rsqrtf(wave_sum(ss) * (1.f / DM) + EPS);
  }
#pragma unroll
  for (int i = 0; i < 4; ++i) {
    int col = i * 256 + lane * 4;
    float4 gp = ld4(gpre + col), s1 = ld4(sc + col), s0 = ld4(sh + col);
#pragma unroll
    for (int r = 0; r < NR; ++r)
      store_bf4(P.abuf() + (size_t)(m0 + r) * DM + col, v[r][i].x * rinv2[r] * gp.x * (1.f + s1.x) + s0.x,
                v[r][i].y * rinv2[r] * gp.y * (1.f + s1.y) + s0.y, v[r][i].z * rinv2[r] * gp.z * (1.f + s1.z) + s0.z,
                v[r][i].w * rinv2[r] * gp.w * (1.f + s1.w) + s0.w);
  }
}

DEV void attn_wave(const Params& P, int layer, bool isctx, int b, int h, int r, int cgp, int lane) {
  const int qi = lane & 15, g = lane >> 4;
  int mq, c = 0, cs = 0, cb = 0, rs = 0;
  if (!isctx) {
    c = cgp * 16 + qi;
    mq = b * SEQ + r * 64 + c;
    cs = c - 8;
    cs = cs < 0 ? 0 : (cs > 48 ? 48 : cs);
    cb = cgp == 0 ? 0 : (cgp == 1 ? 8 : (cgp == 2 ? 24 : 32));
    rs = r - 4;
    rs = rs < 0 ? 0 : (rs > 120 ? 120 : rs);
  } else {
    mq = NLAT + b * LCX + cgp * 16 + qi;
  }
  const u16* qp = P.qbuf() + (size_t)mq * 384 + h * 64 + g * 8;
  const bf16x8 qf0 = *(const bf16x8*)qp, qf1 = *(const bf16x8*)(qp + 32);
  f32x4 o[4];
#pragma unroll
  for (int d = 0; d < 4; ++d) o[d] = f32x4{0.f, 0.f, 0.f, 0.f};
  float mrun = -1e30f, lrun = 0.f;
  const float* rp = P.rpb + (size_t)(layer * 6 + h) * 465;
  const int nblk = isctx ? 8 : 16;
  for (int kb = 0; kb < nblk; ++kb) {
    const bool win = (!isctx) && kb < 8;
    size_t krow0;
    const u16* vbase;
    int vld;
    if (win) {
      int tok0 = (rs + kb) * 64 + cb;
      krow0 = (size_t)b * SEQ + tok0;
      vbase = P.vT() + ((size_t)(b * 384 + h * 64)) * SEQ + tok0;
      vld = SEQ;
    } else {
      int kc = (isctx ? kb : kb - 8) * 32;
      krow0 = (size_t)NLAT + b * LCX + kc;
      vbase = P.vTc() + ((size_t)(b * 384 + h * 64)) * LCX + kc;
      vld = LCX;
    }
    f32x4 s[2];
#pragma unroll
    for (int t = 0; t < 2; ++t) {
      const u16* kp = P.kbuf() + (krow0 + t * 16 + qi) * 384 + h * 64 + g * 8;
      bf16x8 k0 = *(const bf16x8*)kp, k1 = *(const bf16x8*)(kp + 32);
      f32x4 z = {0.f, 0.f, 0.f, 0.f};
      z = __builtin_amdgcn_mfma_f32_16x16x32_bf16(k0, qf0, z, 0, 0, 0);
      s[t] = __builtin_amdgcn_mfma_f32_16x16x32_bf16(k1, qf1, z, 0, 0, 0);
    }
    if (win) {
      const int dr = rs + kb - r + 7;
#pragma unroll
      for (int t = 0; t < 2; ++t)
#pragma unroll
        for (int i = 0; i < 4; ++i) {
          int keycol = cb + t * 16 + g * 4 + i;
          bool valid = keycol >= cs && keycol < cs + 16;
          int dc = keycol - c + 15;
          dc = dc < 0 ? 0 : (dc > 30 ? 30 : dc);
          float bias = rp[dr * 31 + dc];
          s[t][i] = valid ? s[t][i] + bias : -1e30f;
        }
    }
    float mx = fmaxf(fmaxf(fmaxf(s[0][0], s[0][1]), fmaxf(s[0][2], s[0][3])),
                     fmaxf(fmaxf(s[1][0], s[1][1]), fmaxf(s[1][2], s[1][3])));
    mx = fmaxf(mx, __shfl_xor(mx, 16));
    mx = fmaxf(mx, __shfl_xor(mx, 32));
    const float mnew = fmaxf(mrun, mx);
    const float alpha = __expf(mrun - mnew);
    mrun = mnew;
    float p[8], psum = 0.f;
#pragma unroll
    for (int t = 0; t < 2; ++t)
#pragma unroll
      for (int i = 0; i < 4; ++i) {
        p[t * 4 + i] = __expf(s[t][i] - mnew);
        psum += p[t * 4 + i];
      }
    lrun = lrun * alpha + psum;
    bf16x8 pf;
#pragma unroll
    for (int e = 0; e < 8; ++e) pf[e] = (short)f2bf(p[e]);
#pragma unroll
    for (int d = 0; d < 4; ++d) {
      o[d] *= alpha;
      const u16* vp = vbase + (size_t)(d * 16 + qi) * vld + g * 4;
      uint2 v0 = *(const uint2*)vp, v1 = *(const uint2*)(vp + 16);
      union { uint4 u; bf16x8 v; } cv;
      cv.u = make_uint4(v0.x, v0.y, v1.x, v1.y);
      o[d] = __builtin_amdgcn_mfma_f32_16x16x32_bf16(cv.v, pf, o[d], 0, 0, 0);
    }
  }
  float l = lrun + __shfl_xor(lrun, 16);
  l += __shfl_xor(l, 32);
  const float inv = 1.f / l;
#pragma unroll
  for (int d = 0; d < 4; ++d)
    store_bf4(P.ycat() + (size_t)mq * DM + 640 + h * 64 + d * 16 + g * 4, o[d][0] * inv, o[d][1] * inv, o[d][2] * inv,
              o[d][3] * inv);
}

DEV void carry_wave(const Params& P, int wjob, int lane) {
  const int pg = wjob & 7;
  int combo = wjob >> 3;
  const int g = combo % 24;
  combo /= 24;
  const int dir = combo & 1, b = combo >> 1;
  const int p = pg * 8 + (lane & 7), seg = lane >> 3;
  const float lr = P.lamT()[((dir * 24 + g) * 64 + p) * 2], li = P.lamT()[((dir * 24 + g) * 64 + p) * 2 + 1];
  auto chunk_of = [&](int n) {
    if (n < 8) return 512 + b * 8 + (dir ? 7 - n : n);
    int c = n - 8;
    return b * 256 + (dir ? 255 - c : c);
  };
  float cr = 0.f, ci = 0.f;
#pragma unroll 1
  for (int bt = 0; bt < 3; ++bt) {
    float2 e[11];
#pragma unroll
    for (int i = 0; i < 11; ++i) {
      size_t row = (size_t)(g * NCH + chunk_of(seg * 33 + bt * 11 + i));
      e[i] = *(const float2*)(P.E() + row * 256 + dir * 128 + p * 2);
    }
#pragma unroll
    for (int i = 0; i < 11; ++i) {
      float nr = lr * cr - li * ci + e[i].x, ni = lr * ci + li * cr + e[i].y;
      cr = nr;
      ci = ni;
    }
  }
  float sr = lr, si = li;
#pragma unroll
  for (int k = 0; k < 5; ++k) {
    float t = sr * sr - si * si;
    si = 2.f * sr * si;
    sr = t;
  }
  const float l33r = sr * lr - si * li, l33i = sr * li + si * lr;
  float stR = 0.f, stI = 0.f;
#pragma unroll
  for (int k = 1; k < 8; ++k) {
    int src = (lane - 8) & 63;
    float pr_ = __shfl(stR, src), pi_ = __shfl(stI, src), er = __shfl(cr, src), ei = __shfl(ci, src);
    if (seg == k) {
      stR = l33r * pr_ - l33i * pi_ + er;
      stI = l33r * pi_ + l33i * pr_ + ei;
    }
  }
  cr = stR;
  ci = stI;
#pragma unroll 1
  for (int bt = 0; bt < 3; ++bt) {
    float2 e[11];
#pragma unroll
    for (int i = 0; i < 11; ++i) {
      size_t row = (size_t)(g * NCH + chunk_of(seg * 33 + bt * 11 + i));
      e[i] = *(const float2*)(P.E() + row * 256 + dir * 128 + p * 2);
    }
#pragma unroll
    for (int i = 0; i < 11; ++i) {
      size_t row = (size_t)(g * NCH + chunk_of(seg * 33 + bt * 11 + i));
      *(unsigned*)(P.UB() + row * 768 + 512 + dir * 128 + p * 2) = pack2(cr, ci);
      float nr = lr * cr - li * ci + e[i].x, ni = lr * ci + li * cr + e[i].y;
      cr = nr;
      ci = ni;
    }
  }
}

DEV void run_phase(const Params& P, int ph, int bid, int nblk, char* smem) {
  const int lane = g_tid() & 63, w = g_tid() >> 6;
  if (ph == 0) {
    for (int job = bid; job < CONST_N + PREP_N; job += nblk) {
      if (job < CONST_N) const_job(P, job, smem);
      else prep_job(P, 0, job - CONST_N, smem);
    }
    return;
  }
  if (ph == 1) {
    for (int job = bid; job < MR / 16 + EXPAND_N; job += nblk) {
      if (job < MR / 16) rowop(P, 0, 0, (job * 4 + w) * NR, lane);
      else expand_job(P, job - MR / 16);
    }
    return;
  }
  const int layer = (ph - 2) / 10, sub = (ph - 2) % 10;
  switch (sub) {
    case 0: {
      EpiInproj epi{P};
      big_gemm_phase<2>(P.wt_in(), DM, P.abuf(), DM, DM, 7, 7, bid, nblk, smem, epi);
      if (layer == 1)
        for (int job = bid; job < EXPAND_N; job += nblk) expand_job(P, job);
    } break;
    case 1: {
      const int J0 = 1536, J1 = J0 + 48, J2 = J1 + 240, J3 = J2 + 512, J4 = J3 + 16;
      for (int job = bid; job < J4; job += nblk) {
        if (job < J0) {
          int r = job & 127, bh = job >> 7;
          attn_wave(P, layer, false, bh / 6, bh % 6, r, w, lane);
        } else if (job < J1) {
          int j = job - J0;
          int qb = j & 3, bh = j >> 2;
          attn_wave(P, layer, true, bh / 6, bh % 6, 0, qb * 4 + w, lane);
        } else if (job < J2) {
          int j = job - J1;
          int g = j / 10, t = j % 10;
          EpiSsmEnd epi{P.E() + (size_t)g * NCH * 256};
          gemm_tile<0>(P.A_end() + (size_t)g * 256 * 512, 512, P.UB() + (size_t)g * NCH * 768, 768, 512, (t & 1) * 128,
                           (t >> 1) * 128, NCH, smem, epi);
        } else if (job < J3) {
          int j = job - J2;
          int b = j >> 8, t = j & 255;
          EpiFnetA epi{P.A1() + (size_t)b * 128 * 128 * 256};
          gemm_tile<1>(P.D128(), 128, P.fbuf() + (size_t)b * SEQ * 256, 64 * 256, 128, (t & 1) * 128, (t >> 1) * 128,
                          64 * 256, smem, epi);
        } else {
          int j = job - J3;
          int b = j >> 3, t = j & 7;
          EpiFnetCtx epi{P.Gbuf() + (size_t)(NLAT + b * LCX) * 512};
          gemm_tile<1>(P.D256(), 256, P.fbuf() + (size_t)(NLAT + b * LCX) * 256, 256, 256, (t & 3) * 128, (t >> 2) * 128,
                          256, smem, epi);
        }
      }
    } break;
    case 2: {
      for (int job = bid; job < 192; job += nblk) carry_wave(P, job * 4 + w, lane);
    } break;
    case 3: {
      for (int job = bid; job < 480 + 512; job += nblk) {
        if (job < 480) {
          int g = job / 20, t = job % 20;
          EpiSsmOut epi{P.zbuf(), g};
          gemm_tile<0>(P.A_out() + (size_t)g * 512 * 768, 768, P.UB() + (size_t)g * NCH * 768, 768, 768, (t & 3) * 128,
                       (t >> 2) * 128, NCH, smem, epi);
        } else {
          int j = job - 480;
          int bk = j >> 1, t = j & 1;
          int k1 = bk & 127, b = bk >> 7;
          EpiFnetC epi{P.Gbuf() + (size_t)(b * SEQ + k1) * 512};
          gemm_tile<1>(P.Tmat() + (size_t)k1 * 128 * 128, 128, P.A1() + (size_t)bk * 128 * 256, 256, 128, 0, t * 128, 256,
                       smem, epi);
        }
      }
    } break;
    case 4: {
      for (int job = bid; job < 396 + 264; job += nblk) {
        if (job < 396) {
          EpiGlu epi{P.zbuf(), P.ycat()};
          gemm_tile<2>(P.wt_glu(), 384, P.zbuf(), 384, 384, (job % 3) * 128, (job / 3) * 128, MR, smem, epi);
        } else {
          int j = job - 396;
          EpiStoreBf epi{P.ycat(), DM, 384};
          gemm_tile<0>(P.MWt(), 512, P.Gbuf(), 512, 512, (j & 1) * 128, (j >> 1) * 128, MR, smem, epi);
        }
      }
    } break;
    case 5: {
      EpiStoreBf epi{P.obuf(), DM, 0};
      big_gemm_phase<3>(P.wt_out(), DM, P.ycat(), DM, DM, 4, 4, bid, nblk, smem, epi);
    } break;
    case 6: {
      for (int job = bid; job < MR / 16; job += nblk) rowop(P, 1, layer, (job * 4 + w) * NR, lane);
    } break;
    case 7: {
      EpiGateUp epi{P.hidden()};
      big_gemm_phase<3>(P.wt_gu(), DM, P.abuf(), DM, DM, 22, 2, bid, nblk, smem, epi);
    } break;
    case 8: {
      EpiStoreBf epi{P.obuf(), DM, 0};
      big_gemm_phase<3>(P.wt_dn(), DFF, P.hidden(), DFF, DFF, 4, 4, bid, nblk, smem, epi);
    } break;
    case 9: {
      const int nrow = MR / 16;
      const int total = nrow + (layer == 0 ? PREP_N : 0);
      for (int job = bid; job < total; job += nblk) {
        if (job < nrow) rowop(P, 2, layer, (job * 4 + w) * NR, lane);
        else prep_job(P, 1, job - nrow, smem);
      }
    } break;
  }
}

#if MK_MULTI
__global__ void __launch_bounds__(256, 2) phase_kernel(Params P, int ph) {
  __shared__ __attribute__((aligned(16))) char smem[65536];
  run_phase(P, ph, blockIdx.x, gridDim.x, smem);
}
#else
#define XB_XCNT(j) (64 * (j))
#define XB_XSUB(j) (1024 + 64 * (j))
#define XB_XGEN(j) (2048 + 64 * (j))
#define XB_TOP 3072
#define XB_TOPGEN 3136
#define XB_WORDS 3200
DEV unsigned xb_ld(unsigned* p) { return __hip_atomic_load(p, __ATOMIC_RELAXED, __HIP_MEMORY_SCOPE_AGENT); }
DEV unsigned xb_add(unsigned* p, unsigned v) { return __hip_atomic_fetch_add(p, v, __ATOMIC_RELAXED, __HIP_MEMORY_SCOPE_AGENT); }

DEV void grid_barrier(unsigned* bar, unsigned k, unsigned xcc, unsigned nloc, unsigned nx) {
  asm volatile("s_waitcnt vmcnt(0)" ::: "memory");
  __syncthreads();
  if (threadIdx.x == 0) {
    const unsigned old = xb_add(&bar[XB_XSUB(xcc)], 1u);
    if (old + 1u == k * nloc) {
      __builtin_amdgcn_fence(__ATOMIC_RELEASE, "agent");
      asm volatile("s_waitcnt vmcnt(0)" ::: "memory");
      const unsigned og = xb_add(&bar[XB_TOP], 1u);
      if (og + 1u == k * nx) xb_add(&bar[XB_TOPGEN], 1u);
      else
        while (xb_ld(&bar[XB_TOPGEN]) < k) __builtin_amdgcn_s_sleep(4);
      __builtin_amdgcn_fence(__ATOMIC_ACQUIRE, "agent");
      xb_add(&bar[XB_XGEN(xcc)], 1u);
      asm volatile("s_waitcnt vmcnt(0)" ::: "memory");
    } else {
      while (xb_ld(&bar[XB_XGEN(xcc)]) < k) __builtin_amdgcn_s_sleep(8);
      __builtin_amdgcn_fence(__ATOMIC_ACQUIRE, "agent");
      asm volatile("s_waitcnt vmcnt(0)" ::: "memory");
    }
  }
  __syncthreads();
}

__global__ void __launch_bounds__(256) fwd_megakernel(Params P, unsigned* bar) {
  __shared__ __attribute__((aligned(16))) char smem[65536];
  cg::grid_group grid = cg::this_grid();
  const unsigned xcc = (unsigned)__builtin_amdgcn_s_getreg((3 << 11) | 20) & 0xFu;
  if (threadIdx.x == 0) xb_add(&bar[XB_XCNT(xcc)], 1u);
  __threadfence();
  grid.sync();
  unsigned nloc = 0, nx = 0;
#pragma unroll
  for (unsigned j = 0; j < 16; ++j) {
    const unsigned c = xb_ld(&bar[XB_XCNT(j)]);
    nx += c > 0u ? 1u : 0u;
    nloc = j == xcc ? c : nloc;
  }
  nloc = __builtin_amdgcn_readfirstlane(nloc);
  nx = __builtin_amdgcn_readfirstlane(nx);
  unsigned round = 0;
  for (int ph = 0; ph < NPH; ++ph) {
    int bid = blockIdx.x;
    asm volatile("" : "+s"(bid));
    run_phase(P, ph, bid, gridDim.x, smem);
#ifdef PROBE_DUP
    {
      const int sub = ph < 2 ? 10 + ph : (ph - 2) % 10;
      if ((PROBE_DUP >> sub) & 1) {
        grid_barrier(bar, ++round, xcc, nloc, nx);
        asm volatile("" : "+s"(bid));
        run_phase(P, ph, bid, gridDim.x, smem);
      }
    }
#endif
    if (ph + 1 < NPH) grid_barrier(bar, ++round, xcc, nloc, nx);
  }
}
#endif

extern "C" void kernel_launch(void* const* d_in, const int* in_sizes, int n_in, void* d_out, int out_size, void* d_ws,
                              size_t ws_size, hipStream_t stream) {
  Params p{};
  const float* const* in = (const float* const*)d_in;
  p.x = in[0]; p.c = in[1]; p.ctx = in[2]; p.c_ctx = in[3]; p.w_mod = in[4]; p.b_mod = in[5];
  p.g_pre_mix = in[6]; p.g_post_mix = in[7]; p.w_in = in[8]; p.a_re = in[9]; p.a_im = in[10]; p.log_dt = in[11];
  p.b_re = in[12]; p.b_im = in[13]; p.c_re = in[14]; p.c_im = in[15]; p.ssm_d = in[16]; p.w_glu = in[17];
  p.w_fourier = in[18]; p.rpb = in[19]; p.w_out = in[20]; p.g_pre_ffn = in[21]; p.g_post_ffn = in[22];
  p.w_gate = in[23]; p.w_up = in[24]; p.w_down = in[25];
  p.out = (float*)d_out;
  p.ws = (char*)d_ws;
  if (WS_NEED > ws_size) {
    fprintf(stderr, "workspace too small: need %zu have %zu\n", (size_t)WS_NEED, ws_size);
    return;
  }
  unsigned* bar = (unsigned*)(p.ws + O_bar);
#if MK_MULTI
  for (int ph = 0; ph < NPH; ++ph) phase_kernel<<<dim3(1024), dim3(256), 0, stream>>>(p, ph);
#else
  static int grid_blocks = 0;
  if (!grid_blocks) {
    int dev = 0, cus = 0, per_cu = 0;
    hipGetDevice(&dev);
    hipDeviceGetAttribute(&cus, hipDeviceAttributeMultiprocessorCount, dev);
    hipOccupancyMaxActiveBlocksPerMultiprocessor(&per_cu, fwd_megakernel, 256, 0);
    if (per_cu > 2) per_cu = 2;
    grid_blocks = cus * per_cu;
  }
  hipMemsetAsync(bar, 0, XB_WORDS * 4, stream);
  void* args[] = {&p, &bar};
  hipError_t e = hipLaunchCooperativeKernel((void*)fwd_megakernel, dim3(grid_blocks), dim3(256), args, 0, stream);
  if (e != hipSuccess) fprintf(stderr, "cooperative launch failed: %s (grid %d)\n", hipGetErrorString(e), grid_blocks);
#endif
}
```

```cpp
#include <hip/hip_runtime.h>
#include <hip/hip_bf16.h>
#include <hip/hip_cooperative_groups.h>
#include <cstdio>
#include <cstdint>
namespace cg = cooperative_groups;

#ifndef MK_MULTI
#define MK_MULTI 0
#endif

typedef __attribute__((ext_vector_type(8))) short bf16x8;
typedef __attribute__((ext_vector_type(4))) float f32x4;
typedef __attribute__((ext_vector_type(16))) float f32x16;
typedef unsigned short u16;
typedef __attribute__((ext_vector_type(4))) unsigned u32x4;

#define DEV __device__ __forceinline__


constexpr int DM = 1024, SEQ = 8192, LCX = 256;
constexpr int NLAT = 2 * SEQ, NCTX = 2 * LCX, MR = NLAT + NCTX;
constexpr int INW = 1792, DFF = 2816;
constexpr int TCH = 32, NCH = MR / TCH;
constexpr int NPH = 22;
constexpr float EPS = 1e-6f;

constexpr size_t al256(size_t x) { return (x + 255) & ~(size_t)255; }
constexpr size_t O_wt_in = 0;
constexpr size_t O_wt_out = O_wt_in + al256((size_t)INW * DM * 2);
constexpr size_t O_wt_glu = O_wt_out + al256((size_t)DM * DM * 2);
constexpr size_t O_wt_gu = O_wt_glu + al256((size_t)384 * 384 * 2);
constexpr size_t O_wt_dn = O_wt_gu + al256((size_t)2 * DFF * DM * 2);
constexpr size_t O_A_out = O_wt_dn + al256((size_t)DM * DFF * 2);
constexpr size_t O_A_end = O_A_out + al256((size_t)24 * 512 * 768 * 2);
constexpr size_t O_D128 = O_A_end + al256((size_t)24 * 256 * 512 * 2);
constexpr size_t O_D256 = O_D128 + al256(256 * 128 * 2);
constexpr size_t O_Tmat = O_D256 + al256(512 * 256 * 2);
constexpr size_t O_MWt = O_Tmat + al256((size_t)128 * 128 * 128 * 2);
constexpr size_t O_lamT = O_MWt + al256(256 * 512 * 2);
constexpr size_t O_Ktau = O_lamT + al256(2 * 24 * 64 * 2 * 4);
constexpr size_t O_mod = O_Ktau + al256((size_t)24 * 63 * 256 * 4);
constexpr size_t O_abuf = O_mod + al256(2 * 3 * 6144 * 4);
constexpr size_t O_xctx = O_abuf + al256((size_t)MR * DM * 2);
constexpr size_t O_bar = O_xctx + al256((size_t)NCTX * DM * 4);
constexpr size_t O_R = O_bar + al256(16384);
constexpr size_t O_ycat = O_R;
constexpr size_t O_UB = O_ycat + al256((size_t)MR * DM * 2);
constexpr size_t O_fbuf = O_UB + al256((size_t)24 * NCH * 768 * 2);
constexpr size_t O_qbuf = O_fbuf + al256((size_t)MR * 256 * 2);
constexpr size_t O_kbuf = O_qbuf + al256((size_t)MR * 384 * 2);
constexpr size_t O_vT = O_kbuf + al256((size_t)MR * 384 * 2);
constexpr size_t O_vTc = O_vT + al256((size_t)2 * 384 * SEQ * 2);
constexpr size_t O_E = O_vTc + al256((size_t)2 * 384 * LCX * 2);
constexpr size_t O_A1 = O_E + al256((size_t)24 * NCH * 256 * 4);
constexpr size_t O_Gbuf = O_A1 + al256((size_t)2 * 128 * 128 * 256 * 2);
constexpr size_t O_Rend = O_Gbuf + al256((size_t)MR * 512 * 2);
constexpr size_t O_zbuf = O_qbuf;
constexpr size_t O_hidden = O_R;
constexpr size_t O_obuf = O_R + al256((size_t)MR * DFF * 2);
constexpr size_t O_obuf_end = O_obuf + al256((size_t)MR * DM * 2);
constexpr size_t WS_NEED = O_Rend > O_obuf_end ? O_Rend : O_obuf_end;

struct Params {
  const float *x, *c, *ctx, *c_ctx, *w_mod, *b_mod, *g_pre_mix, *g_post_mix, *w_in;
  const float *a_re, *a_im, *log_dt, *b_re, *b_im, *c_re, *c_im, *ssm_d, *w_glu, *w_fourier, *rpb, *w_out;
  const float *g_pre_ffn, *g_post_ffn, *w_gate, *w_up, *w_down;
  float* out;
  char* ws;
  DEV u16* wt_in() const { return (u16*)(ws + O_wt_in); }
  DEV u16* wt_out() const { return (u16*)(ws + O_wt_out); }
  DEV u16* wt_glu() const { return (u16*)(ws + O_wt_glu); }
  DEV u16* wt_gu() const { return (u16*)(ws + O_wt_gu); }
  DEV u16* wt_dn() const { return (u16*)(ws + O_wt_dn); }
  DEV u16* A_out() const { return (u16*)(ws + O_A_out); }
  DEV u16* A_end() const { return (u16*)(ws + O_A_end); }
  DEV u16* D128() const { return (u16*)(ws + O_D128); }
  DEV u16* D256() const { return (u16*)(ws + O_D256); }
  DEV u16* Tmat() const { return (u16*)(ws + O_Tmat); }
  DEV u16* MWt() const { return (u16*)(ws + O_MWt); }
  DEV u16* abuf() const { return (u16*)(ws + O_abuf); }
  DEV u16* UB() const { return (u16*)(ws + O_UB); }
  DEV u16* fbuf() const { return (u16*)(ws + O_fbuf); }
  DEV u16* qbuf() const { return (u16*)(ws + O_qbuf); }
  DEV u16* kbuf() const { return (u16*)(ws + O_kbuf); }
  DEV u16* vT() const { return (u16*)(ws + O_vT); }
  DEV u16* vTc() const { return (u16*)(ws + O_vTc); }
  DEV u16* zbuf() const { return (u16*)(ws + O_zbuf); }
  DEV u16* A1() const { return (u16*)(ws + O_A1); }
  DEV u16* Gbuf() const { return (u16*)(ws + O_Gbuf); }
  DEV u16* ycat() const { return (u16*)(ws + O_ycat); }
  DEV u16* obuf() const { return (u16*)(ws + O_obuf); }
  DEV u16* hidden() const { return (u16*)(ws + O_hidden); }
  DEV float* lamT() const { return (float*)(ws + O_lamT); }
  DEV float* mod() const { return (float*)(ws + O_mod); }
  DEV float* xctx() const { return (float*)(ws + O_xctx); }
  DEV float* E() const { return (float*)(ws + O_E); }
  DEV float* Ktau() const { return (float*)(ws + O_Ktau); }
};

DEV int g_tid() { int t = threadIdx.x; asm volatile("" : "+v"(t)); return t; }
DEV u16 f2bf(float f) { unsigned u = __float_as_uint(f); u += 0x7fffu + ((u >> 16) & 1u); return (u16)(u >> 16); }
DEV float bf2f(u16 h) { return __uint_as_float(((unsigned)h) << 16); }
DEV unsigned pack2(float a, float b) { return (unsigned)f2bf(a) | ((unsigned)f2bf(b) << 16); }
DEV void store_bf4(u16* p, float a, float b, float c, float d) { uint2 v; v.x = pack2(a, b); v.y = pack2(c, d); *(uint2*)p = v; }
DEV float wave_sum(float v) {
#pragma unroll
  for (int o = 32; o >= 1; o >>= 1) v += __shfl_xor(v, o);
  return v;
}
DEV float hw_sin_rev(float r) { return __builtin_amdgcn_sinf(r); }
DEV float hw_cos_rev(float r) { return __builtin_amdgcn_cosf(r); }

template <int BMODE, class Epi>
DEV void gemm_tile(const u16* A, int lda, const u16* B, int ldb, int K, int n0, int m0, int mmax, char* smem,
                   const Epi& epi) {
  const int tid = g_tid(), lane = tid & 63, w = tid >> 6;
  const int wn = w & 1, wm = w >> 1;
  f32x16 acc[2][2];
#pragma unroll
  for (int i = 0; i < 2; ++i)
#pragma unroll
    for (int j = 0; j < 2; ++j)
#pragma unroll
      for (int r = 0; r < 16; ++r) acc[i][j][r] = 0.f;
#define GT_GL1(S, I, K0)                                                                                  \
  {                                                                                                        \
    const int id = tid + 256 * (I);                                                                        \
    const int r = id >> 3, ch = id & 7;                                                                    \
    S##a##I = *(const u32x4*)(A + (size_t)(n0 + r) * lda + (K0) + ch * 8);                                 \
    if (BMODE == 0) {                                                                                      \
      int m = m0 + r;                                                                                      \
      m = m < mmax ? m : mmax - 1;                                                                         \
      S##b##I = *(const u32x4*)(B + (size_t)m * ldb + (K0) + ch * 8);                                      \
    } else if (BMODE == 2) {                                                                               \
      const int k = (K0) + ch * 8;                                                                         \
      S##b##I = *(const u32x4*)(B + ((size_t)(k >> 4) * MR + (m0 + r)) * 16 + (k & 15));                   \
    } else {                                                                                               \
      const int kk = id >> 4, nch = id & 15;                                                               \
      S##b##I = *(const u32x4*)(B + (size_t)((K0) + kk) * ldb + m0 + nch * 8);                             \
    }                                                                                                      \
  }
#define GT_GLOAD(S, K0) GT_GL1(S, 0, K0) GT_GL1(S, 1, K0) GT_GL1(S, 2, K0) GT_GL1(S, 3, K0)
#define GT_SS1(S, I, BUF)                                                                                 \
  {                                                                                                        \
    char* sa = smem + (BUF) * 32768;                                                                       \
    char* sb = sa + 16384;                                                                                 \
    const int id = tid + 256 * (I);                                                                        \
    const int r = id >> 3, ch = id & 7;                                                                    \
    *(u32x4*)(sa + r * 128 + ((ch ^ (r & 7)) << 4)) = S##a##I;                                             \
    if (BMODE != 1) {                                                                                      \
      *(u32x4*)(sb + r * 128 + ((ch ^ (r & 7)) << 4)) = S##b##I;                                           \
    } else {                                                                                               \
      const int kk = id >> 4, nch = id & 15;                                                               \
      _Pragma("unroll") for (int e = 0; e < 8; ++e) {                                                      \
        unsigned wd = S##b##I[e >> 1];                                                                     \
        u16 v = (u16)((e & 1) ? (wd >> 16) : (wd & 0xffffu));                                              \
        int n = nch * 8 + e;                                                                               \
        *(u16*)(sb + n * 128 + ((((kk >> 3) ^ (n & 7)) << 4) + (kk & 7) * 2)) = v;                         \
      }                                                                                                    \
    }                                                                                                      \
  }
#define GT_SSTORE(S, BUF) GT_SS1(S, 0, BUF) GT_SS1(S, 1, BUF) GT_SS1(S, 2, BUF) GT_SS1(S, 3, BUF)
  u32x4 pa0, pa1, pa2, pa3, pb0, pb1, pb2, pb3, qa0, qa1, qa2, qa3, qb0, qb1, qb2, qb3;
  const unsigned lds0 = (unsigned)(uintptr_t)((__attribute__((address_space(3))) char*)smem);
  const int frow = lane & 31, fhi = lane >> 5, fsw = lane & 7;
  const unsigned rA = lds0 + (wn * 64 + frow) * 128, rB = lds0 + 16384 + (wm * 64 + frow) * 128;
  const unsigned aA0 = rA + (((0 + fhi) ^ fsw) << 4), aA1 = rA + (((2 + fhi) ^ fsw) << 4);
  const unsigned aA2 = rA + (((4 + fhi) ^ fsw) << 4), aA3 = rA + (((6 + fhi) ^ fsw) << 4);
  const unsigned aB0 = rB + (((0 + fhi) ^ fsw) << 4), aB1 = rB + (((2 + fhi) ^ fsw) << 4);
  const unsigned aB2 = rB + (((4 + fhi) ^ fsw) << 4), aB3 = rB + (((6 + fhi) ^ fsw) << 4);
  bf16x8 x0a0, x0a1, x0b0, x0b1, x1a0, x1a1, x1b0, x1b1, x2a0, x2a1, x2b0, x2b1, x3a0, x3a1, x3b0, x3b1;
#define GT_DSR(dst, addr, OFF) asm volatile("ds_read_b128 %0, %1 offset:%2" : "=v"(dst) : "v"(addr), "n"(OFF))
#define GT_LOADKS(KS, BUF)                        \
  GT_DSR(x##KS##a0, aA##KS, (BUF) * 32768);        \
  GT_DSR(x##KS##a1, aA##KS, (BUF) * 32768 + 4096); \
  GT_DSR(x##KS##b0, aB##KS, (BUF) * 32768);        \
  GT_DSR(x##KS##b1, aB##KS, (BUF) * 32768 + 4096);
#define GT_MMAKS(KS, N)                                                                                         \
  asm volatile("s_waitcnt lgkmcnt(%4)" : "+v"(x##KS##a0), "+v"(x##KS##a1), "+v"(x##KS##b0), "+v"(x##KS##b1) : "n"(N)); \
  acc[0][0] = __builtin_amdgcn_mfma_f32_32x32x16_bf16(x##KS##a0, x##KS##b0, acc[0][0], 0, 0, 0);                 \
  acc[0][1] = __builtin_amdgcn_mfma_f32_32x32x16_bf16(x##KS##a0, x##KS##b1, acc[0][1], 0, 0, 0);                 \
  acc[1][0] = __builtin_amdgcn_mfma_f32_32x32x16_bf16(x##KS##a1, x##KS##b0, acc[1][0], 0, 0, 0);                 \
  acc[1][1] = __builtin_amdgcn_mfma_f32_32x32x16_bf16(x##KS##a1, x##KS##b1, acc[1][1], 0, 0, 0);
#define GT_COMPUTE(BUF)                                                               \
  GT_LOADKS(0, BUF) GT_LOADKS(1, BUF) GT_LOADKS(2, BUF) GT_LOADKS(3, BUF)              \
  GT_MMAKS(0, 12) GT_MMAKS(1, 8) GT_MMAKS(2, 4) GT_MMAKS(3, 0)
  const int nk = K >> 6;
  const int klast = K - 64;
  GT_GLOAD(p, 0)
  GT_GLOAD(q, 64)
  GT_SSTORE(p, 0)
  __syncthreads();
  for (int kt = 0; kt < nk; kt += 2) {
    {
      int k0 = (kt + 2) << 6;
      k0 = k0 > klast ? klast : k0;
      GT_GLOAD(p, k0)
    }
    GT_COMPUTE(0)
    GT_SSTORE(q, 1)
    __syncthreads();
    {
      int k0 = (kt + 3) << 6;
      k0 = k0 > klast ? klast : k0;
      GT_GLOAD(q, k0)
    }
    GT_COMPUTE(1)
    GT_SSTORE(p, 0)
    __syncthreads();
  }
  epi(acc, n0 + wn * 64, m0 + wm * 64, lane);
}

#define BIG_GLOAD(S, K0)                                                       \
  S##a0 = *(const u32x4*)(ga + (K0));                                          \
  S##a1 = *(const u32x4*)(ga + (size_t)64 * lda + (K0));                       \
  S##a2 = *(const u32x4*)(ga + (size_t)128 * lda + (K0));                      \
  S##a3 = *(const u32x4*)(ga + (size_t)192 * lda + (K0));                      \
  S##b0 = *(const u32x4*)(gb + (K0));                                          \
  S##b1 = *(const u32x4*)(gb + (size_t)64 * ldb + (K0));                       \
  if (NJ >= 3) S##b2 = *(const u32x4*)(gb + (size_t)128 * ldb + (K0));         \
  if (NJ == 4) S##b3 = *(const u32x4*)(gb + (size_t)192 * ldb + (K0));
#define BIG_SSTORE(S, BUF)                                                     \
  *(u32x4*)(smem + (BUF) * 32768 + soff) = S##a0;                              \
  *(u32x4*)(smem + (BUF) * 32768 + soff + 4096) = S##a1;                       \
  *(u32x4*)(smem + (BUF) * 32768 + soff + 8192) = S##a2;                       \
  *(u32x4*)(smem + (BUF) * 32768 + soff + 12288) = S##a3;                      \
  *(u32x4*)(smem + (BUF) * 32768 + 16384 + soff) = S##b0;                      \
  *(u32x4*)(smem + (BUF) * 32768 + 16384 + soff + 4096) = S##b1;               \
  if (NJ >= 3) *(u32x4*)(smem + (BUF) * 32768 + 16384 + soff + 8192) = S##b2;  \
  if (NJ == 4) *(u32x4*)(smem + (BUF) * 32768 + 16384 + soff + 12288) = S##b3;
template <int NJ, class Epi>
DEV void gemm_big(const u16* A, int lda, const u16* B, int ldb, int K, int n0, int m0, char* smem, const Epi& epi) {
  const int tid = g_tid(), lane = tid & 63, w = tid >> 6;
  const int wn = w & 1, wm = w >> 1;
  f32x16 acc[4][NJ];
#pragma unroll
  for (int i = 0; i < 4; ++i)
#pragma unroll
    for (int j = 0; j < NJ; ++j)
#pragma unroll
      for (int r = 0; r < 16; ++r) acc[i][j][r] = 0.f;
  u32x4 pa0, pa1, pa2, pa3, pb0, pb1, pb2, pb3, qa0, qa1, qa2, qa3, qb0, qb1, qb2, qb3;
  pb2 = pb3 = qb2 = qb3 = u32x4{0u, 0u, 0u, 0u};
  const int lrow = tid >> 2, lch = tid & 3;
  const u16* ga = A + (size_t)(n0 + lrow) * lda + lch * 8;
  const u16* gb = B + (size_t)(m0 + lrow) * ldb + lch * 8;
  const int soff = lrow * 64 + ((lch ^ ((lrow >> 2) & 3)) << 4);
  const int frow = lane & 31, fhi = lane >> 5;
  const int sw = (frow >> 2) & 3;
  const unsigned lds0 = (unsigned)(uintptr_t)((__attribute__((address_space(3))) char*)smem);
  const unsigned aA0 = lds0 + (wn * 128 + frow) * 64 + (((0 + fhi) ^ sw) << 4);
  const unsigned aA1 = lds0 + (wn * 128 + frow) * 64 + (((2 + fhi) ^ sw) << 4);
  const unsigned aB0 = lds0 + 16384 + (wm * 32 * NJ + frow) * 64 + (((0 + fhi) ^ sw) << 4);
  const unsigned aB1 = lds0 + 16384 + (wm * 32 * NJ + frow) * 64 + (((2 + fhi) ^ sw) << 4);
#define DSR(dst, addr, OFF) asm volatile("ds_read_b128 %0, %1 offset:%2" : "=v"(dst) : "v"(addr), "n"(OFF))
#define BIG_LOADF(F, AA, AB, BUF)                                   \
  DSR(F##a0, AA, (BUF) * 32768);                                     \
  DSR(F##a1, AA, (BUF) * 32768 + 2048);                              \
  DSR(F##a2, AA, (BUF) * 32768 + 4096);                              \
  DSR(F##a3, AA, (BUF) * 32768 + 6144);                              \
  DSR(F##b0, AB, (BUF) * 32768);                                     \
  DSR(F##b1, AB, (BUF) * 32768 + 2048);                              \
  if (NJ >= 3) DSR(F##b2, AB, (BUF) * 32768 + 4096);                 \
  if (NJ == 4) DSR(F##b3, AB, (BUF) * 32768 + 6144);
#define BIG_WAITF(N, F)                                                                                       \
  asm volatile("s_waitcnt lgkmcnt(%8)"                                                                       \
               : "+v"(F##a0), "+v"(F##a1), "+v"(F##a2), "+v"(F##a3), "+v"(F##b0), "+v"(F##b1), "+v"(F##b2), "+v"(F##b3) \
               : "n"(N));
#define BIG_MFMA(F)                                                                                           \
  acc[0][0] = __builtin_amdgcn_mfma_f32_32x32x16_bf16(F##a0, F##b0, acc[0][0], 0, 0, 0);                        \
  acc[0][1] = __builtin_amdgcn_mfma_f32_32x32x16_bf16(F##a0, F##b1, acc[0][1], 0, 0, 0);                        \
  if (NJ >= 3) acc[0][NJ >= 3 ? 2 : 0] = __builtin_amdgcn_mfma_f32_32x32x16_bf16(F##a0, F##b2, acc[0][NJ >= 3 ? 2 : 0], 0, 0, 0); \
  if (NJ == 4) acc[0][NJ - 1] = __builtin_amdgcn_mfma_f32_32x32x16_bf16(F##a0, F##b3, acc[0][NJ - 1], 0, 0, 0);  \
  acc[1][0] = __builtin_amdgcn_mfma_f32_32x32x16_bf16(F##a1, F##b0, acc[1][0], 0, 0, 0);                        \
  acc[1][1] = __builtin_amdgcn_mfma_f32_32x32x16_bf16(F##a1, F##b1, acc[1][1], 0, 0, 0);                        \
  if (NJ >= 3) acc[1][NJ >= 3 ? 2 : 0] = __builtin_amdgcn_mfma_f32_32x32x16_bf16(F##a1, F##b2, acc[1][NJ >= 3 ? 2 : 0], 0, 0, 0); \
  if (NJ == 4) acc[1][NJ - 1] = __builtin_amdgcn_mfma_f32_32x32x16_bf16(F##a1, F##b3, acc[1][NJ - 1], 0, 0, 0);  \
  acc[2][0] = __builtin_amdgcn_mfma_f32_32x32x16_bf16(F##a2, F##b0, acc[2][0], 0, 0, 0);                        \
  acc[2][1] = __builtin_amdgcn_mfma_f32_32x32x16_bf16(F##a2, F##b1, acc[2][1], 0, 0, 0);                        \
  if (NJ >= 3) acc[2][NJ >= 3 ? 2 : 0] = __builtin_amdgcn_mfma_f32_32x32x16_bf16(F##a2, F##b2, acc[2][NJ >= 3 ? 2 : 0], 0, 0, 0); \
  if (NJ == 4) acc[2][NJ - 1] = __builtin_amdgcn_mfma_f32_32x32x16_bf16(F##a2, F##b3, acc[2][NJ - 1], 0, 0, 0);  \
  acc[3][0] = __builtin_amdgcn_mfma_f32_32x32x16_bf16(F##a3, F##b0, acc[3][0], 0, 0, 0);                        \
  acc[3][1] = __builtin_amdgcn_mfma_f32_32x32x16_bf16(F##a3, F##b1, acc[3][1], 0, 0, 0);                        \
  if (NJ >= 3) acc[3][NJ >= 3 ? 2 : 0] = __builtin_amdgcn_mfma_f32_32x32x16_bf16(F##a3, F##b2, acc[3][NJ >= 3 ? 2 : 0], 0, 0, 0); \
  if (NJ == 4) acc[3][NJ - 1] = __builtin_amdgcn_mfma_f32_32x32x16_bf16(F##a3, F##b3, acc[3][NJ - 1], 0, 0, 0);
#define BIG_COMPUTE(BUF)                 \
  BIG_LOADF(f, aA0, aB0, BUF)            \
  BIG_LOADF(h, aA1, aB1, BUF)            \
  BIG_WAITF(NJ + 4, f)                   \
  BIG_MFMA(f)                            \
  BIG_WAITF(0, h)                        \
  BIG_MFMA(h)
  bf16x8 fa0, fa1, fa2, fa3, fb0, fb1, fb2, fb3, ha0, ha1, ha2, ha3, hb0, hb1, hb2, hb3;
  fb2 = fb3 = hb2 = hb3 = bf16x8{0, 0, 0, 0, 0, 0, 0, 0};
  const int nk = K >> 5;
  const int klast = K - 32;
  BIG_GLOAD(p, 0)
  BIG_GLOAD(q, 32)
  BIG_SSTORE(p, 0)
  __syncthreads();
  for (int kt = 0; kt < nk; kt += 2) {
    {
      int k0 = (kt + 2) << 5;
      k0 = k0 > klast ? klast : k0;
      BIG_GLOAD(p, k0)
    }
    BIG_COMPUTE(0)
    BIG_SSTORE(q, 1)
    __syncthreads();
    {
      int k0 = (kt + 3) << 5;
      k0 = k0 > klast ? klast : k0;
      BIG_GLOAD(q, k0)
    }
    BIG_COMPUTE(1)
    BIG_SSTORE(p, 0)
    __syncthreads();
  }
  epi(acc, n0 + wn * 128, m0 + wm * 32 * NJ, lane);
}


template <int NJ, class Epi>
DEV void big_gemm_phase(const u16* A, int lda, const u16* B, int ldb, int K, int NF, int G, int bid, int nblk, char* smem,
                        const Epi& epi) {
  constexpr int TT = 64 * NJ;
  const int NT = MR / TT;
  if (nblk == 256) {
    const int xcd = bid & 7, slot = bid >> 3;
    const int rem = NT % 8;
    const int TPX = NT / 8 + (xcd < rem ? 1 : 0);
    const int t0 = xcd * (NT / 8) + (xcd < rem ? xcd : rem);
    for (int j = slot; j < NF * TPX; j += 32) {
      int f = (j / (G * TPX)) * G + j % G;
      int t = t0 + (j / G) % TPX;
      gemm_big<NJ>(A, lda, B, ldb, K, f * 256, t * TT, smem, epi);
    }
  } else {
    for (int job = bid; job < NF * NT; job += nblk) gemm_big<NJ>(A, lda, B, ldb, K, (job % NF) * 256, (job / NF) * TT, smem, epi);
  }
}

template <int NI, int NJ, class F>
DEV void for_quads(f32x16 (&acc)[NI][NJ], int nW, int mW, int lane, F f) {
#pragma unroll
  for (int i = 0; i < NI; ++i)
#pragma unroll
    for (int j = 0; j < NJ; ++j)
#pragma unroll
      for (int q = 0; q < 4; ++q) {
        int nf = nW + i * 32 + 8 * q + 4 * (lane >> 5);
        int m = mW + j * 32 + (lane & 31);
        f(nf, m, acc[i][j][4 * q], acc[i][j][4 * q + 1], acc[i][j][4 * q + 2], acc[i][j][4 * q + 3]);
      }
}

struct EpiInproj {
  const Params& P;
  template <int NI, int NJ>
  DEV void operator()(f32x16 (&acc)[NI][NJ], int nW, int mW, int lane) const {
    const int hi = lane >> 5;
#pragma unroll
    for (int i = 0; i < NI; ++i) {
      const int nt = nW + i * 32;
#pragma unroll
      for (int j = 0; j < NJ; ++j) {
        const int m = mW + j * 32 + (lane & 31);
        f32x16 a = acc[i][j];
        if (nt < 384) {
#pragma unroll
          for (int q = 0; q < 4; ++q) {
            int nf = nt + 8 * q + 4 * hi;
            int g = nf >> 4, h = nf & 15;
            u16* dst = P.UB() + ((size_t)(g * NCH + (m >> 5))) * 768 + (m & 31) * 16 + h;
            store_bf4(dst, a[4 * q], a[4 * q + 1], a[4 * q + 2], a[4 * q + 3]);
          }
        } else if (nt < 640) {
#pragma unroll
          for (int q = 0; q < 4; ++q) {
            int nf = nt + 8 * q + 4 * hi - 384;
            store_bf4(P.fbuf() + (size_t)m * 256 + nf, a[4 * q], a[4 * q + 1], a[4 * q + 2], a[4 * q + 3]);
          }
        } else if (nt < 1408) {
          const bool isq = nt < 1024;
          const int off = nt - (isq ? 640 : 1024);
          if (m < NLAT) {
            const int l = m & (SEQ - 1);
            const float pos = (off & 32) ? (float)(l & 63) : (float)(l >> 6);
#pragma unroll
            for (int e = 0; e < 8; ++e) {
              int fl = 8 * (e >> 2) + 4 * hi + (e & 3);
              float freq = exp2f(-(float)fl * (13.287712379549449f / 16.f));
              float rev = pos * freq * 0.15915494309189535f;
              float sn = hw_sin_rev(rev), cs = hw_cos_rev(rev);
              float x1 = a[e], x2 = a[e + 8];
              a[e] = x1 * cs - x2 * sn;
              a[e + 8] = x2 * cs + x1 * sn;
            }
          }
          const float sc = isq ? 0.125f : 1.f;
          u16* base = (isq ? P.qbuf() : P.kbuf()) + (size_t)m * 384 + off;
#pragma unroll
          for (int q = 0; q < 4; ++q)
            store_bf4(base + 8 * q + 4 * hi, a[4 * q] * sc, a[4 * q + 1] * sc, a[4 * q + 2] * sc, a[4 * q + 3] * sc);
        } else {
#pragma unroll
          for (int r = 0; r < 16; ++r) {
            int feat = nt - 1408 + (r & 3) + 8 * (r >> 2) + 4 * hi;
            if (m < NLAT)
              P.vT()[((size_t)((m >> 13) * 384 + feat)) * SEQ + (m & (SEQ - 1))] = f2bf(a[r]);
            else
              P.vTc()[((size_t)(((m - NLAT) >> 8) * 384 + feat)) * LCX + ((m - NLAT) & 255)] = f2bf(a[r]);
          }
        }
      }
    }
  }
};

struct EpiSsmEnd {
  float* Eg;
  template <int NI, int NJ>
  DEV void operator()(f32x16 (&acc)[NI][NJ], int nW, int mW, int lane) const {
    for_quads(acc, nW, mW, lane, [&](int nf, int m, float a, float b, float c, float d) {
      if (m < NCH) *(float4*)(Eg + (size_t)m * 256 + nf) = make_float4(a, b, c, d);
    });
  }
};

DEV float gelu_tanh(float x) {
  float u = 0.7978845608028654f * (x + 0.044715f * x * x * x);
  float t = 1.f - 2.f / (1.f + __expf(2.f * u));
  return 0.5f * x * (1.f + t);
}

struct EpiSsmOut {
  u16* zb;
  int g;
  template <int NI, int NJ>
  DEV void operator()(f32x16 (&acc)[NI][NJ], int nW, int mW, int lane) const {
    for_quads(acc, nW, mW, lane, [&](int nf, int m, float a, float b, float c, float d) {
      if (m < NCH) {
        int t = nf >> 4, h = nf & 15;
        store_bf4(zb + ((size_t)g * MR + m * TCH + t) * 16 + h, gelu_tanh(a), gelu_tanh(b), gelu_tanh(c),
                  gelu_tanh(d));
      }
    });
  }
};

struct EpiGlu {
  const u16* zb;
  u16* yc;
  template <int NI, int NJ>
  DEV void operator()(f32x16 (&acc)[NI][NJ], int nW, int mW, int lane) const {
    for_quads(acc, nW, mW, lane, [&](int nf, int m, float a, float b, float c, float d) {
      uint2 zz = *(const uint2*)(zb + ((size_t)(nf >> 4) * MR + m) * 16 + (nf & 15));
      float z0 = bf2f((u16)(zz.x & 0xffff)), z1 = bf2f((u16)(zz.x >> 16));
      float z2 = bf2f((u16)(zz.y & 0xffff)), z3 = bf2f((u16)(zz.y >> 16));
      store_bf4(yc + (size_t)m * 1024 + nf, z0 / (1.f + __expf(-a)), z1 / (1.f + __expf(-b)), z2 / (1.f + __expf(-c)),
                z3 / (1.f + __expf(-d)));
    });
  }
};

struct EpiFnetA {
  u16* A1b;
  template <int NI, int NJ>
  DEV void operator()(f32x16 (&acc)[NI][NJ], int nW, int mW, int lane) const {
    for_quads(acc, nW, mW, lane, [&](int nf, int m, float a, float b, float c, float d) {
      int k1 = nf >> 1;
      int cc = m >> 8, j = m & 255;
      u16* p = A1b + ((size_t)(k1 * 128 + cc * 2)) * 256 + j;
      p[0] = f2bf(a);
      p[256] = f2bf(b);
      p[128 * 256] = f2bf(c);
      p[128 * 256 + 256] = f2bf(d);
    });
  }
};

struct EpiFnetCtx {
  u16* Gb;
  template <int NI, int NJ>
  DEV void operator()(f32x16 (&acc)[NI][NJ], int nW, int mW, int lane) const {
    for_quads(acc, nW, mW, lane, [&](int nf, int m, float a, float b, float c, float d) {
      int k = nf >> 1;
      const float s = 1.f / 128.f;
      u16* p = Gb + (size_t)k * 512 + m;
      p[0] = f2bf(a * s);
      p[256] = f2bf(b * s);
      p[512] = f2bf(c * s);
      p[512 + 256] = f2bf(d * s);
    });
  }
};

struct EpiFnetC {
  u16* Gb;
  template <int NI, int NJ>
  DEV void operator()(f32x16 (&acc)[NI][NJ], int nW, int mW, int lane) const {
    for_quads(acc, nW, mW, lane, [&](int nf, int m, float a, float b, float c, float d) {
      int k2 = nf >> 1;
      const float s = 0.0013810679320049757f;
      u16* p = Gb + (size_t)k2 * 128 * 512 + m;
      p[0] = f2bf(a * s);
      p[256] = f2bf(b * s);
      p[128 * 512] = f2bf(c * s);
      p[128 * 512 + 256] = f2bf(d * s);
    });
  }
};

struct EpiStoreBf {
  u16* dst;
  int ld, coff;
  template <int NI, int NJ>
  DEV void operator()(f32x16 (&acc)[NI][NJ], int nW, int mW, int lane) const {
    for_quads(acc, nW, mW, lane, [&](int nf, int m, float a, float b, float c, float d) {
      store_bf4(dst + (size_t)m * ld + coff + nf, a, b, c, d);
    });
  }
};

struct EpiGateUp {
  u16* hid;
  template <int NI, int NJ>
  DEV void operator()(f32x16 (&acc)[NI][NJ], int nW, int mW, int lane) const {
    const int hi = lane >> 5;
#pragma unroll
    for (int ip = 0; ip < NI / 2; ++ip)
#pragma unroll
      for (int j = 0; j < NJ; ++j) {
        const int m = mW + j * 32 + (lane & 31);
#pragma unroll
        for (int q = 0; q < 4; ++q) {
          float o[4];
#pragma unroll
          for (int e = 0; e < 4; ++e) {
            float g = acc[2 * ip][j][4 * q + e], u = acc[2 * ip + 1][j][4 * q + e];
            o[e] = g / (1.f + __expf(-g)) * u;
          }
          int col = (nW >> 6) * 32 + ip * 32 + 8 * q + 4 * hi;
          store_bf4(hid + (size_t)m * DFF + col, o[0], o[1], o[2], o[3]);
        }
      }
  }
};

DEV void transpose_tile(const float* src, int K, int N, u16* dst, int mode, int kt, int nt, char* smem) {
  float* s = (float*)smem;
  const int tid = g_tid();
  const int k0 = kt * 64, n0 = nt * 64;
#pragma unroll
  for (int i = 0; i < 4; ++i) {
    int id = tid + 256 * i;
    int kk = id >> 4, c4 = id & 15;
    float4 v = *(const float4*)(src + (size_t)(k0 + kk) * N + n0 + c4 * 4);
    s[kk * 65 + c4 * 4 + 0] = v.x;
    s[kk * 65 + c4 * 4 + 1] = v.y;
    s[kk * 65 + c4 * 4 + 2] = v.z;
    s[kk * 65 + c4 * 4 + 3] = v.w;
  }
  __syncthreads();
#pragma unroll
  for (int i = 0; i < 2; ++i) {
    int id = tid + 256 * i;
    int nn = id >> 3, kc = id & 7;
    int n = n0 + nn;
    int row = mode == 0 ? n : (64 * (n >> 5) + (n & 31) + (mode == 2 ? 32 : 0));
    uint4 o;
    o.x = pack2(s[(kc * 8 + 0) * 65 + nn], s[(kc * 8 + 1) * 65 + nn]);
    o.y = pack2(s[(kc * 8 + 2) * 65 + nn], s[(kc * 8 + 3) * 65 + nn]);
    o.z = pack2(s[(kc * 8 + 4) * 65 + nn], s[(kc * 8 + 5) * 65 + nn]);
    o.w = pack2(s[(kc * 8 + 6) * 65 + nn], s[(kc * 8 + 7) * 65 + nn]);
    *(uint4*)(dst + (size_t)row * K + k0 + kc * 8) = o;
  }
  __syncthreads();
}

DEV void lam_pow(float are, float aim, float dt, int n, float& pr, float& pi) {
  float mag = expf((float)n * are * dt);
  double rev = (double)n * (double)aim * (double)dt * 0.15915494309189535;
  rev -= rint(rev);
  float fr = (float)rev;
  pr = mag * hw_cos_rev(fr);
  pi = mag * hw_sin_rev(fr);
}
DEV void zoh_factor(float are, float aim, float dt, float& fr, float& fi) {
  float lr, li;
  lam_pow(are, aim, dt, 1, lr, li);
  float nr = lr - 1.f, ni = li;
  float d2 = are * are + aim * aim;
  fr = (nr * are + ni * aim) / d2;
  fi = (ni * are - nr * aim) / d2;
}

constexpr int PREP_TR = 2852;
constexpr int PREP_KF = 24 * 63;
constexpr int PREP_WC = 24 * 2 * 32;
constexpr int PREP_WE = 24 * 2 * 8;
constexpr int PREP_MW = 64;
constexpr int PREP_N = PREP_TR + PREP_KF + PREP_WC + PREP_WE + PREP_MW;
constexpr int EXPAND_N = 24 * 32;

DEV void prep_job(const Params& P, int layer, int job, char* smem) {
  const int tid = g_tid();
  if (job < PREP_TR) {
    int j = job;
    if (j < 448) { transpose_tile(P.w_in + (size_t)layer * DM * INW, DM, INW, P.wt_in(), 0, j / 28, j % 28, smem); return; }
    j -= 448;
    if (j < 256) { transpose_tile(P.w_out + (size_t)layer * DM * DM, DM, DM, P.wt_out(), 0, j / 16, j % 16, smem); return; }
    j -= 256;
    if (j < 36) { transpose_tile(P.w_glu + (size_t)layer * 384 * 384, 384, 384, P.wt_glu(), 0, j / 6, j % 6, smem); return; }
    j -= 36;
    if (j < 704) { transpose_tile(P.w_gate + (size_t)layer * DM * DFF, DM, DFF, P.wt_gu(), 1, j / 44, j % 44, smem); return; }
    j -= 704;
    if (j < 704) { transpose_tile(P.w_up + (size_t)layer * DM * DFF, DM, DFF, P.wt_gu(), 2, j / 44, j % 44, smem); return; }
    j -= 704;
    transpose_tile(P.w_down + (size_t)layer * DFF * DM, DFF, DM, P.wt_dn(), 0, j / 16, j % 16, smem);
    return;
  }
  job -= PREP_TR;
  float* sf = (float*)smem;
  if (job < PREP_KF) {
    const int g = job / 63, delta = job % 63 - 31;
    const int ad = delta < 0 ? -delta : delta;
    float* sQ = sf;
    float* sCQ = sf + 256;
    if (tid < 128) {
      int dir = tid >> 6, p = tid & 63;
      int ix = ((layer * 2 + dir) * 24 + g) * 64 + p;
      float are = P.a_re[ix], aim = P.a_im[ix], dt = expf(P.log_dt[(layer * 2 + dir) * 24 + g]);
      float pr, pi, fr, fi;
      lam_pow(are, aim, dt, ad, pr, pi);
      zoh_factor(are, aim, dt, fr, fi);
      sQ[(dir * 64 + p) * 2 + 0] = pr * fr - pi * fi;
      sQ[(dir * 64 + p) * 2 + 1] = pr * fi + pi * fr;
    }
    __syncthreads();
#pragma unroll
    for (int i = 0; i < 8; ++i) {
      int e = tid + 256 * i;
      int dir = e >> 10, h = (e >> 6) & 15, p = e & 63;
      size_t ci = ((size_t)(((layer * 2 + dir) * 24 + g) * 16 + h)) * 64 + p;
      float cr = P.c_re[ci], cim = P.c_im[ci];
      float qr = sQ[(dir * 64 + p) * 2], qi = sQ[(dir * 64 + p) * 2 + 1];
      sCQ[e * 2 + 0] = cr * qr - cim * qi;
      sCQ[e * 2 + 1] = cr * qi + cim * qr;
    }
    __syncthreads();
    const int h = tid >> 4, hp = tid & 15;
    float val = 0.f;
#pragma unroll
    for (int dir = 0; dir < 2; ++dir) {
      bool need = dir == 0 ? (delta >= 0) : (delta <= 0);
      if (need) {
        const float* br = P.b_re + ((size_t)(((layer * 2 + dir) * 24 + g) * 64)) * 16 + hp;
        const float* bi = P.b_im + ((size_t)(((layer * 2 + dir) * 24 + g) * 64)) * 16 + hp;
        const float* cq = sCQ + ((dir * 16 + h) * 64) * 2;
#pragma unroll 16
        for (int p = 0; p < 64; ++p) val += cq[p * 2] * br[p * 16] - cq[p * 2 + 1] * bi[p * 16];
      }
    }
    if (delta == 0 && h == hp) val += P.ssm_d[layer * 384 + g * 16 + h];
    P.Ktau()[(size_t)job * 256 + tid] = val;
    __syncthreads();
    return;
  }
  job -= PREP_KF;
  if (job < PREP_WC) {
    const int j = job & 31, dir = (job >> 5) & 1, g = job >> 6;
    float* sP = sf;
    if (tid < 64) {
      int p = tid;
      int ix = ((layer * 2 + dir) * 24 + g) * 64 + p;
      float are = P.a_re[ix], aim = P.a_im[ix], dt = expf(P.log_dt[(layer * 2 + dir) * 24 + g]);
      float pr, pi;
      lam_pow(are, aim, dt, dir == 0 ? j + 1 : 32 - j, pr, pi);
      sP[p * 2] = pr;
      sP[p * 2 + 1] = pi;
      if (j == 0) {
        float tr, ti;
        lam_pow(are, aim, dt, 32, tr, ti);
        P.lamT()[((dir * 24 + g) * 64 + p) * 2] = tr;
        P.lamT()[((dir * 24 + g) * 64 + p) * 2 + 1] = ti;
      }
    }
    __syncthreads();
#pragma unroll
    for (int i = 0; i < 8; ++i) {
      int e = tid + 256 * i;
      int h = e >> 7, pc = e & 127, p = pc >> 1, ri = pc & 1;
      size_t ci = ((size_t)(((layer * 2 + dir) * 24 + g) * 16 + h)) * 64 + p;
      float cr = P.c_re[ci], cim = P.c_im[ci];
      float pr = sP[p * 2], pi = sP[p * 2 + 1];
      float v = ri == 0 ? (cr * pr - cim * pi) : -(cr * pi + cim * pr);
      P.A_out()[((size_t)(g * 512 + j * 16 + h)) * 768 + 512 + dir * 128 + pc] = f2bf(v);
    }
    __syncthreads();
    return;
  }
  job -= PREP_WC;
  if (job < PREP_WE) {
    const int jq = job & 7, dir = (job >> 3) & 1, g = job >> 4;
    float* sP = sf;
    {
      int jj = tid >> 6, p = tid & 63;
      int j = jq * 4 + jj;
      int ix = ((layer * 2 + dir) * 24 + g) * 64 + p;
      float are = P.a_re[ix], aim = P.a_im[ix], dt = expf(P.log_dt[(layer * 2 + dir) * 24 + g]);
      float pr, pi, fr, fi;
      lam_pow(are, aim, dt, dir == 0 ? 31 - j : j, pr, pi);
      zoh_factor(are, aim, dt, fr, fi);
      sP[(jj * 64 + p) * 2] = pr * fr - pi * fi;
      sP[(jj * 64 + p) * 2 + 1] = pr * fi + pi * fr;
    }
    __syncthreads();
    {
      const int prow = tid >> 1, half = tid & 1, p = prow >> 1, ri = prow & 1;
      const size_t bbase = ((size_t)(((layer * 2 + dir) * 24 + g) * 64 + p)) * 16;
      u16* dst = P.A_end() + ((size_t)(g * 256 + dir * 128 + prow)) * 512 + jq * 64 + half * 32;
#pragma unroll
      for (int q = 0; q < 2; ++q) {
        int jj = half * 2 + q;
        float pr = sP[(jj * 64 + p) * 2], pi = sP[(jj * 64 + p) * 2 + 1];
        unsigned pk[8];
#pragma unroll
        for (int h2 = 0; h2 < 8; ++h2) {
          float b0r = P.b_re[bbase + 2 * h2], b0i = P.b_im[bbase + 2 * h2];
          float b1r = P.b_re[bbase + 2 * h2 + 1], b1i = P.b_im[bbase + 2 * h2 + 1];
          float v0 = ri == 0 ? (pr * b0r - pi * b0i) : (pr * b0i + pi * b0r);
          float v1 = ri == 0 ? (pr * b1r - pi * b1i) : (pr * b1i + pi * b1r);
          pk[h2] = pack2(v0, v1);
        }
        *(uint4*)(dst + q * 16) = make_uint4(pk[0], pk[1], pk[2], pk[3]);
        *(uint4*)(dst + q * 16 + 8) = make_uint4(pk[4], pk[5], pk[6], pk[7]);
      }
    }
    __syncthreads();
    return;
  }
  job -= PREP_WE;
  {
    const int nb = job & 7, g = (job >> 3) & 3, ri = job >> 5;
    const float* wf = P.w_fourier + (size_t)layer * 256 * 256;
    const int n = nb * 32 + (tid >> 3), jg = tid & 7;
    unsigned pk[4];
#pragma unroll
    for (int jp = 0; jp < 4; ++jp) {
      float sum2[2];
#pragma unroll
      for (int q = 0; q < 2; ++q) {
        int j = jg * 8 + jp * 2 + q;
        float sum = 0.f;
        for (int m = 0; m < 64; ++m) {
          float fr = (float)((m * j) & 63) * (1.f / 64.f);
          float tr = ri ? hw_sin_rev(fr) : hw_cos_rev(fr);
          sum += tr * wf[(size_t)(g * 64 + m) * 256 + n];
        }
        sum2[q] = sum;
      }
      pk[jp] = pack2(sum2[0], sum2[1]);
    }
    *(uint4*)(P.MWt() + (size_t)n * 512 + ri * 256 + g * 64 + jg * 8) = make_uint4(pk[0], pk[1], pk[2], pk[3]);
  }
}

DEV void expand_job(const Params& P, int job) {
  const int tid = g_tid();
  const int g = job >> 5, t = job & 31;
  const int h = tid >> 4, cgp = tid & 15;
  u16* dst = P.A_out() + ((size_t)(g * 512 + t * 16 + h)) * 768 + cgp * 32;
#pragma unroll
  for (int q = 0; q < 2; ++q) {
    int sidx = cgp * 2 + q;
    int dI = t - sidx + 31;
    const float4* src = (const float4*)(P.Ktau() + ((size_t)(g * 63 + dI)) * 256 + h * 16);
    float4 a = src[0], b = src[1], c = src[2], d = src[3];
    *(uint4*)(dst + q * 16) = make_uint4(pack2(a.x, a.y), pack2(a.z, a.w), pack2(b.x, b.y), pack2(b.z, b.w));
    *(uint4*)(dst + q * 16 + 8) = make_uint4(pack2(c.x, c.y), pack2(c.z, c.w), pack2(d.x, d.y), pack2(d.z, d.w));
  }
}

constexpr int CONST_MOD = 384, CONST_D128 = 16, CONST_D256 = 64, CONST_T = 1024;
constexpr int CONST_N = CONST_MOD + CONST_D128 + CONST_D256 + CONST_T;

DEV void const_job(const Params& P, int job, char* smem) {
  const int tid = g_tid();
  if (job < CONST_MOD) {
    const int layer = job / 192, cb = job % 192;
    float* sv = (float*)smem;
    float* red = sv + 3 * 1024;
    for (int i = tid; i < 3 * 1024; i += 256) {
      int v = i >> 10, k = i & 1023;
      float cv = v < 2 ? P.c[v * 1024 + k] : P.c_ctx[k];
      sv[i] = cv / (1.f + __expf(-cv));
    }
    __syncthreads();
    const int kg = tid >> 5, cl = tid & 31;
    const int n = cb * 32 + cl;
    const float* W = P.w_mod + (size_t)layer * DM * 6144 + n;
    float a0 = 0.f, a1 = 0.f, a2 = 0.f;
#pragma unroll 16
    for (int k = kg * 128; k < kg * 128 + 128; ++k) {
      float wv = W[(size_t)k * 6144];
      a0 += sv[k] * wv;
      a1 += sv[1024 + k] * wv;
      a2 += sv[2048 + k] * wv;
    }
    red[(kg * 3 + 0) * 32 + cl] = a0;
    red[(kg * 3 + 1) * 32 + cl] = a1;
    red[(kg * 3 + 2) * 32 + cl] = a2;
    __syncthreads();
    if (tid < 96) {
      int v = tid >> 5, c2 = tid & 31;
      float s = P.b_mod[layer * 6144 + cb * 32 + c2];
      for (int q = 0; q < 8; ++q) s += red[(q * 3 + v) * 32 + c2];
      P.mod()[(layer * 3 + v) * 6144 + cb * 32 + c2] = s;
    }
    __syncthreads();
    return;
  }
  job -= CONST_MOD;
  if (job < CONST_D128) {
#pragma unroll
    for (int i = 0; i < 8; ++i) {
      int idx = job * 2048 + tid + 256 * i;
      int row = idx >> 7, r = idx & 127;
      int k1 = row >> 1, ri = row & 1;
      float fr = (float)((k1 * r) & 127) * (1.f / 128.f);
      P.D128()[idx] = f2bf(ri ? -hw_sin_rev(fr) : hw_cos_rev(fr));
    }
    return;
  }
  job -= CONST_D128;
  if (job < CONST_D256) {
#pragma unroll
    for (int i = 0; i < 8; ++i) {
      int idx = job * 2048 + tid + 256 * i;
      int row = idx >> 8, l = idx & 255;
      int k = row >> 1, ri = row & 1;
      float fr = (float)((k * l) & 255) * (1.f / 256.f);
      P.D256()[idx] = f2bf(ri ? -hw_sin_rev(fr) : hw_cos_rev(fr));
    }
    return;
  }
  job -= CONST_D256;
  {
#pragma unroll
    for (int i = 0; i < 8; ++i) {
      int idx = job * 2048 + tid + 256 * i;
      int k1 = idx >> 14, row = (idx >> 7) & 127, col = idx & 127;
      int k2 = row >> 1, ri = row & 1, cc = col >> 1, rj = col & 1;
      float fr = (float)((cc * (k1 + 128 * k2)) & 8191) * (1.f / 8192.f);
      float cs = hw_cos_rev(fr), sn = hw_sin_rev(fr);
      float v = (ri == rj) ? cs : (ri == 0 ? sn : -sn);
      P.Tmat()[idx] = f2bf(v);
    }
  }
}

DEV float4 ld4(const float* p) { return *(const float4*)p; }
DEV float4 ldbf4(const u16* p) {
  uint2 v = *(const uint2*)p;
  return make_float4(bf2f((u16)(v.x & 0xffff)), bf2f((u16)(v.x >> 16)), bf2f((u16)(v.y & 0xffff)), bf2f((u16)(v.y >> 16)));
}
DEV float sq4(float4 v) { return v.x * v.x + v.y * v.y + v.z * v.z + v.w * v.w; }

constexpr int NR = 4;
DEV void rowop(const Params& P, int kind, int layer, int m0, int lane) {
  const bool last = layer == 1;
  if (kind == 2 && last && m0 >= NLAT) return;
  const int mi = m0 < NLAT ? (m0 >> 13) : 2;
  float* resid = m0 < NLAT ? P.out + (size_t)m0 * DM : P.xctx() + (size_t)(m0 - NLAT) * DM;
  const float* xin;
  if (kind == 0 || (kind == 1 && layer == 0))
    xin = m0 < NLAT ? P.x + (size_t)m0 * DM : P.ctx + (size_t)(m0 - NLAT) * DM;
  else
    xin = resid;
  const float* modv = P.mod() + (size_t)(layer * 3 + mi) * 6144;
  float4 v[NR][4];
#pragma unroll
  for (int r = 0; r < NR; ++r)
#pragma unroll
    for (int i = 0; i < 4; ++i) v[r][i] = ld4(xin + (size_t)r * DM + i * 256 + lane * 4);
  if (kind != 0) {
    const float* gpost = (kind == 1 ? P.g_post_mix : P.g_post_ffn) + layer * DM;
    const float* gate = modv + (kind == 1 ? 2048 : 5120);
    float4 o[NR][4];
    float ss[NR];
#pragma unroll
    for (int r = 0; r < NR; ++r) {
      ss[r] = 0.f;
#pragma unroll
      for (int i = 0; i < 4; ++i) {
        o[r][i] = ldbf4(P.obuf() + (size_t)(m0 + r) * DM + i * 256 + lane * 4);
        ss[r] += sq4(o[r][i]);
      }
    }
    float rinv[NR];
#pragma unroll
    for (int r = 0; r < NR; ++r) rinv[r] = rsqrtf(wave_sum(ss[r]) * (1.f / DM) + EPS);
#pragma unroll
    for (int i = 0; i < 4; ++i) {
      float4 gp = ld4(gpost + i * 256 + lane * 4), gt = ld4(gate + i * 256 + lane * 4);
#pragma unroll
      for (int r = 0; r < NR; ++r) {
        v[r][i].x += gt.x * (o[r][i].x * rinv[r] * gp.x);
        v[r][i].y += gt.y * (o[r][i].y * rinv[r] * gp.y);
        v[r][i].z += gt.z * (o[r][i].z * rinv[r] * gp.z);
        v[r][i].w += gt.w * (o[r][i].w * rinv[r] * gp.w);
      }
    }
    float* dst = (kind == 2 && last) ? P.out + (size_t)m0 * DM : resid;
#pragma unroll
    for (int r = 0; r < NR; ++r)
#pragma unroll
      for (int i = 0; i < 4; ++i) *(float4*)(dst + (size_t)r * DM + i * 256 + lane * 4) = v[r][i];
    if (kind == 2 && last) return;
  }
  const int la = kind == 2 ? layer + 1 : layer;
  const float* gpre = (kind == 1 ? P.g_pre_ffn : P.g_pre_mix) + la * DM;
  const float* mv = P.mod() + (size_t)(la * 3 + mi) * 6144;
  const float* sh = mv + (kind == 1 ? 3072 : 0);
  const float* sc = mv + (kind == 1 ? 4096 : 1024);
  float rinv2[NR];
#pragma unroll
  for (int r = 0; r < NR; ++r) {
    float ss = 0.f;
#pragma unroll
    for (int i = 0; i < 4; ++i) ss += sq4(v[r][i]);
    rinv2[r] = rsqrtf(wave_sum(ss) * (1.f / DM) + EPS);
  }
#pragma unroll
  for (int i = 0; i < 4; ++i) {
    int col = i * 256 + lane * 4;
    float4 gp = ld4(gpre + col), s1 = ld4(sc + col), s0 = ld4(sh + col);
#pragma unroll
    for (int r = 0; r < NR; ++r)
      store_bf4(P.abuf() + (size_t)(m0 + r) * DM + col, v[r][i].x * rinv2[r] * gp.x * (1.f + s1.x) + s0.x,
                v[r][i].y * rinv2[r] * gp.y * (1.f + s1.y) + s0.y, v[r][i].z * rinv2[r] * gp.z * (1.f + s1.z) + s0.z,
                v[r][i].w * rinv2[r] * gp.w * (1.f + s1.w) + s0.w);
  }
}

DEV void attn_wave(const Params& P, int layer, bool isctx, int b, int h, int r, int cgp, int lane) {
  const int qi = lane & 15, g = lane >> 4;
  int mq, c = 0, cs = 0, cb = 0, rs = 0;
  if (!isctx) {
    c = cgp * 16 + qi;
    mq = b * SEQ + r * 64 + c;
    cs = c - 8;
    cs = cs < 0 ? 0 : (cs > 48 ? 48 : cs);
    cb = cgp == 0 ? 0 : (cgp == 1 ? 8 : (cgp == 2 ? 24 : 32));
    rs = r - 4;
    rs = rs < 0 ? 0 : (rs > 120 ? 120 : rs);
  } else {
    mq = NLAT + b * LCX + cgp * 16 + qi;
  }
  const u16* qp = P.qbuf() + (size_t)mq * 384 + h * 64 + g * 8;
  const bf16x8 qf0 = *(const bf16x8*)qp, qf1 = *(const bf16x8*)(qp + 32);
  f32x4 o[4];
#pragma unroll
  for (int d = 0; d < 4; ++d) o[d] = f32x4{0.f, 0.f, 0.f, 0.f};
  float mrun = -1e30f, lrun = 0.f;
  const float* rp = P.rpb + (size_t)(layer * 6 + h) * 465;
  const int nblk = isctx ? 8 : 16;
  struct KV {
    bf16x8 k00, k01, k10, k11;
    uint2 v0a, v0b, v1a, v1b, v2a, v2b, v3a, v3b;
  };
  auto loadkv = [&](KV& x, int kb) {
    kb = kb < nblk ? kb : nblk - 1;
    const bool win = (!isctx) && kb < 8;
    size_t krow0;
    const u16* vbase;
    int vld;
    if (win) {
      int tok0 = (rs + kb) * 64 + cb;
      krow0 = (size_t)b * SEQ + tok0;
      vbase = P.vT() + ((size_t)(b * 384 + h * 64)) * SEQ + tok0;
      vld = SEQ;
    } else {
      int kc = (isctx ? kb : kb - 8) * 32;
      krow0 = (size_t)NLAT + b * LCX + kc;
      vbase = P.vTc() + ((size_t)(b * 384 + h * 64)) * LCX + kc;
      vld = LCX;
    }
    const u16* kp0 = P.kbuf() + (krow0 + qi) * 384 + h * 64 + g * 8;
    const u16* kp1 = kp0 + 16 * 384;
    x.k00 = *(const bf16x8*)kp0;
    x.k01 = *(const bf16x8*)(kp0 + 32);
    x.k10 = *(const bf16x8*)kp1;
    x.k11 = *(const bf16x8*)(kp1 + 32);
    const u16* vp = vbase + (size_t)qi * vld + g * 4;
    x.v0a = *(const uint2*)vp;
    x.v0b = *(const uint2*)(vp + 16);
    x.v1a = *(const uint2*)(vp + (size_t)16 * vld);
    x.v1b = *(const uint2*)(vp + (size_t)16 * vld + 16);
    x.v2a = *(const uint2*)(vp + (size_t)32 * vld);
    x.v2b = *(const uint2*)(vp + (size_t)32 * vld + 16);
    x.v3a = *(const uint2*)(vp + (size_t)48 * vld);
    x.v3b = *(const uint2*)(vp + (size_t)48 * vld + 16);
  };
  auto pvmma = [&](f32x4& od, uint2 va, uint2 vb, bf16x8 pf) {
    union { uint4 u; bf16x8 v; } cv;
    cv.u = make_uint4(va.x, va.y, vb.x, vb.y);
    od = __builtin_amdgcn_mfma_f32_16x16x32_bf16(cv.v, pf, od, 0, 0, 0);
  };
  auto step = [&](const KV& x, int kb) {
    const bool win = (!isctx) && kb < 8;
    f32x4 s[2];
    {
      f32x4 z = {0.f, 0.f, 0.f, 0.f};
      z = __builtin_amdgcn_mfma_f32_16x16x32_bf16(x.k00, qf0, z, 0, 0, 0);
      s[0] = __builtin_amdgcn_mfma_f32_16x16x32_bf16(x.k01, qf1, z, 0, 0, 0);
      f32x4 z2 = {0.f, 0.f, 0.f, 0.f};
      z2 = __builtin_amdgcn_mfma_f32_16x16x32_bf16(x.k10, qf0, z2, 0, 0, 0);
      s[1] = __builtin_amdgcn_mfma_f32_16x16x32_bf16(x.k11, qf1, z2, 0, 0, 0);
    }
    if (win) {
      const int dr = rs + kb - r + 7;
#pragma unroll
      for (int t = 0; t < 2; ++t)
#pragma unroll
        for (int i = 0; i < 4; ++i) {
          int keycol = cb + t * 16 + g * 4 + i;
          bool valid = keycol >= cs && keycol < cs + 16;
          int dc = keycol - c + 15;
          dc = dc < 0 ? 0 : (dc > 30 ? 30 : dc);
          float bias = rp[dr * 31 + dc];
          s[t][i] = valid ? s[t][i] + bias : -1e30f;
        }
    }
    float mx = fmaxf(fmaxf(fmaxf(s[0][0], s[0][1]), fmaxf(s[0][2], s[0][3])),
                     fmaxf(fmaxf(s[1][0], s[1][1]), fmaxf(s[1][2], s[1][3])));
    mx = fmaxf(mx, __shfl_xor(mx, 16));
    mx = fmaxf(mx, __shfl_xor(mx, 32));
    const float mnew = fmaxf(mrun, mx);
    const float alpha = __expf(mrun - mnew);
    mrun = mnew;
    float p[8], psum = 0.f;
#pragma unroll
    for (int t = 0; t < 2; ++t)
#pragma unroll
      for (int i = 0; i < 4; ++i) {
        p[t * 4 + i] = __expf(s[t][i] - mnew);
        psum += p[t * 4 + i];
      }
    lrun = lrun * alpha + psum;
    bf16x8 pf;
#pragma unroll
    for (int e = 0; e < 8; ++e) pf[e] = (short)f2bf(p[e]);
#pragma unroll
    for (int d = 0; d < 4; ++d) o[d] *= alpha;
    pvmma(o[0], x.v0a, x.v0b, pf);
    pvmma(o[1], x.v1a, x.v1b, pf);
    pvmma(o[2], x.v2a, x.v2b, pf);
    pvmma(o[3], x.v3a, x.v3b, pf);
  };
  KV ka, kb2;
  loadkv(ka, 0);
  for (int kb = 0; kb < nblk; kb += 2) {
    loadkv(kb2, kb + 1);
    step(ka, kb);
    loadkv(ka, kb + 2);
    step(kb2, kb + 1);
  }
  float l = lrun + __shfl_xor(lrun, 16);
  l += __shfl_xor(l, 32);
  const float inv = 1.f / l;
#pragma unroll
  for (int d = 0; d < 4; ++d)
    store_bf4(P.ycat() + (size_t)mq * DM + 640 + h * 64 + d * 16 + g * 4, o[d][0] * inv, o[d][1] * inv, o[d][2] * inv,
              o[d][3] * inv);
}

DEV void carry_wave(const Params& P, int wjob, int lane) {
  const int pg = wjob & 7;
  int combo = wjob >> 3;
  const int g = combo % 24;
  combo /= 24;
  const int dir = combo & 1, b = combo >> 1;
  const int p = pg * 8 + (lane & 7), seg = lane >> 3;
  const float lr = P.lamT()[((dir * 24 + g) * 64 + p) * 2], li = P.lamT()[((dir * 24 + g) * 64 + p) * 2 + 1];
  auto chunk_of = [&](int n) {
    if (n < 8) return 512 + b * 8 + (dir ? 7 - n : n);
    int c = n - 8;
    return b * 256 + (dir ? 255 - c : c);
  };
  float cr = 0.f, ci = 0.f;
#pragma unroll 1
  for (int bt = 0; bt < 3; ++bt) {
    float2 e[11];
#pragma unroll
    for (int i = 0; i < 11; ++i) {
      size_t row = (size_t)(g * NCH + chunk_of(seg * 33 + bt * 11 + i));
      e[i] = *(const float2*)(P.E() + row * 256 + dir * 128 + p * 2);
    }
#pragma unroll
    for (int i = 0; i < 11; ++i) {
      float nr = lr * cr - li * ci + e[i].x, ni = lr * ci + li * cr + e[i].y;
      cr = nr;
      ci = ni;
    }
  }
  float sr = lr, si = li;
#pragma unroll
  for (int k = 0; k < 5; ++k) {
    float t = sr * sr - si * si;
    si = 2.f * sr * si;
    sr = t;
  }
  const float l33r = sr * lr - si * li, l33i = sr * li + si * lr;
  float stR = 0.f, stI = 0.f;
#pragma unroll
  for (int k = 1; k < 8; ++k) {
    int src = (lane - 8) & 63;
    float pr_ = __shfl(stR, src), pi_ = __shfl(stI, src), er = __shfl(cr, src), ei = __shfl(ci, src);
    if (seg == k) {
      stR = l33r * pr_ - l33i * pi_ + er;
      stI = l33r * pi_ + l33i * pr_ + ei;
    }
  }
  cr = stR;
  ci = stI;
#pragma unroll 1
  for (int bt = 0; bt < 3; ++bt) {
    float2 e[11];
#pragma unroll
    for (int i = 0; i < 11; ++i) {
      size_t row = (size_t)(g * NCH + chunk_of(seg * 33 + bt * 11 + i));
      e[i] = *(const float2*)(P.E() + row * 256 + dir * 128 + p * 2);
    }
#pragma unroll
    for (int i = 0; i < 11; ++i) {
      size_t row = (size_t)(g * NCH + chunk_of(seg * 33 + bt * 11 + i));
      *(unsigned*)(P.UB() + row * 768 + 512 + dir * 128 + p * 2) = pack2(cr, ci);
      float nr = lr * cr - li * ci + e[i].x, ni = lr * ci + li * cr + e[i].y;
      cr = nr;
      ci = ni;
    }
  }
}

DEV void run_phase(const Params& P, int ph, int bid, int nblk, char* smem) {
  const int lane = g_tid() & 63, w = g_tid() >> 6;
  if (ph == 0) {
    for (int job = bid; job < CONST_N + PREP_N; job += nblk) {
      if (job < CONST_N) const_job(P, job, smem);
      else prep_job(P, 0, job - CONST_N, smem);
    }
    return;
  }
  if (ph == 1) {
    for (int job = bid; job < MR / 16 + EXPAND_N; job += nblk) {
      if (job < MR / 16) rowop(P, 0, 0, (job * 4 + w) * NR, lane);
      else expand_job(P, job - MR / 16);
    }
    return;
  }
  const int layer = (ph - 2) / 10, sub = (ph - 2) % 10;
  switch (sub) {
    case 0: {
      EpiInproj epi{P};
      big_gemm_phase<2>(P.wt_in(), DM, P.abuf(), DM, DM, 7, 7, bid, nblk, smem, epi);
      if (layer == 1)
        for (int job = bid; job < EXPAND_N; job += nblk) expand_job(P, job);
    } break;
    case 1: {
      const int J0 = 1536, J1 = J0 + 48, J2 = J1 + 240, J3 = J2 + 512, J4 = J3 + 16;
      for (int job = bid; job < J4; job += nblk) {
        if (job < J0) {
          int r = job & 127, bh = job >> 7;
          attn_wave(P, layer, false, bh / 6, bh % 6, r, w, lane);
        } else if (job < J1) {
          int j = job - J0;
          int qb = j & 3, bh = j >> 2;
          attn_wave(P, layer, true, bh / 6, bh % 6, 0, qb * 4 + w, lane);
        } else if (job < J2) {
          int j = job - J1;
          int g = j / 10, t = j % 10;
          EpiSsmEnd epi{P.E() + (size_t)g * NCH * 256};
          gemm_tile<0>(P.A_end() + (size_t)g * 256 * 512, 512, P.UB() + (size_t)g * NCH * 768, 768, 512, (t & 1) * 128,
                           (t >> 1) * 128, NCH, smem, epi);
        } else if (job < J3) {
          int j = job - J2;
          int b = j >> 8, t = j & 255;
          EpiFnetA epi{P.A1() + (size_t)b * 128 * 128 * 256};
          gemm_tile<1>(P.D128(), 128, P.fbuf() + (size_t)b * SEQ * 256, 64 * 256, 128, (t & 1) * 128, (t >> 1) * 128,
                          64 * 256, smem, epi);
        } else {
          int j = job - J3;
          int b = j >> 3, t = j & 7;
          EpiFnetCtx epi{P.Gbuf() + (size_t)(NLAT + b * LCX) * 512};
          gemm_tile<1>(P.D256(), 256, P.fbuf() + (size_t)(NLAT + b * LCX) * 256, 256, 256, (t & 3) * 128, (t >> 2) * 128,
                          256, smem, epi);
        }
      }
    } break;
    case 2: {
      for (int job = bid; job < 192; job += nblk) carry_wave(P, job * 4 + w, lane);
    } break;
    case 3: {
      for (int job = bid; job < 480 + 512; job += nblk) {
        if (job < 480) {
          int g = job / 20, t = job % 20;
          EpiSsmOut epi{P.zbuf(), g};
          gemm_tile<0>(P.A_out() + (size_t)g * 512 * 768, 768, P.UB() + (size_t)g * NCH * 768, 768, 768, (t & 3) * 128,
                       (t >> 2) * 128, NCH, smem, epi);
        } else {
          int j = job - 480;
          int bk = j >> 1, t = j & 1;
          int k1 = bk & 127, b = bk >> 7;
          EpiFnetC epi{P.Gbuf() + (size_t)(b * SEQ + k1) * 512};
          gemm_tile<1>(P.Tmat() + (size_t)k1 * 128 * 128, 128, P.A1() + (size_t)bk * 128 * 256, 256, 128, 0, t * 128, 256,
                       smem, epi);
        }
      }
    } break;
    case 4: {
      for (int job = bid; job < 396 + 264; job += nblk) {
        if (job < 396) {
          EpiGlu epi{P.zbuf(), P.ycat()};
          gemm_tile<2>(P.wt_glu(), 384, P.zbuf(), 384, 384, (job % 3) * 128, (job / 3) * 128, MR, smem, epi);
        } else {
          int j = job - 396;
          EpiStoreBf epi{P.ycat(), DM, 384};
          gemm_tile<0>(P.MWt(), 512, P.Gbuf(), 512, 512, (j & 1) * 128, (j >> 1) * 128, MR, smem, epi);
        }
      }
    } break;
    case 5: {
      EpiStoreBf epi{P.obuf(), DM, 0};
      big_gemm_phase<3>(P.wt_out(), DM, P.ycat(), DM, DM, 4, 4, bid, nblk, smem, epi);
    } break;
    case 6: {
      for (int job = bid; job < MR / 16; job += nblk) rowop(P, 1, layer, (job * 4 + w) * NR, lane);
    } break;
    case 7: {
      EpiGateUp epi{P.hidden()};
      big_gemm_phase<3>(P.wt_gu(), DM, P.abuf(), DM, DM, 22, 2, bid, nblk, smem, epi);
    } break;
    case 8: {
      EpiStoreBf epi{P.obuf(), DM, 0};
      big_gemm_phase<3>(P.wt_dn(), DFF, P.hidden(), DFF, DFF, 4, 4, bid, nblk, smem, epi);
    } break;
    case 9: {
      const int nrow = MR / 16;
      const int total = nrow + (layer == 0 ? PREP_N : 0);
      for (int job = bid; job < total; job += nblk) {
        if (job < nrow) rowop(P, 2, layer, (job * 4 + w) * NR, lane);
        else prep_job(P, 1, job - nrow, smem);
      }
    } break;
  }
}

#if MK_MULTI
__global__ void __launch_bounds__(256, 2) phase_kernel(Params P, int ph) {
  __shared__ __attribute__((aligned(16))) char smem[65536];
  run_phase(P, ph, blockIdx.x, gridDim.x, smem);
}
#else
#define XB_XCNT(j) (64 * (j))
#define XB_XSUB(j) (1024 + 64 * (j))
#define XB_XGEN(j) (2048 + 64 * (j))
#define XB_TOP 3072
#define XB_TOPGEN 3136
#define XB_WORDS 3200
DEV unsigned xb_ld(unsigned* p) { return __hip_atomic_load(p, __ATOMIC_RELAXED, __HIP_MEMORY_SCOPE_AGENT); }
DEV unsigned xb_add(unsigned* p, unsigned v) { return __hip_atomic_fetch_add(p, v, __ATOMIC_RELAXED, __HIP_MEMORY_SCOPE_AGENT); }

DEV void grid_barrier(unsigned* bar, unsigned k, unsigned xcc, unsigned nloc, unsigned nx) {
  asm volatile("s_waitcnt vmcnt(0)" ::: "memory");
  __syncthreads();
  if (threadIdx.x == 0) {
    const unsigned old = xb_add(&bar[XB_XSUB(xcc)], 1u);
    if (old + 1u == k * nloc) {
      __builtin_amdgcn_fence(__ATOMIC_RELEASE, "agent");
      asm volatile("s_waitcnt vmcnt(0)" ::: "memory");
      const unsigned og = xb_add(&bar[XB_TOP], 1u);
      if (og + 1u == k * nx) xb_add(&bar[XB_TOPGEN], 1u);
      else
        while (xb_ld(&bar[XB_TOPGEN]) < k) __builtin_amdgcn_s_sleep(4);
      __builtin_amdgcn_fence(__ATOMIC_ACQUIRE, "agent");
      xb_add(&bar[XB_XGEN(xcc)], 1u);
      asm volatile("s_waitcnt vmcnt(0)" ::: "memory");
    } else {
      while (xb_ld(&bar[XB_XGEN(xcc)]) < k) __builtin_amdgcn_s_sleep(8);
      __builtin_amdgcn_fence(__ATOMIC_ACQUIRE, "agent");
      asm volatile("s_waitcnt vmcnt(0)" ::: "memory");
    }
  }
  __syncthreads();
}

__global__ void __launch_bounds__(256) fwd_megakernel(Params P, unsigned* bar) {
  __shared__ __attribute__((aligned(16))) char smem[65536];
  cg::grid_group grid = cg::this_grid();
  const unsigned xcc = (unsigned)__builtin_amdgcn_s_getreg((3 << 11) | 20) & 0xFu;
  if (threadIdx.x == 0) xb_add(&bar[XB_XCNT(xcc)], 1u);
  __threadfence();
  grid.sync();
  unsigned nloc = 0, nx = 0;
#pragma unroll
  for (unsigned j = 0; j < 16; ++j) {
    const unsigned c = xb_ld(&bar[XB_XCNT(j)]);
    nx += c > 0u ? 1u : 0u;
    nloc = j == xcc ? c : nloc;
  }
  nloc = __builtin_amdgcn_readfirstlane(nloc);
  nx = __builtin_amdgcn_readfirstlane(nx);
  unsigned round = 0;
  for (int ph = 0; ph < NPH; ++ph) {
    int bid = blockIdx.x;
    asm volatile("" : "+s"(bid));
    run_phase(P, ph, bid, gridDim.x, smem);
#ifdef PROBE_DUP
    {
      const int sub = ph < 2 ? 10 + ph : (ph - 2) % 10;
      if ((PROBE_DUP >> sub) & 1) {
        grid_barrier(bar, ++round, xcc, nloc, nx);
        asm volatile("" : "+s"(bid));
        run_phase(P, ph, bid, gridDim.x, smem);
      }
    }
#endif
    if (ph + 1 < NPH) grid_barrier(bar, ++round, xcc, nloc, nx);
  }
}
#endif

extern "C" void kernel_launch(void* const* d_in, const int* in_sizes, int n_in, void* d_out, int out_size, void* d_ws,
                              size_t ws_size, hipStream_t stream) {
  Params p{};
  const float* const* in = (const float* const*)d_in;
  p.x = in[0]; p.c = in[1]; p.ctx = in[2]; p.c_ctx = in[3]; p.w_mod = in[4]; p.b_mod = in[5];
  p.g_pre_mix = in[6]; p.g_post_mix = in[7]; p.w_in = in[8]; p.a_re = in[9]; p.a_im = in[10]; p.log_dt = in[11];
  p.b_re = in[12]; p.b_im = in[13]; p.c_re = in[14]; p.c_im = in[15]; p.ssm_d = in[16]; p.w_glu = in[17];
  p.w_fourier = in[18]; p.rpb = in[19]; p.w_out = in[20]; p.g_pre_ffn = in[21]; p.g_post_ffn = in[22];
  p.w_gate = in[23]; p.w_up = in[24]; p.w_down = in[25];
  p.out = (float*)d_out;
  p.ws = (char*)d_ws;
  if (WS_NEED > ws_size) {
    fprintf(stderr, "workspace too small: need %zu have %zu\n", (size_t)WS_NEED, ws_size);
    return;
  }
  unsigned* bar = (unsigned*)(p.ws + O_bar);
#if MK_MULTI
  for (int ph = 0; ph < NPH; ++ph) phase_kernel<<<dim3(1024), dim3(256), 0, stream>>>(p, ph);
#else
  static int grid_blocks = 0;
  if (!grid_blocks) {
    int dev = 0, cus = 0, per_cu = 0;
    hipGetDevice(&dev);
    hipDeviceGetAttribute(&cus, hipDeviceAttributeMultiprocessorCount, dev);
    hipOccupancyMaxActiveBlocksPerMultiprocessor(&per_cu, fwd_megakernel, 256, 0);
    if (per_cu > 2) per_cu = 2;
    grid_blocks = cus * per_cu;
  }
  hipMemsetAsync(bar, 0, XB_WORDS * 4, stream);
  void* args[] = {&p, &bar};
  hipError_t e = hipLaunchCooperativeKernel((void*)fwd_megakernel, dim3(grid_blocks), dim3(256), args, 0, stream);
  if (e != hipSuccess) fprintf(stderr, "cooperative launch failed: %s (grid %d)\n", hipGetErrorString(e), grid_blocks);
#endif
}
```

```cpp
#include <hip/hip_runtime.h>
#include <hip/hip_bf16.h>
#include <hip/hip_cooperative_groups.h>
#include <cstdio>
#include <cstdint>
namespace cg = cooperative_groups;

#ifndef MK_MULTI
#define MK_MULTI 0
#endif

typedef __attribute__((ext_vector_type(8))) short bf16x8;
typedef __attribute__((ext_vector_type(4))) float f32x4;
typedef __attribute__((ext_vector_type(16))) float f32x16;
typedef unsigned short u16;
typedef __attribute__((ext_vector_type(4))) unsigned u32x4;

#define DEV __device__ __forceinline__


constexpr int DM = 1024, SEQ = 8192, LCX = 256;
constexpr int NLAT = 2 * SEQ, NCTX = 2 * LCX, MR = NLAT + NCTX;
constexpr int INW = 1792, DFF = 2816;
constexpr int TCH = 32, NCH = MR / TCH;
constexpr int NPH = 22;
constexpr float EPS = 1e-6f;

constexpr size_t al256(size_t x) { return (x + 255) & ~(size_t)255; }
constexpr size_t O_wt_in = 0;
constexpr size_t O_wt_out = O_wt_in + al256((size_t)INW * DM * 2);
constexpr size_t O_wt_glu = O_wt_out + al256((size_t)DM * DM * 2);
constexpr size_t O_wt_gu = O_wt_glu + al256((size_t)384 * 384 * 2);
constexpr size_t O_wt_dn = O_wt_gu + al256((size_t)2 * DFF * DM * 2);
constexpr size_t O_A_out = O_wt_dn + al256((size_t)DM * DFF * 2);
constexpr size_t O_A_end = O_A_out + al256((size_t)24 * 512 * 768 * 2);
constexpr size_t O_D128 = O_A_end + al256((size_t)24 * 256 * 512 * 2);
constexpr size_t O_D256 = O_D128 + al256(256 * 128 * 2);
constexpr size_t O_Tmat = O_D256 + al256(512 * 256 * 2);
constexpr size_t O_MWt = O_Tmat + al256((size_t)128 * 128 * 128 * 2);
constexpr size_t O_lamT = O_MWt + al256(256 * 512 * 2);
constexpr size_t O_Ktau = O_lamT + al256(2 * 24 * 64 * 2 * 4);
constexpr size_t O_mod = O_Ktau + al256((size_t)24 * 63 * 256 * 4);
constexpr size_t O_abuf = O_mod + al256(2 * 3 * 6144 * 4);
constexpr size_t O_xctx = O_abuf + al256((size_t)MR * DM * 2);
constexpr size_t O_bar = O_xctx + al256((size_t)NCTX * DM * 4);
constexpr size_t O_R = O_bar + al256(16384);
constexpr size_t O_ycat = O_R;
constexpr size_t O_UB = O_ycat + al256((size_t)MR * DM * 2);
constexpr size_t O_fbuf = O_UB + al256((size_t)24 * NCH * 768 * 2);
constexpr size_t O_qbuf = O_fbuf + al256((size_t)MR * 256 * 2);
constexpr size_t O_kbuf = O_qbuf + al256((size_t)MR * 384 * 2);
constexpr size_t O_vT = O_kbuf + al256((size_t)MR * 384 * 2);
constexpr size_t O_vTc = O_vT + al256((size_t)2 * 384 * SEQ * 2);
constexpr size_t O_E = O_vTc + al256((size_t)2 * 384 * LCX * 2);
constexpr size_t O_A1 = O_E + al256((size_t)24 * NCH * 256 * 4);
constexpr size_t O_Gbuf = O_A1 + al256((size_t)2 * 128 * 128 * 256 * 2);
constexpr size_t O_Rend = O_Gbuf + al256((size_t)MR * 512 * 2);
constexpr size_t O_zbuf = O_qbuf;
constexpr size_t O_hidden = O_R;
constexpr size_t O_obuf = O_R + al256((size_t)MR * DFF * 2);
constexpr size_t O_obuf_end = O_obuf + al256((size_t)MR * DM * 2);
constexpr size_t WS_NEED = O_Rend > O_obuf_end ? O_Rend : O_obuf_end;

struct Params {
  const float *x, *c, *ctx, *c_ctx, *w_mod, *b_mod, *g_pre_mix, *g_post_mix, *w_in;
  const float *a_re, *a_im, *log_dt, *b_re, *b_im, *c_re, *c_im, *ssm_d, *w_glu, *w_fourier, *rpb, *w_out;
  const float *g_pre_ffn, *g_post_ffn, *w_gate, *w_up, *w_down;
  float* out;
  char* ws;
  DEV u16* wt_in() const { return (u16*)(ws + O_wt_in); }
  DEV u16* wt_out() const { return (u16*)(ws + O_wt_out); }
  DEV u16* wt_glu() const { return (u16*)(ws + O_wt_glu); }
  DEV u16* wt_gu() const { return (u16*)(ws + O_wt_gu); }
  DEV u16* wt_dn() const { return (u16*)(ws + O_wt_dn); }
  DEV u16* A_out() const { return (u16*)(ws + O_A_out); }
  DEV u16* A_end() const { return (u16*)(ws + O_A_end); }
  DEV u16* D128() const { return (u16*)(ws + O_D128); }
  DEV u16* D256() const { return (u16*)(ws + O_D256); }
  DEV u16* Tmat() const { return (u16*)(ws + O_Tmat); }
  DEV u16* MWt() const { return (u16*)(ws + O_MWt); }
  DEV u16* abuf() const { return (u16*)(ws + O_abuf); }
  DEV u16* UB() const { return (u16*)(ws + O_UB); }
  DEV u16* fbuf() const { return (u16*)(ws + O_fbuf); }
  DEV u16* qbuf() const { return (u16*)(ws + O_qbuf); }
  DEV u16* kbuf() const { return (u16*)(ws + O_kbuf); }
  DEV u16* vT() const { return (u16*)(ws + O_vT); }
  DEV u16* vTc() const { return (u16*)(ws + O_vTc); }
  DEV u16* zbuf() const { return (u16*)(ws + O_zbuf); }
  DEV u16* A1() const { return (u16*)(ws + O_A1); }
  DEV u16* Gbuf() const { return (u16*)(ws + O_Gbuf); }
  DEV u16* ycat() const { return (u16*)(ws + O_ycat); }
  DEV u16* obuf() const { return (u16*)(ws + O_obuf); }
  DEV u16* hidden() const { return (u16*)(ws + O_hidden); }
  DEV float* lamT() const { return (float*)(ws + O_lamT); }
  DEV float* mod() const { return (float*)(ws + O_mod); }
  DEV float* xctx() const { return (float*)(ws + O_xctx); }
  DEV float* E() const { return (float*)(ws + O_E); }
  DEV float* Ktau() const { return (float*)(ws + O_Ktau); }
};

struct XcdMap { int ord, nx, rank, nloc; };
DEV int g_tid() { int t = threadIdx.x; asm volatile("" : "+v"(t)); return t; }
DEV u16 f2bf(float f) { unsigned u = __float_as_uint(f); u += 0x7fffu + ((u >> 16) & 1u); return (u16)(u >> 16); }
DEV float bf2f(u16 h) { return __uint_as_float(((unsigned)h) << 16); }
DEV unsigned pack2(float a, float b) { return (unsigned)f2bf(a) | ((unsigned)f2bf(b) << 16); }
DEV void store_bf4(u16* p, float a, float b, float c, float d) { uint2 v; v.x = pack2(a, b); v.y = pack2(c, d); *(uint2*)p = v; }
DEV float wave_sum(float v) {
#pragma unroll
  for (int o = 32; o >= 1; o >>= 1) v += __shfl_xor(v, o);
  return v;
}
DEV float hw_sin_rev(float r) { return __builtin_amdgcn_sinf(r); }
DEV float hw_cos_rev(float r) { return __builtin_amdgcn_cosf(r); }

template <int BMODE, class Epi>
DEV void gemm_tile(const u16* A, int lda, const u16* B, int ldb, int K, int n0, int m0, int mmax, char* smem,
                   const Epi& epi) {
  const int tid = g_tid(), lane = tid & 63, w = tid >> 6;
  const int wn = w & 1, wm = w >> 1;
  f32x16 acc[2][2];
#pragma unroll
  for (int i = 0; i < 2; ++i)
#pragma unroll
    for (int j = 0; j < 2; ++j)
#pragma unroll
      for (int r = 0; r < 16; ++r) acc[i][j][r] = 0.f;
#define GT_GL1(S, I, K0)                                                                                  \
  {                                                                                                        \
    const int id = tid + 256 * (I);                                                                        \
    const int r = id >> 3, ch = id & 7;                                                                    \
    S##a##I = *(const u32x4*)(A + (size_t)(n0 + r) * lda + (K0) + ch * 8);                                 \
    if (BMODE == 0) {                                                                                      \
      int m = m0 + r;                                                                                      \
      m = m < mmax ? m : mmax - 1;                                                                         \
      S##b##I = *(const u32x4*)(B + (size_t)m * ldb + (K0) + ch * 8);                                      \
    } else if (BMODE == 2) {                                                                               \
      const int k = (K0) + ch * 8;                                                                         \
      S##b##I = *(const u32x4*)(B + ((size_t)(k >> 4) * MR + (m0 + r)) * 16 + (k & 15));                   \
    } else {                                                                                               \
      const int kk = id >> 4, nch = id & 15;                                                               \
      S##b##I = *(const u32x4*)(B + (size_t)((K0) + kk) * ldb + m0 + nch * 8);                             \
    }                                                                                                      \
  }
#define GT_GLOAD(S, K0) GT_GL1(S, 0, K0) GT_GL1(S, 1, K0) GT_GL1(S, 2, K0) GT_GL1(S, 3, K0)
#define GT_SS1(S, I, BUF)                                                                                 \
  {                                                                                                        \
    char* sa = smem + (BUF) * 32768;                                                                       \
    char* sb = sa + 16384;                                                                                 \
    const int id = tid + 256 * (I);                                                                        \
    const int r = id >> 3, ch = id & 7;                                                                    \
    *(u32x4*)(sa + r * 128 + ((ch ^ (r & 7)) << 4)) = S##a##I;                                             \
    if (BMODE != 1) {                                                                                      \
      *(u32x4*)(sb + r * 128 + ((ch ^ (r & 7)) << 4)) = S##b##I;                                           \
    } else {                                                                                               \
      const int kk = id >> 4, nch = id & 15;                                                               \
      _Pragma("unroll") for (int e = 0; e < 8; ++e) {                                                      \
        unsigned wd = S##b##I[e >> 1];                                                                     \
        u16 v = (u16)((e & 1) ? (wd >> 16) : (wd & 0xffffu));                                              \
        int n = nch * 8 + e;                                                                               \
        *(u16*)(sb + n * 128 + ((((kk >> 3) ^ (n & 7)) << 4) + (kk & 7) * 2)) = v;                         \
      }                                                                                                    \
    }                                                                                                      \
  }
#define GT_SSTORE(S, BUF) GT_SS1(S, 0, BUF) GT_SS1(S, 1, BUF) GT_SS1(S, 2, BUF) GT_SS1(S, 3, BUF)
  u32x4 pa0, pa1, pa2, pa3, pb0, pb1, pb2, pb3, qa0, qa1, qa2, qa3, qb0, qb1, qb2, qb3;
  const unsigned lds0 = (unsigned)(uintptr_t)((__attribute__((address_space(3))) char*)smem);
  const int frow = lane & 31, fhi = lane >> 5, fsw = lane & 7;
  const unsigned rA = lds0 + (wn * 64 + frow) * 128, rB = lds0 + 16384 + (wm * 64 + frow) * 128;
  const unsigned aA0 = rA + (((0 + fhi) ^ fsw) << 4), aA1 = rA + (((2 + fhi) ^ fsw) << 4);
  const unsigned aA2 = rA + (((4 + fhi) ^ fsw) << 4), aA3 = rA + (((6 + fhi) ^ fsw) << 4);
  const unsigned aB0 = rB + (((0 + fhi) ^ fsw) << 4), aB1 = rB + (((2 + fhi) ^ fsw) << 4);
  const unsigned aB2 = rB + (((4 + fhi) ^ fsw) << 4), aB3 = rB + (((6 + fhi) ^ fsw) << 4);
  bf16x8 x0a0, x0a1, x0b0, x0b1, x1a0, x1a1, x1b0, x1b1, x2a0, x2a1, x2b0, x2b1, x3a0, x3a1, x3b0, x3b1;
#define GT_DSR(dst, addr, OFF) asm volatile("ds_read_b128 %0, %1 offset:%2" : "=v"(dst) : "v"(addr), "n"(OFF))
#define GT_LOADKS(KS, BUF)                        \
  GT_DSR(x##KS##a0, aA##KS, (BUF) * 32768);        \
  GT_DSR(x##KS##a1, aA##KS, (BUF) * 32768 + 4096); \
  GT_DSR(x##KS##b0, aB##KS, (BUF) * 32768);        \
  GT_DSR(x##KS##b1, aB##KS, (BUF) * 32768 + 4096);
#define GT_MMAKS(KS, N)                                                                                         \
  asm volatile("s_waitcnt lgkmcnt(%4)" : "+v"(x##KS##a0), "+v"(x##KS##a1), "+v"(x##KS##b0), "+v"(x##KS##b1) : "n"(N)); \
  acc[0][0] = __builtin_amdgcn_mfma_f32_32x32x16_bf16(x##KS##a0, x##KS##b0, acc[0][0], 0, 0, 0);                 \
  acc[0][1] = __builtin_amdgcn_mfma_f32_32x32x16_bf16(x##KS##a0, x##KS##b1, acc[0][1], 0, 0, 0);                 \
  acc[1][0] = __builtin_amdgcn_mfma_f32_32x32x16_bf16(x##KS##a1, x##KS##b0, acc[1][0], 0, 0, 0);                 \
  acc[1][1] = __builtin_amdgcn_mfma_f32_32x32x16_bf16(x##KS##a1, x##KS##b1, acc[1][1], 0, 0, 0);
#define GT_COMPUTE(BUF)                                                               \
  GT_LOADKS(0, BUF) GT_LOADKS(1, BUF) GT_LOADKS(2, BUF) GT_LOADKS(3, BUF)              \
  GT_MMAKS(0, 12) GT_MMAKS(1, 8) GT_MMAKS(2, 4) GT_MMAKS(3, 0)
  const int nk = K >> 6;
  const int klast = K - 64;
  GT_GLOAD(p, 0)
  GT_GLOAD(q, 64)
  GT_SSTORE(p, 0)
  __syncthreads();
  for (int kt = 0; kt < nk; kt += 2) {
    {
      int k0 = (kt + 2) << 6;
      k0 = k0 > klast ? klast : k0;
      GT_GLOAD(p, k0)
    }
    GT_COMPUTE(0)
    GT_SSTORE(q, 1)
    __syncthreads();
    {
      int k0 = (kt + 3) << 6;
      k0 = k0 > klast ? klast : k0;
      GT_GLOAD(q, k0)
    }
    GT_COMPUTE(1)
    GT_SSTORE(p, 0)
    __syncthreads();
  }
  epi(acc, n0 + wn * 64, m0 + wm * 64, lane);
}

#define BIG_GLOAD(S, K0)                                                       \
  S##a0 = *(const u32x4*)(ga + (K0));                                          \
  S##a1 = *(const u32x4*)(ga + (size_t)64 * lda + (K0));                       \
  S##a2 = *(const u32x4*)(ga + (size_t)128 * lda + (K0));                      \
  S##a3 = *(const u32x4*)(ga + (size_t)192 * lda + (K0));                      \
  S##b0 = *(const u32x4*)(gb + (K0));                                          \
  S##b1 = *(const u32x4*)(gb + (size_t)64 * ldb + (K0));                       \
  if (NJ >= 3) S##b2 = *(const u32x4*)(gb + (size_t)128 * ldb + (K0));         \
  if (NJ == 4) S##b3 = *(const u32x4*)(gb + (size_t)192 * ldb + (K0));
#define BIG_SSTORE(S, BUF)                                                     \
  *(u32x4*)(smem + (BUF) * 32768 + soff) = S##a0;                              \
  *(u32x4*)(smem + (BUF) * 32768 + soff + 4096) = S##a1;                       \
  *(u32x4*)(smem + (BUF) * 32768 + soff + 8192) = S##a2;                       \
  *(u32x4*)(smem + (BUF) * 32768 + soff + 12288) = S##a3;                      \
  *(u32x4*)(smem + (BUF) * 32768 + 16384 + soff) = S##b0;                      \
  *(u32x4*)(smem + (BUF) * 32768 + 16384 + soff + 4096) = S##b1;               \
  if (NJ >= 3) *(u32x4*)(smem + (BUF) * 32768 + 16384 + soff + 8192) = S##b2;  \
  if (NJ == 4) *(u32x4*)(smem + (BUF) * 32768 + 16384 + soff + 12288) = S##b3;
template <int NJ, class Epi>
DEV void gemm_big(const u16* A, int lda, const u16* B, int ldb, int K, int n0, int m0, char* smem, const Epi& epi) {
  const int tid = g_tid(), lane = tid & 63, w = tid >> 6;
  const int wn = w & 1, wm = w >> 1;
  f32x16 acc[4][NJ];
#pragma unroll
  for (int i = 0; i < 4; ++i)
#pragma unroll
    for (int j = 0; j < NJ; ++j)
#pragma unroll
      for (int r = 0; r < 16; ++r) acc[i][j][r] = 0.f;
  u32x4 pa0, pa1, pa2, pa3, pb0, pb1, pb2, pb3, qa0, qa1, qa2, qa3, qb0, qb1, qb2, qb3;
  pb2 = pb3 = qb2 = qb3 = u32x4{0u, 0u, 0u, 0u};
  const int lrow = tid >> 2, lch = tid & 3;
  const u16* ga = A + (size_t)(n0 + lrow) * lda + lch * 8;
  const u16* gb = B + (size_t)(m0 + lrow) * ldb + lch * 8;
  const int soff = lrow * 64 + ((lch ^ ((lrow >> 2) & 3)) << 4);
  const int frow = lane & 31, fhi = lane >> 5;
  const int sw = (frow >> 2) & 3;
  const unsigned lds0 = (unsigned)(uintptr_t)((__attribute__((address_space(3))) char*)smem);
  const unsigned aA0 = lds0 + (wn * 128 + frow) * 64 + (((0 + fhi) ^ sw) << 4);
  const unsigned aA1 = lds0 + (wn * 128 + frow) * 64 + (((2 + fhi) ^ sw) << 4);
  const unsigned aB0 = lds0 + 16384 + (wm * 32 * NJ + frow) * 64 + (((0 + fhi) ^ sw) << 4);
  const unsigned aB1 = lds0 + 16384 + (wm * 32 * NJ + frow) * 64 + (((2 + fhi) ^ sw) << 4);
#define DSR(dst, addr, OFF) asm volatile("ds_read_b128 %0, %1 offset:%2" : "=v"(dst) : "v"(addr), "n"(OFF))
#define BIG_LOADF(F, AA, AB, BUF)                                   \
  DSR(F##a0, AA, (BUF) * 32768);                                     \
  DSR(F##a1, AA, (BUF) * 32768 + 2048);                              \
  DSR(F##a2, AA, (BUF) * 32768 + 4096);                              \
  DSR(F##a3, AA, (BUF) * 32768 + 6144);                              \
  DSR(F##b0, AB, (BUF) * 32768);                                     \
  DSR(F##b1, AB, (BUF) * 32768 + 2048);                              \
  if (NJ >= 3) DSR(F##b2, AB, (BUF) * 32768 + 4096);                 \
  if (NJ == 4) DSR(F##b3, AB, (BUF) * 32768 + 6144);
#define BIG_WAITF(N, F)                                                                                       \
  asm volatile("s_waitcnt lgkmcnt(%8)"                                                                       \
               : "+v"(F##a0), "+v"(F##a1), "+v"(F##a2), "+v"(F##a3), "+v"(F##b0), "+v"(F##b1), "+v"(F##b2), "+v"(F##b3) \
               : "n"(N));
#define BIG_MFMA(F)                                                                                           \
  acc[0][0] = __builtin_amdgcn_mfma_f32_32x32x16_bf16(F##a0, F##b0, acc[0][0], 0, 0, 0);                        \
  acc[0][1] = __builtin_amdgcn_mfma_f32_32x32x16_bf16(F##a0, F##b1, acc[0][1], 0, 0, 0);                        \
  if (NJ >= 3) acc[0][NJ >= 3 ? 2 : 0] = __builtin_amdgcn_mfma_f32_32x32x16_bf16(F##a0, F##b2, acc[0][NJ >= 3 ? 2 : 0], 0, 0, 0); \
  if (NJ == 4) acc[0][NJ - 1] = __builtin_amdgcn_mfma_f32_32x32x16_bf16(F##a0, F##b3, acc[0][NJ - 1], 0, 0, 0);  \
  acc[1][0] = __builtin_amdgcn_mfma_f32_32x32x16_bf16(F##a1, F##b0, acc[1][0], 0, 0, 0);                        \
  acc[1][1] = __builtin_amdgcn_mfma_f32_32x32x16_bf16(F##a1, F##b1, acc[1][1], 0, 0, 0);                        \
  if (NJ >= 3) acc[1][NJ >= 3 ? 2 : 0] = __builtin_amdgcn_mfma_f32_32x32x16_bf16(F##a1, F##b2, acc[1][NJ >= 3 ? 2 : 0], 0, 0, 0); \
  if (NJ == 4) acc[1][NJ - 1] = __builtin_amdgcn_mfma_f32_32x32x16_bf16(F##a1, F##b3, acc[1][NJ - 1], 0, 0, 0);  \
  acc[2][0] = __builtin_amdgcn_mfma_f32_32x32x16_bf16(F##a2, F##b0, acc[2][0], 0, 0, 0);                        \
  acc[2][1] = __builtin_amdgcn_mfma_f32_32x32x16_bf16(F##a2, F##b1, acc[2][1], 0, 0, 0);                        \
  if (NJ >= 3) acc[2][NJ >= 3 ? 2 : 0] = __builtin_amdgcn_mfma_f32_32x32x16_bf16(F##a2, F##b2, acc[2][NJ >= 3 ? 2 : 0], 0, 0, 0); \
  if (NJ == 4) acc[2][NJ - 1] = __builtin_amdgcn_mfma_f32_32x32x16_bf16(F##a2, F##b3, acc[2][NJ - 1], 0, 0, 0);  \
  acc[3][0] = __builtin_amdgcn_mfma_f32_32x32x16_bf16(F##a3, F##b0, acc[3][0], 0, 0, 0);                        \
  acc[3][1] = __builtin_amdgcn_mfma_f32_32x32x16_bf16(F##a3, F##b1, acc[3][1], 0, 0, 0);                        \
  if (NJ >= 3) acc[3][NJ >= 3 ? 2 : 0] = __builtin_amdgcn_mfma_f32_32x32x16_bf16(F##a3, F##b2, acc[3][NJ >= 3 ? 2 : 0], 0, 0, 0); \
  if (NJ == 4) acc[3][NJ - 1] = __builtin_amdgcn_mfma_f32_32x32x16_bf16(F##a3, F##b3, acc[3][NJ - 1], 0, 0, 0);
#define BIG_COMPUTE(BUF)                 \
  BIG_LOADF(f, aA0, aB0, BUF)            \
  BIG_LOADF(h, aA1, aB1, BUF)            \
  BIG_WAITF(NJ + 4, f)                   \
  BIG_MFMA(f)                            \
  BIG_WAITF(0, h)                        \
  BIG_MFMA(h)
  bf16x8 fa0, fa1, fa2, fa3, fb0, fb1, fb2, fb3, ha0, ha1, ha2, ha3, hb0, hb1, hb2, hb3;
  fb2 = fb3 = hb2 = hb3 = bf16x8{0, 0, 0, 0, 0, 0, 0, 0};
  const int nk = K >> 5;
  const int klast = K - 32;
  BIG_GLOAD(p, 0)
  BIG_GLOAD(q, 32)
  BIG_SSTORE(p, 0)
  __syncthreads();
  for (int kt = 0; kt < nk; kt += 2) {
    {
      int k0 = (kt + 2) << 5;
      k0 = k0 > klast ? klast : k0;
      BIG_GLOAD(p, k0)
    }
    BIG_COMPUTE(0)
    BIG_SSTORE(q, 1)
    __syncthreads();
    {
      int k0 = (kt + 3) << 5;
      k0 = k0 > klast ? klast : k0;
      BIG_GLOAD(q, k0)
    }
    BIG_COMPUTE(1)
    BIG_SSTORE(p, 0)
    __syncthreads();
  }
  epi(acc, n0 + wn * 128, m0 + wm * 32 * NJ, lane);
}


template <int NJ, class Epi>
DEV void big_gemm_phase(const u16* A, int lda, const u16* B, int ldb, int K, int NF, int G, int bid, int nblk, char* smem,
                        const Epi& epi, const XcdMap& xm) {
  constexpr int TT = 64 * NJ;
  const int NT = MR / TT;
  if (xm.nx > 0) {
    const int xcd = xm.ord, slot = xm.rank;
    const int rem = NT % xm.nx;
    const int TPX = NT / xm.nx + (xcd < rem ? 1 : 0);
    const int t0 = xcd * (NT / xm.nx) + (xcd < rem ? xcd : rem);
    for (int j = slot; j < NF * TPX; j += xm.nloc) {
      int f = (j / (G * TPX)) * G + j % G;
      int t = t0 + (j / G) % TPX;
      gemm_big<NJ>(A, lda, B, ldb, K, f * 256, t * TT, smem, epi);
    }
  } else {
    for (int job = bid; job < NF * NT; job += nblk) gemm_big<NJ>(A, lda, B, ldb, K, (job % NF) * 256, (job / NF) * TT, smem, epi);
  }
}

template <int NI, int NJ, class F>
DEV void for_quads(f32x16 (&acc)[NI][NJ], int nW, int mW, int lane, F f) {
#pragma unroll
  for (int i = 0; i < NI; ++i)
#pragma unroll
    for (int j = 0; j < NJ; ++j)
#pragma unroll
      for (int q = 0; q < 4; ++q) {
        int nf = nW + i * 32 + 8 * q + 4 * (lane >> 5);
        int m = mW + j * 32 + (lane & 31);
        f(nf, m, acc[i][j][4 * q], acc[i][j][4 * q + 1], acc[i][j][4 * q + 2], acc[i][j][4 * q + 3]);
      }
}

struct EpiInproj {
  const Params& P;
  template <int NI, int NJ>
  DEV void operator()(f32x16 (&acc)[NI][NJ], int nW, int mW, int lane) const {
    const int hi = lane >> 5;
#pragma unroll
    for (int i = 0; i < NI; ++i) {
      const int nt = nW + i * 32;
#pragma unroll
      for (int j = 0; j < NJ; ++j) {
        const int m = mW + j * 32 + (lane & 31);
        f32x16 a = acc[i][j];
        if (nt < 384) {
#pragma unroll
          for (int q = 0; q < 4; ++q) {
            int nf = nt + 8 * q + 4 * hi;
            int g = nf >> 4, h = nf & 15;
            u16* dst = P.UB() + ((size_t)(g * NCH + (m >> 5))) * 768 + (m & 31) * 16 + h;
            store_bf4(dst, a[4 * q], a[4 * q + 1], a[4 * q + 2], a[4 * q + 3]);
          }
        } else if (nt < 640) {
#pragma unroll
          for (int q = 0; q < 4; ++q) {
            int nf = nt + 8 * q + 4 * hi - 384;
            store_bf4(P.fbuf() + (size_t)m * 256 + nf, a[4 * q], a[4 * q + 1], a[4 * q + 2], a[4 * q + 3]);
          }
        } else if (nt < 1408) {
          const bool isq = nt < 1024;
          const int off = nt - (isq ? 640 : 1024);
          if (m < NLAT) {
            const int l = m & (SEQ - 1);
            const float pos = (off & 32) ? (float)(l & 63) : (float)(l >> 6);
#pragma unroll
            for (int e = 0; e < 8; ++e) {
              int fl = 8 * (e >> 2) + 4 * hi + (e & 3);
              float freq = exp2f(-(float)fl * (13.287712379549449f / 16.f));
              float rev = pos * freq * 0.15915494309189535f;
              float sn = hw_sin_rev(rev), cs = hw_cos_rev(rev);
              float x1 = a[e], x2 = a[e + 8];
              a[e] = x1 * cs - x2 * sn;
              a[e + 8] = x2 * cs + x1 * sn;
            }
          }
          const float sc = isq ? 0.125f : 1.f;
          u16* base = (isq ? P.qbuf() : P.kbuf()) + (size_t)m * 384 + off;
#pragma unroll
          for (int q = 0; q < 4; ++q)
            store_bf4(base + 8 * q + 4 * hi, a[4 * q] * sc, a[4 * q + 1] * sc, a[4 * q + 2] * sc, a[4 * q + 3] * sc);
        } else {
#pragma unroll
          for (int r = 0; r < 16; ++r) {
            int feat = nt - 1408 + (r & 3) + 8 * (r >> 2) + 4 * hi;
            if (m < NLAT)
              P.vT()[((size_t)((m >> 13) * 384 + feat)) * SEQ + (m & (SEQ - 1))] = f2bf(a[r]);
            else
              P.vTc()[((size_t)(((m - NLAT) >> 8) * 384 + feat)) * LCX + ((m - NLAT) & 255)] = f2bf(a[r]);
          }
        }
      }
    }
  }
};

struct EpiSsmEnd {
  float* Eg;
  template <int NI, int NJ>
  DEV void operator()(f32x16 (&acc)[NI][NJ], int nW, int mW, int lane) const {
    for_quads(acc, nW, mW, lane, [&](int nf, int m, float a, float b, float c, float d) {
      if (m < NCH) *(float4*)(Eg + (size_t)m * 256 + nf) = make_float4(a, b, c, d);
    });
  }
};

DEV float gelu_tanh(float x) {
  float u = 0.7978845608028654f * (x + 0.044715f * x * x * x);
  float t = 1.f - 2.f / (1.f + __expf(2.f * u));
  return 0.5f * x * (1.f + t);
}

struct EpiSsmOut {
  u16* zb;
  int g;
  template <int NI, int NJ>
  DEV void operator()(f32x16 (&acc)[NI][NJ], int nW, int mW, int lane) const {
    for_quads(acc, nW, mW, lane, [&](int nf, int m, float a, float b, float c, float d) {
      if (m < NCH) {
        int t = nf >> 4, h = nf & 15;
        store_bf4(zb + ((size_t)g * MR + m * TCH + t) * 16 + h, gelu_tanh(a), gelu_tanh(b), gelu_tanh(c),
                  gelu_tanh(d));
      }
    });
  }
};

struct EpiGlu {
  const u16* zb;
  u16* yc;
  template <int NI, int NJ>
  DEV void operator()(f32x16 (&acc)[NI][NJ], int nW, int mW, int lane) const {
    for_quads(acc, nW, mW, lane, [&](int nf, int m, float a, float b, float c, float d) {
      uint2 zz = *(const uint2*)(zb + ((size_t)(nf >> 4) * MR + m) * 16 + (nf & 15));
      float z0 = bf2f((u16)(zz.x & 0xffff)), z1 = bf2f((u16)(zz.x >> 16));
      float z2 = bf2f((u16)(zz.y & 0xffff)), z3 = bf2f((u16)(zz.y >> 16));
      store_bf4(yc + (size_t)m * 1024 + nf, z0 / (1.f + __expf(-a)), z1 / (1.f + __expf(-b)), z2 / (1.f + __expf(-c)),
                z3 / (1.f + __expf(-d)));
    });
  }
};

struct EpiFnetA {
  u16* A1b;
  template <int NI, int NJ>
  DEV void operator()(f32x16 (&acc)[NI][NJ], int nW, int mW, int lane) const {
    for_quads(acc, nW, mW, lane, [&](int nf, int m, float a, float b, float c, float d) {
      int k1 = nf >> 1;
      int cc = m >> 8, j = m & 255;
      u16* p = A1b + ((size_t)(k1 * 128 + cc * 2)) * 256 + j;
      p[0] = f2bf(a);
      p[256] = f2bf(b);
      p[128 * 256] = f2bf(c);
      p[128 * 256 + 256] = f2bf(d);
    });
  }
};

struct EpiFnetCtx {
  u16* Gb;
  template <int NI, int NJ>
  DEV void operator()(f32x16 (&acc)[NI][NJ], int nW, int mW, int lane) const {
    for_quads(acc, nW, mW, lane, [&](int nf, int m, float a, float b, float c, float d) {
      int k = nf >> 1;
      const float s = 1.f / 128.f;
      u16* p = Gb + (size_t)k * 512 + m;
      p[0] = f2bf(a * s);
      p[256] = f2bf(b * s);
      p[512] = f2bf(c * s);
      p[512 + 256] = f2bf(d * s);
    });
  }
};

struct EpiFnetC {
  u16* Gb;
  template <int NI, int NJ>
  DEV void operator()(f32x16 (&acc)[NI][NJ], int nW, int mW, int lane) const {
    for_quads(acc, nW, mW, lane, [&](int nf, int m, float a, float b, float c, float d) {
      int k2 = nf >> 1;
      const float s = 0.0013810679320049757f;
      u16* p = Gb + (size_t)k2 * 128 * 512 + m;
      p[0] = f2bf(a * s);
      p[256] = f2bf(b * s);
      p[128 * 512] = f2bf(c * s);
      p[128 * 512 + 256] = f2bf(d * s);
    });
  }
};

struct EpiStoreBf {
  u16* dst;
  int ld, coff;
  template <int NI, int NJ>
  DEV void operator()(f32x16 (&acc)[NI][NJ], int nW, int mW, int lane) const {
    for_quads(acc, nW, mW, lane, [&](int nf, int m, float a, float b, float c, float d) {
      store_bf4(dst + (size_t)m * ld + coff + nf, a, b, c, d);
    });
  }
};

struct EpiGateUp {
  u16* hid;
  template <int NI, int NJ>
  DEV void operator()(f32x16 (&acc)[NI][NJ], int nW, int mW, int lane) const {
    const int hi = lane >> 5;
#pragma unroll
    for (int ip = 0; ip < NI / 2; ++ip)
#pragma unroll
      for (int j = 0; j < NJ; ++j) {
        const int m = mW + j * 32 + (lane & 31);
#pragma unroll
        for (int q = 0; q < 4; ++q) {
          float o[4];
#pragma unroll
          for (int e = 0; e < 4; ++e) {
            float g = acc[2 * ip][j][4 * q + e], u = acc[2 * ip + 1][j][4 * q + e];
            o[e] = g / (1.f + __expf(-g)) * u;
          }
          int col = (nW >> 6) * 32 + ip * 32 + 8 * q + 4 * hi;
          store_bf4(hid + (size_t)m * DFF + col, o[0], o[1], o[2], o[3]);
        }
      }
  }
};

DEV void transpose_tile(const float* src, int K, int N, u16* dst, int mode, int kt, int nt, char* smem) {
  float* s = (float*)smem;
  const int tid = g_tid();
  const int k0 = kt * 64, n0 = nt * 64;
#pragma unroll
  for (int i = 0; i < 4; ++i) {
    int id = tid + 256 * i;
    int kk = id >> 4, c4 = id & 15;
    float4 v = *(const float4*)(src + (size_t)(k0 + kk) * N + n0 + c4 * 4);
    s[kk * 65 + c4 * 4 + 0] = v.x;
    s[kk * 65 + c4 * 4 + 1] = v.y;
    s[kk * 65 + c4 * 4 + 2] = v.z;
    s[kk * 65 + c4 * 4 + 3] = v.w;
  }
  __syncthreads();
#pragma unroll
  for (int i = 0; i < 2; ++i) {
    int id = tid + 256 * i;
    int nn = id >> 3, kc = id & 7;
    int n = n0 + nn;
    int row = mode == 0 ? n : (64 * (n >> 5) + (n & 31) + (mode == 2 ? 32 : 0));
    uint4 o;
    o.x = pack2(s[(kc * 8 + 0) * 65 + nn], s[(kc * 8 + 1) * 65 + nn]);
    o.y = pack2(s[(kc * 8 + 2) * 65 + nn], s[(kc * 8 + 3) * 65 + nn]);
    o.z = pack2(s[(kc * 8 + 4) * 65 + nn], s[(kc * 8 + 5) * 65 + nn]);
    o.w = pack2(s[(kc * 8 + 6) * 65 + nn], s[(kc * 8 + 7) * 65 + nn]);
    *(uint4*)(dst + (size_t)row * K + k0 + kc * 8) = o;
  }
  __syncthreads();
}

DEV void lam_pow(float are, float aim, float dt, int n, float& pr, float& pi) {
  float mag = expf((float)n * are * dt);
  double rev = (double)n * (double)aim * (double)dt * 0.15915494309189535;
  rev -= rint(rev);
  float fr = (float)rev;
  pr = mag * hw_cos_rev(fr);
  pi = mag * hw_sin_rev(fr);
}
DEV void zoh_factor(float are, float aim, float dt, float& fr, float& fi) {
  float lr, li;
  lam_pow(are, aim, dt, 1, lr, li);
  float nr = lr - 1.f, ni = li;
  float d2 = are * are + aim * aim;
  fr = (nr * are + ni * aim) / d2;
  fi = (ni * are - nr * aim) / d2;
}

constexpr int PREP_TR = 2852;
constexpr int PREP_KF = 24 * 63;
constexpr int PREP_WC = 24 * 2 * 32;
constexpr int PREP_WE = 24 * 2 * 8;
constexpr int PREP_MW = 64;
constexpr int PREP_N = PREP_TR + PREP_KF + PREP_WC + PREP_WE + PREP_MW;
constexpr int EXPAND_N = 24 * 32;

DEV void prep_job(const Params& P, int layer, int job, char* smem) {
  const int tid = g_tid();
  if (job < PREP_TR) {
    int j = job;
    if (j < 448) { transpose_tile(P.w_in + (size_t)layer * DM * INW, DM, INW, P.wt_in(), 0, j / 28, j % 28, smem); return; }
    j -= 448;
    if (j < 256) { transpose_tile(P.w_out + (size_t)layer * DM * DM, DM, DM, P.wt_out(), 0, j / 16, j % 16, smem); return; }
    j -= 256;
    if (j < 36) { transpose_tile(P.w_glu + (size_t)layer * 384 * 384, 384, 384, P.wt_glu(), 0, j / 6, j % 6, smem); return; }
    j -= 36;
    if (j < 704) { transpose_tile(P.w_gate + (size_t)layer * DM * DFF, DM, DFF, P.wt_gu(), 1, j / 44, j % 44, smem); return; }
    j -= 704;
    if (j < 704) { transpose_tile(P.w_up + (size_t)layer * DM * DFF, DM, DFF, P.wt_gu(), 2, j / 44, j % 44, smem); return; }
    j -= 704;
    transpose_tile(P.w_down + (size_t)layer * DFF * DM, DFF, DM, P.wt_dn(), 0, j / 16, j % 16, smem);
    return;
  }
  job -= PREP_TR;
  float* sf = (float*)smem;
  if (job < PREP_KF) {
    const int g = job / 63, delta = job % 63 - 31;
    const int ad = delta < 0 ? -delta : delta;
    float* sQ = sf;
    float* sCQ = sf + 256;
    float* sB = sf + 256 + 4096;
#pragma unroll
    for (int i = 0; i < 4; ++i) {
      const float* src = ((i & 1) ? P.b_im : P.b_re) + ((size_t)(((layer * 2 + (i >> 1)) * 24 + g) * 64)) * 16;
      *(float4*)(sB + i * 1024 + tid * 4) = *(const float4*)(src + tid * 4);
    }
    if (tid < 128) {
      int dir = tid >> 6, p = tid & 63;
      int ix = ((layer * 2 + dir) * 24 + g) * 64 + p;
      float are = P.a_re[ix], aim = P.a_im[ix], dt = expf(P.log_dt[(layer * 2 + dir) * 24 + g]);
      float pr, pi, fr, fi;
      lam_pow(are, aim, dt, ad, pr, pi);
      zoh_factor(are, aim, dt, fr, fi);
      sQ[(dir * 64 + p) * 2 + 0] = pr * fr - pi * fi;
      sQ[(dir * 64 + p) * 2 + 1] = pr * fi + pi * fr;
    }
    __syncthreads();
#pragma unroll
    for (int i = 0; i < 8; ++i) {
      int e = tid + 256 * i;
      int dir = e >> 10, h = (e >> 6) & 15, p = e & 63;
      size_t ci = ((size_t)(((layer * 2 + dir) * 24 + g) * 16 + h)) * 64 + p;
      float cr = P.c_re[ci], cim = P.c_im[ci];
      float qr = sQ[(dir * 64 + p) * 2], qi = sQ[(dir * 64 + p) * 2 + 1];
      sCQ[e * 2 + 0] = cr * qr - cim * qi;
      sCQ[e * 2 + 1] = cr * qi + cim * qr;
    }
    __syncthreads();
    const int h = tid >> 4, hp = tid & 15;
    float val = 0.f;
#pragma unroll
    for (int dir = 0; dir < 2; ++dir) {
      bool need = dir == 0 ? (delta >= 0) : (delta <= 0);
      if (need) {
        const float* br = sB + (dir * 2) * 1024 + hp;
        const float* bi = sB + (dir * 2 + 1) * 1024 + hp;
        const float* cq = sCQ + ((dir * 16 + h) * 64) * 2;
#pragma unroll 16
        for (int p = 0; p < 64; ++p) val += cq[p * 2] * br[p * 16] - cq[p * 2 + 1] * bi[p * 16];
      }
    }
    if (delta == 0 && h == hp) val += P.ssm_d[layer * 384 + g * 16 + h];
    P.Ktau()[(size_t)job * 256 + tid] = val;
    __syncthreads();
    return;
  }
  job -= PREP_KF;
  if (job < PREP_WC) {
    const int j = job & 31, dir = (job >> 5) & 1, g = job >> 6;
    float* sP = sf;
    if (tid < 64) {
      int p = tid;
      int ix = ((layer * 2 + dir) * 24 + g) * 64 + p;
      float are = P.a_re[ix], aim = P.a_im[ix], dt = expf(P.log_dt[(layer * 2 + dir) * 24 + g]);
      float pr, pi;
      lam_pow(are, aim, dt, dir == 0 ? j + 1 : 32 - j, pr, pi);
      sP[p * 2] = pr;
      sP[p * 2 + 1] = pi;
      if (j == 0) {
        float tr, ti;
        lam_pow(are, aim, dt, 32, tr, ti);
        P.lamT()[((dir * 24 + g) * 64 + p) * 2] = tr;
        P.lamT()[((dir * 24 + g) * 64 + p) * 2 + 1] = ti;
      }
    }
    __syncthreads();
#pragma unroll
    for (int i = 0; i < 8; ++i) {
      int e = tid + 256 * i;
      int h = e >> 7, pc = e & 127, p = pc >> 1, ri = pc & 1;
      size_t ci = ((size_t)(((layer * 2 + dir) * 24 + g) * 16 + h)) * 64 + p;
      float cr = P.c_re[ci], cim = P.c_im[ci];
      float pr = sP[p * 2], pi = sP[p * 2 + 1];
      float v = ri == 0 ? (cr * pr - cim * pi) : -(cr * pi + cim * pr);
      P.A_out()[((size_t)(g * 512 + j * 16 + h)) * 768 + 512 + dir * 128 + pc] = f2bf(v);
    }
    __syncthreads();
    return;
  }
  job -= PREP_WC;
  if (job < PREP_WE) {
    const int jq = job & 7, dir = (job >> 3) & 1, g = job >> 4;
    float* sP = sf;
    {
      int jj = tid >> 6, p = tid & 63;
      int j = jq * 4 + jj;
      int ix = ((layer * 2 + dir) * 24 + g) * 64 + p;
      float are = P.a_re[ix], aim = P.a_im[ix], dt = expf(P.log_dt[(layer * 2 + dir) * 24 + g]);
      float pr, pi, fr, fi;
      lam_pow(are, aim, dt, dir == 0 ? 31 - j : j, pr, pi);
      zoh_factor(are, aim, dt, fr, fi);
      sP[(jj * 64 + p) * 2] = pr * fr - pi * fi;
      sP[(jj * 64 + p) * 2 + 1] = pr * fi + pi * fr;
    }
    __syncthreads();
    {
      const int prow = tid >> 1, half = tid & 1, p = prow >> 1, ri = prow & 1;
      const size_t bbase = ((size_t)(((layer * 2 + dir) * 24 + g) * 64 + p)) * 16;
      u16* dst = P.A_end() + ((size_t)(g * 256 + dir * 128 + prow)) * 512 + jq * 64 + half * 32;
#pragma unroll
      for (int q = 0; q < 2; ++q) {
        int jj = half * 2 + q;
        float pr = sP[(jj * 64 + p) * 2], pi = sP[(jj * 64 + p) * 2 + 1];
        unsigned pk[8];
#pragma unroll
        for (int h2 = 0; h2 < 8; ++h2) {
          float b0r = P.b_re[bbase + 2 * h2], b0i = P.b_im[bbase + 2 * h2];
          float b1r = P.b_re[bbase + 2 * h2 + 1], b1i = P.b_im[bbase + 2 * h2 + 1];
          float v0 = ri == 0 ? (pr * b0r - pi * b0i) : (pr * b0i + pi * b0r);
          float v1 = ri == 0 ? (pr * b1r - pi * b1i) : (pr * b1i + pi * b1r);
          pk[h2] = pack2(v0, v1);
        }
        *(uint4*)(dst + q * 16) = make_uint4(pk[0], pk[1], pk[2], pk[3]);
        *(uint4*)(dst + q * 16 + 8) = make_uint4(pk[4], pk[5], pk[6], pk[7]);
      }
    }
    __syncthreads();
    return;
  }
  job -= PREP_WE;
  {
    const int nb = job & 7, g = (job >> 3) & 3, ri = job >> 5;
    const float* wf = P.w_fourier + (size_t)layer * 256 * 256;
    float* sW = sf;
    float* sT = sf + 2048;
#pragma unroll
    for (int i = 0; i < 2; ++i) {
      int e = tid + 256 * i;
      *(float4*)(sW + e * 4) = *(const float4*)(wf + (size_t)(g * 64 + (e >> 3)) * 256 + nb * 32 + (e & 7) * 4);
    }
    if (tid < 64) {
      float fr = (float)tid * (1.f / 64.f);
      sT[tid] = ri ? hw_sin_rev(fr) : hw_cos_rev(fr);
    }
    __syncthreads();
    const int nl = tid >> 3, jg = tid & 7;
    const int n = nb * 32 + nl;
    unsigned pk[4];
#pragma unroll
    for (int jp = 0; jp < 4; ++jp) {
      float sum2[2];
#pragma unroll
      for (int q = 0; q < 2; ++q) {
        int j = jg * 8 + jp * 2 + q;
        float sum = 0.f;
#pragma unroll 8
        for (int m = 0; m < 64; ++m) sum += sT[(m * j) & 63] * sW[m * 32 + nl];
        sum2[q] = sum;
      }
      pk[jp] = pack2(sum2[0], sum2[1]);
    }
    *(uint4*)(P.MWt() + (size_t)n * 512 + ri * 256 + g * 64 + jg * 8) = make_uint4(pk[0], pk[1], pk[2], pk[3]);
    __syncthreads();
  }
}

DEV void expand_job(const Params& P, int job) {
  const int tid = g_tid();
  const int g = job >> 5, t = job & 31;
  const int h = tid >> 4, cgp = tid & 15;
  u16* dst = P.A_out() + ((size_t)(g * 512 + t * 16 + h)) * 768 + cgp * 32;
#pragma unroll
  for (int q = 0; q < 2; ++q) {
    int sidx = cgp * 2 + q;
    int dI = t - sidx + 31;
    const float4* src = (const float4*)(P.Ktau() + ((size_t)(g * 63 + dI)) * 256 + h * 16);
    float4 a = src[0], b = src[1], c = src[2], d = src[3];
    *(uint4*)(dst + q * 16) = make_uint4(pack2(a.x, a.y), pack2(a.z, a.w), pack2(b.x, b.y), pack2(b.z, b.w));
    *(uint4*)(dst + q * 16 + 8) = make_uint4(pack2(c.x, c.y), pack2(c.z, c.w), pack2(d.x, d.y), pack2(d.z, d.w));
  }
}

constexpr int CONST_MOD = 384, CONST_D128 = 16, CONST_D256 = 64, CONST_T = 1024;
constexpr int CONST_N = CONST_MOD + CONST_D128 + CONST_D256 + CONST_T;

DEV void const_job(const Params& P, int job, char* smem) {
  const int tid = g_tid();
  if (job < CONST_MOD) {
    const int layer = job / 192, cb = job % 192;
    float* sv = (float*)smem;
    float* red = sv + 3 * 1024;
    for (int i = tid; i < 3 * 1024; i += 256) {
      int v = i >> 10, k = i & 1023;
      float cv = v < 2 ? P.c[v * 1024 + k] : P.c_ctx[k];
      sv[i] = cv / (1.f + __expf(-cv));
    }
    __syncthreads();
    const int kg = tid >> 5, cl = tid & 31;
    const int n = cb * 32 + cl;
    const float* W = P.w_mod + (size_t)layer * DM * 6144 + n;
    float a0 = 0.f, a1 = 0.f, a2 = 0.f;
#pragma unroll 16
    for (int k = kg * 128; k < kg * 128 + 128; ++k) {
      float wv = W[(size_t)k * 6144];
      a0 += sv[k] * wv;
      a1 += sv[1024 + k] * wv;
      a2 += sv[2048 + k] * wv;
    }
    red[(kg * 3 + 0) * 32 + cl] = a0;
    red[(kg * 3 + 1) * 32 + cl] = a1;
    red[(kg * 3 + 2) * 32 + cl] = a2;
    __syncthreads();
    if (tid < 96) {
      int v = tid >> 5, c2 = tid & 31;
      float s = P.b_mod[layer * 6144 + cb * 32 + c2];
      for (int q = 0; q < 8; ++q) s += red[(q * 3 + v) * 32 + c2];
      P.mod()[(layer * 3 + v) * 6144 + cb * 32 + c2] = s;
    }
    __syncthreads();
    return;
  }
  job -= CONST_MOD;
  if (job < CONST_D128) {
#pragma unroll
    for (int i = 0; i < 8; ++i) {
      int idx = job * 2048 + tid + 256 * i;
      int row = idx >> 7, r = idx & 127;
      int k1 = row >> 1, ri = row & 1;
      float fr = (float)((k1 * r) & 127) * (1.f / 128.f);
      P.D128()[idx] = f2bf(ri ? -hw_sin_rev(fr) : hw_cos_rev(fr));
    }
    return;
  }
  job -= CONST_D128;
  if (job < CONST_D256) {
#pragma unroll
    for (int i = 0; i < 8; ++i) {
      int idx = job * 2048 + tid + 256 * i;
      int row = idx >> 8, l = idx & 255;
      int k = row >> 1, ri = row & 1;
      float fr = (float)((k * l) & 255) * (1.f / 256.f);
      P.D256()[idx] = f2bf(ri ? -hw_sin_rev(fr) : hw_cos_rev(fr));
    }
    return;
  }
  job -= CONST_D256;
  {
#pragma unroll
    for (int i = 0; i < 8; ++i) {
      int idx = job * 2048 + tid + 256 * i;
      int k1 = idx >> 14, row = (idx >> 7) & 127, col = idx & 127;
      int k2 = row >> 1, ri = row & 1, cc = col >> 1, rj = col & 1;
      float fr = (float)((cc * (k1 + 128 * k2)) & 8191) * (1.f / 8192.f);
      float cs = hw_cos_rev(fr), sn = hw_sin_rev(fr);
      float v = (ri == rj) ? cs : (ri == 0 ? sn : -sn);
      P.Tmat()[idx] = f2bf(v);
    }
  }
}

DEV float4 ld4(const float* p) { return *(const float4*)p; }
DEV float4 ldbf4(const u16* p) {
  uint2 v = *(const uint2*)p;
  return make_float4(bf2f((u16)(v.x & 0xffff)), bf2f((u16)(v.x >> 16)), bf2f((u16)(v.y & 0xffff)), bf2f((u16)(v.y >> 16)));
}
DEV float sq4(float4 v) { return v.x * v.x + v.y * v.y + v.z * v.z + v.w * v.w; }

constexpr int NR = 4;
DEV void rowop(const Params& P, int kind, int layer, int m0, int lane) {
  const bool last = layer == 1;
  if (kind == 2 && last && m0 >= NLAT) return;
  const int mi = m0 < NLAT ? (m0 >> 13) : 2;
  float* resid = m0 < NLAT ? P.out + (size_t)m0 * DM : P.xctx() + (size_t)(m0 - NLAT) * DM;
  const float* xin;
  if (kind == 0 || (kind == 1 && layer == 0))
    xin = m0 < NLAT ? P.x + (size_t)m0 * DM : P.ctx + (size_t)(m0 - NLAT) * DM;
  else
    xin = resid;
  const float* modv = P.mod() + (size_t)(layer * 3 + mi) * 6144;
  float4 v[NR][4];
#pragma unroll
  for (int r = 0; r < NR; ++r)
#pragma unroll
    for (int i = 0; i < 4; ++i) v[r][i] = ld4(xin + (size_t)r * DM + i * 256 + lane * 4);
  if (kind != 0) {
    const float* gpost = (kind == 1 ? P.g_post_mix : P.g_post_ffn) + layer * DM;
    const float* gate = modv + (kind == 1 ? 2048 : 5120);
    float4 o[NR][4];
    float ss[NR];
#pragma unroll
    for (int r = 0; r < NR; ++r) {
      ss[r] = 0.f;
#pragma unroll
      for (int i = 0; i < 4; ++i) {
        o[r][i] = ldbf4(P.obuf() + (size_t)(m0 + r) * DM + i * 256 + lane * 4);
        ss[r] += sq4(o[r][i]);
      }
    }
    float rinv[NR];
#pragma unroll
    for (int r = 0; r < NR; ++r) rinv[r] = rsqrtf(wave_sum(ss[r]) * (1.f / DM) + EPS);
#pragma unroll
    for (int i = 0; i < 4; ++i) {
      float4 gp = ld4(gpost + i * 256 + lane * 4), gt = ld4(gate + i * 256 + lane * 4);
#pragma unroll
      for (int r = 0; r < NR; ++r) {
        v[r][i].x += gt.x * (o[r][i].x * rinv[r] * gp.x);
        v[r][i].y += gt.y * (o[r][i].y * rinv[r] * gp.y);
        v[r][i].z += gt.z * (o[r][i].z * rinv[r] * gp.z);
        v[r][i].w += gt.w * (o[r][i].w * rinv[r] * gp.w);
      }
    }
    float* dst = (kind == 2 && last) ? P.out + (size_t)m0 * DM : resid;
#pragma unroll
    for (int r = 0; r < NR; ++r)
#pragma unroll
      for (int i = 0; i < 4; ++i) *(float4*)(dst + (size_t)r * DM + i * 256 + lane * 4) = v[r][i];
    if (kind == 2 && last) return;
  }
  const int la = kind == 2 ? layer + 1 : layer;
  const float* gpre = (kind == 1 ? P.g_pre_ffn : P.g_pre_mix) + la * DM;
  const float* mv = P.mod() + (size_t)(la * 3 + mi) * 6144;
  const float* sh = mv + (kind == 1 ? 3072 : 0);
  const float* sc = mv + (kind == 1 ? 4096 : 1024);
  float rinv2[NR];
#pragma unroll
  for (int r = 0; r < NR; ++r) {
    float ss = 0.f;
#pragma unroll
    for (int i = 0; i < 4; ++i) ss += sq4(v[r][i]);
    rinv2[r] = rsqrtf(wave_sum(ss) * (1.f / DM) + EPS);
  }
#pragma unroll
  for (int i = 0; i < 4; ++i) {
    int col = i * 256 + lane * 4;
    float4 gp = ld4(gpre + col), s1 = ld4(sc + col), s0 = ld4(sh + col);
#pragma unroll
    for (int r = 0; r < NR; ++r)
      store_bf4(P.abuf() + (size_t)(m0 + r) * DM + col, v[r][i].x * rinv2[r] * gp.x * (1.f + s1.x) + s0.x,
                v[r][i].y * rinv2[r] * gp.y * (1.f + s1.y) + s0.y, v[r][i].z * rinv2[r] * gp.z * (1.f + s1.z) + s0.z,
                v[r][i].w * rinv2[r] * gp.w * (1.f + s1.w) + s0.w);
  }
}

DEV void attn_wave(const Params& P, int layer, bool isctx, int b, int h, int r, int cgp, int lane) {
  const int qi = lane & 15, g = lane >> 4;
  int mq, c = 0, cs = 0, cb = 0, rs = 0;
  if (!isctx) {
    c = cgp * 16 + qi;
    mq = b * SEQ + r * 64 + c;
    cs = c - 8;
    cs = cs < 0 ? 0 : (cs > 48 ? 48 : cs);
    cb = cgp == 0 ? 0 : (cgp == 1 ? 8 : (cgp == 2 ? 24 : 32));
    rs = r - 4;
    rs = rs < 0 ? 0 : (rs > 120 ? 120 : rs);
  } else {
    mq = NLAT + b * LCX + cgp * 16 + qi;
  }
  const u16* qp = P.qbuf() + (size_t)mq * 384 + h * 64 + g * 8;
  const bf16x8 qf0 = *(const bf16x8*)qp, qf1 = *(const bf16x8*)(qp + 32);
  f32x4 o[4];
#pragma unroll
  for (int d = 0; d < 4; ++d) o[d] = f32x4{0.f, 0.f, 0.f, 0.f};
  float mrun = -1e30f, lrun = 0.f;
  const float* rp = P.rpb + (size_t)(layer * 6 + h) * 465;
  const int nblk = isctx ? 8 : 16;
  struct KV {
    bf16x8 k00, k01, k10, k11;
    uint2 v0a, v0b, v1a, v1b, v2a, v2b, v3a, v3b;
  };
  auto loadkv = [&](KV& x, int kb) {
    kb = kb < nblk ? kb : nblk - 1;
    const bool win = (!isctx) && kb < 8;
    size_t krow0;
    const u16* vbase;
    int vld;
    if (win) {
      int tok0 = (rs + kb) * 64 + cb;
      krow0 = (size_t)b * SEQ + tok0;
      vbase = P.vT() + ((size_t)(b * 384 + h * 64)) * SEQ + tok0;
      vld = SEQ;
    } else {
      int kc = (isctx ? kb : kb - 8) * 32;
      krow0 = (size_t)NLAT + b * LCX + kc;
      vbase = P.vTc() + ((size_t)(b * 384 + h * 64)) * LCX + kc;
      vld = LCX;
    }
    const u16* kp0 = P.kbuf() + (krow0 + qi) * 384 + h * 64 + g * 8;
    const u16* kp1 = kp0 + 16 * 384;
    x.k00 = *(const bf16x8*)kp0;
    x.k01 = *(const bf16x8*)(kp0 + 32);
    x.k10 = *(const bf16x8*)kp1;
    x.k11 = *(const bf16x8*)(kp1 + 32);
    const u16* vp = vbase + (size_t)qi * vld + g * 4;
    x.v0a = *(const uint2*)vp;
    x.v0b = *(const uint2*)(vp + 16);
    x.v1a = *(const uint2*)(vp + (size_t)16 * vld);
    x.v1b = *(const uint2*)(vp + (size_t)16 * vld + 16);
    x.v2a = *(const uint2*)(vp + (size_t)32 * vld);
    x.v2b = *(const uint2*)(vp + (size_t)32 * vld + 16);
    x.v3a = *(const uint2*)(vp + (size_t)48 * vld);
    x.v3b = *(const uint2*)(vp + (size_t)48 * vld + 16);
  };
  auto pvmma = [&](f32x4& od, uint2 va, uint2 vb, bf16x8 pf) {
    union { uint4 u; bf16x8 v; } cv;
    cv.u = make_uint4(va.x, va.y, vb.x, vb.y);
    od = __builtin_amdgcn_mfma_f32_16x16x32_bf16(cv.v, pf, od, 0, 0, 0);
  };
  auto step = [&](const KV& x, int kb) {
    const bool win = (!isctx) && kb < 8;
    f32x4 s[2];
    {
      f32x4 z = {0.f, 0.f, 0.f, 0.f};
      z = __builtin_amdgcn_mfma_f32_16x16x32_bf16(x.k00, qf0, z, 0, 0, 0);
      s[0] = __builtin_amdgcn_mfma_f32_16x16x32_bf16(x.k01, qf1, z, 0, 0, 0);
      f32x4 z2 = {0.f, 0.f, 0.f, 0.f};
      z2 = __builtin_amdgcn_mfma_f32_16x16x32_bf16(x.k10, qf0, z2, 0, 0, 0);
      s[1] = __builtin_amdgcn_mfma_f32_16x16x32_bf16(x.k11, qf1, z2, 0, 0, 0);
    }
    if (win) {
      const int dr = rs + kb - r + 7;
#pragma unroll
      for (int t = 0; t < 2; ++t)
#pragma unroll
        for (int i = 0; i < 4; ++i) {
          int keycol = cb + t * 16 + g * 4 + i;
          bool valid = keycol >= cs && keycol < cs + 16;
          int dc = keycol - c + 15;
          dc = dc < 0 ? 0 : (dc > 30 ? 30 : dc);
          float bias = rp[dr * 31 + dc];
          s[t][i] = valid ? s[t][i] + bias : -1e30f;
        }
    }
    float mx = fmaxf(fmaxf(fmaxf(s[0][0], s[0][1]), fmaxf(s[0][2], s[0][3])),
                     fmaxf(fmaxf(s[1][0], s[1][1]), fmaxf(s[1][2], s[1][3])));
    mx = fmaxf(mx, __shfl_xor(mx, 16));
    mx = fmaxf(mx, __shfl_xor(mx, 32));
    const float mnew = fmaxf(mrun, mx);
    const float alpha = __expf(mrun - mnew);
    mrun = mnew;
    float p[8], psum = 0.f;
#pragma unroll
    for (int t = 0; t < 2; ++t)
#pragma unroll
      for (int i = 0; i < 4; ++i) {
        p[t * 4 + i] = __expf(s[t][i] - mnew);
        psum += p[t * 4 + i];
      }
    lrun = lrun * alpha + psum;
    bf16x8 pf;
#pragma unroll
    for (int e = 0; e < 8; ++e) pf[e] = (short)f2bf(p[e]);
#pragma unroll
    for (int d = 0; d < 4; ++d) o[d] *= alpha;
    pvmma(o[0], x.v0a, x.v0b, pf);
    pvmma(o[1], x.v1a, x.v1b, pf);
    pvmma(o[2], x.v2a, x.v2b, pf);
    pvmma(o[3], x.v3a, x.v3b, pf);
  };
  KV ka, kb2;
  loadkv(ka, 0);
  for (int kb = 0; kb < nblk; kb += 2) {
    loadkv(kb2, kb + 1);
    step(ka, kb);
    loadkv(ka, kb + 2);
    step(kb2, kb + 1);
  }
  float l = lrun + __shfl_xor(lrun, 16);
  l += __shfl_xor(l, 32);
  const float inv = 1.f / l;
#pragma unroll
  for (int d = 0; d < 4; ++d)
    store_bf4(P.ycat() + (size_t)mq * DM + 640 + h * 64 + d * 16 + g * 4, o[d][0] * inv, o[d][1] * inv, o[d][2] * inv,
              o[d][3] * inv);
}

DEV void attn_wave2(const Params& P, int layer, int b, int h, int r, int cgp, int lane) {
  const int qi = lane & 15, g = lane >> 4;
  const int c = cgp * 16 + qi;
  int cs = c - 8;
  cs = cs < 0 ? 0 : (cs > 48 ? 48 : cs);
  const int cb = cgp == 0 ? 0 : (cgp == 1 ? 8 : (cgp == 2 ? 24 : 32));
  int rsA = r - 4, rsB = r - 3;
  rsA = rsA < 0 ? 0 : (rsA > 120 ? 120 : rsA);
  rsB = rsB < 0 ? 0 : (rsB > 120 ? 120 : rsB);
  const int nwin = rsB - rsA + 8, nb = nwin + 8;
  const int mqA = b * SEQ + r * 64 + c, mqB = mqA + 64;
  const u16* qpA = P.qbuf() + (size_t)mqA * 384 + h * 64 + g * 8;
  const u16* qpB = qpA + 64 * 384;
  const bf16x8 qA0 = *(const bf16x8*)qpA, qA1 = *(const bf16x8*)(qpA + 32);
  const bf16x8 qB0 = *(const bf16x8*)qpB, qB1 = *(const bf16x8*)(qpB + 32);
  f32x4 oA[4], oB[4];
#pragma unroll
  for (int d = 0; d < 4; ++d) oA[d] = oB[d] = f32x4{0.f, 0.f, 0.f, 0.f};
  float mA = -1e30f, lA = 0.f, mB = -1e30f, lB = 0.f;
  const float* rp = P.rpb + (size_t)(layer * 6 + h) * 465;
  struct KV {
    bf16x8 k00, k01, k10, k11;
    uint2 v0a, v0b, v1a, v1b, v2a, v2b, v3a, v3b;
  };
  auto loadkv = [&](KV& x, int idx) {
    idx = idx < nb ? idx : nb - 1;
    size_t krow0;
    const u16* vbase;
    int vld;
    if (idx < nwin) {
      int tok0 = (rsA + idx) * 64 + cb;
      krow0 = (size_t)b * SEQ + tok0;
      vbase = P.vT() + ((size_t)(b * 384 + h * 64)) * SEQ + tok0;
      vld = SEQ;
    } else {
      int kc = (idx - nwin) * 32;
      krow0 = (size_t)NLAT + b * LCX + kc;
      vbase = P.vTc() + ((size_t)(b * 384 + h * 64)) * LCX + kc;
      vld = LCX;
    }
    const u16* kp0 = P.kbuf() + (krow0 + qi) * 384 + h * 64 + g * 8;
    const u16* kp1 = kp0 + 16 * 384;
    x.k00 = *(const bf16x8*)kp0;
    x.k01 = *(const bf16x8*)(kp0 + 32);
    x.k10 = *(const bf16x8*)kp1;
    x.k11 = *(const bf16x8*)(kp1 + 32);
    const u16* vp = vbase + (size_t)qi * vld + g * 4;
    x.v0a = *(const uint2*)vp;
    x.v0b = *(const uint2*)(vp + 16);
    x.v1a = *(const uint2*)(vp + (size_t)16 * vld);
    x.v1b = *(const uint2*)(vp + (size_t)16 * vld + 16);
    x.v2a = *(const uint2*)(vp + (size_t)32 * vld);
    x.v2b = *(const uint2*)(vp + (size_t)32 * vld + 16);
    x.v3a = *(const uint2*)(vp + (size_t)48 * vld);
    x.v3b = *(const uint2*)(vp + (size_t)48 * vld + 16);
  };
  auto pvmma = [&](f32x4& od, uint2 va, uint2 vb, bf16x8 pf) {
    union { uint4 u; bf16x8 v; } cv;
    cv.u = make_uint4(va.x, va.y, vb.x, vb.y);
    od = __builtin_amdgcn_mfma_f32_16x16x32_bf16(cv.v, pf, od, 0, 0, 0);
  };
  auto update = [&](const KV& x, f32x4 (&o)[4], float& mrun, float& lrun, bf16x8 q0, bf16x8 q1, int dr) {
    f32x4 s[2];
    {
      f32x4 z = {0.f, 0.f, 0.f, 0.f};
      z = __builtin_amdgcn_mfma_f32_16x16x32_bf16(x.k00, q0, z, 0, 0, 0);
      s[0] = __builtin_amdgcn_mfma_f32_16x16x32_bf16(x.k01, q1, z, 0, 0, 0);
      f32x4 z2 = {0.f, 0.f, 0.f, 0.f};
      z2 = __builtin_amdgcn_mfma_f32_16x16x32_bf16(x.k10, q0, z2, 0, 0, 0);
      s[1] = __builtin_amdgcn_mfma_f32_16x16x32_bf16(x.k11, q1, z2, 0, 0, 0);
    }
    if (dr >= 0) {
#pragma unroll
      for (int t = 0; t < 2; ++t)
#pragma unroll
        for (int i = 0; i < 4; ++i) {
          int keycol = cb + t * 16 + g * 4 + i;
          bool valid = keycol >= cs && keycol < cs + 16;
          int dc = keycol - c + 15;
          dc = dc < 0 ? 0 : (dc > 30 ? 30 : dc);
          float bias = rp[dr * 31 + dc];
          s[t][i] = valid ? s[t][i] + bias : -1e30f;
        }
    }
    float mx = fmaxf(fmaxf(fmaxf(s[0][0], s[0][1]), fmaxf(s[0][2], s[0][3])),
                     fmaxf(fmaxf(s[1][0], s[1][1]), fmaxf(s[1][2], s[1][3])));
    mx = fmaxf(mx, __shfl_xor(mx, 16));
    mx = fmaxf(mx, __shfl_xor(mx, 32));
    const float mnew = fmaxf(mrun, mx);
    const float alpha = __expf(mrun - mnew);
    mrun = mnew;
    float p[8], psum = 0.f;
#pragma unroll
    for (int t = 0; t < 2; ++t)
#pragma unroll
      for (int i = 0; i < 4; ++i) {
        p[t * 4 + i] = __expf(s[t][i] - mnew);
        psum += p[t * 4 + i];
      }
    lrun = lrun * alpha + psum;
    bf16x8 pf;
#pragma unroll
    for (int e = 0; e < 8; ++e) pf[e] = (short)f2bf(p[e]);
#pragma unroll
    for (int d = 0; d < 4; ++d) o[d] *= alpha;
    pvmma(o[0], x.v0a, x.v0b, pf);
    pvmma(o[1], x.v1a, x.v1b, pf);
    pvmma(o[2], x.v2a, x.v2b, pf);
    pvmma(o[3], x.v3a, x.v3b, pf);
  };
  auto step = [&](const KV& x, int idx) {
    if (idx < nwin) {
      const int kr = rsA + idx;
      if (kr < rsA + 8) update(x, oA, mA, lA, qA0, qA1, kr - r + 7);
      if (kr >= rsB) update(x, oB, mB, lB, qB0, qB1, kr - (r + 1) + 7);
    } else {
      update(x, oA, mA, lA, qA0, qA1, -1);
      update(x, oB, mB, lB, qB0, qB1, -1);
    }
  };
  KV ka, kb2;
  loadkv(ka, 0);
  for (int idx = 0; idx < nb; idx += 2) {
    loadkv(kb2, idx + 1);
    step(ka, idx);
    loadkv(ka, idx + 2);
    if (idx + 1 < nb) step(kb2, idx + 1);
  }
  {
    float l = lA + __shfl_xor(lA, 16);
    l += __shfl_xor(l, 32);
    const float inv = 1.f / l;
#pragma unroll
    for (int d = 0; d < 4; ++d)
      store_bf4(P.ycat() + (size_t)mqA * DM + 640 + h * 64 + d * 16 + g * 4, oA[d][0] * inv, oA[d][1] * inv,
                oA[d][2] * inv, oA[d][3] * inv);
  }
  {
    float l = lB + __shfl_xor(lB, 16);
    l += __shfl_xor(l, 32);
    const float inv = 1.f / l;
#pragma unroll
    for (int d = 0; d < 4; ++d)
      store_bf4(P.ycat() + (size_t)mqB * DM + 640 + h * 64 + d * 16 + g * 4, oB[d][0] * inv, oB[d][1] * inv,
                oB[d][2] * inv, oB[d][3] * inv);
  }
}

DEV void carry_wave(const Params& P, int wjob, int lane) {
  const int pg = wjob & 7;
  int combo = wjob >> 3;
  const int g = combo % 24;
  combo /= 24;
  const int dir = combo & 1, b = combo >> 1;
  const int p = pg * 8 + (lane & 7), seg = lane >> 3;
  const float lr = P.lamT()[((dir * 24 + g) * 64 + p) * 2], li = P.lamT()[((dir * 24 + g) * 64 + p) * 2 + 1];
  auto chunk_of = [&](int n) {
    if (n < 8) return 512 + b * 8 + (dir ? 7 - n : n);
    int c = n - 8;
    return b * 256 + (dir ? 255 - c : c);
  };
  float cr = 0.f, ci = 0.f;
#pragma unroll 1
  for (int bt = 0; bt < 3; ++bt) {
    float2 e[11];
#pragma unroll
    for (int i = 0; i < 11; ++i) {
      size_t row = (size_t)(g * NCH + chunk_of(seg * 33 + bt * 11 + i));
      e[i] = *(const float2*)(P.E() + row * 256 + dir * 128 + p * 2);
    }
#pragma unroll
    for (int i = 0; i < 11; ++i) {
      float nr = lr * cr - li * ci + e[i].x, ni = lr * ci + li * cr + e[i].y;
      cr = nr;
      ci = ni;
    }
  }
  float sr = lr, si = li;
#pragma unroll
  for (int k = 0; k < 5; ++k) {
    float t = sr * sr - si * si;
    si = 2.f * sr * si;
    sr = t;
  }
  const float l33r = sr * lr - si * li, l33i = sr * li + si * lr;
  float stR = 0.f, stI = 0.f;
#pragma unroll
  for (int k = 1; k < 8; ++k) {
    int src = (lane - 8) & 63;
    float pr_ = __shfl(stR, src), pi_ = __shfl(stI, src), er = __shfl(cr, src), ei = __shfl(ci, src);
    if (seg == k) {
      stR = l33r * pr_ - l33i * pi_ + er;
      stI = l33r * pi_ + l33i * pr_ + ei;
    }
  }
  cr = stR;
  ci = stI;
#pragma unroll 1
  for (int bt = 0; bt < 3; ++bt) {
    float2 e[11];
#pragma unroll
    for (int i = 0; i < 11; ++i) {
      size_t row = (size_t)(g * NCH + chunk_of(seg * 33 + bt * 11 + i));
      e[i] = *(const float2*)(P.E() + row * 256 + dir * 128 + p * 2);
    }
#pragma unroll
    for (int i = 0; i < 11; ++i) {
      size_t row = (size_t)(g * NCH + chunk_of(seg * 33 + bt * 11 + i));
      *(unsigned*)(P.UB() + row * 768 + 512 + dir * 128 + p * 2) = pack2(cr, ci);
      float nr = lr * cr - li * ci + e[i].x, ni = lr * ci + li * cr + e[i].y;
      cr = nr;
      ci = ni;
    }
  }
}

DEV void run_phase(const Params& P, int ph, int bid, int nblk, char* smem, const XcdMap& xm) {
  const int lane = g_tid() & 63, w = g_tid() >> 6;
  if (ph == 0) {
    for (int job = bid; job < CONST_N + PREP_N; job += nblk) {
      if (job < CONST_N) const_job(P, job, smem);
      else prep_job(P, 0, job - CONST_N, smem);
    }
    return;
  }
  if (ph == 1) {
    for (int job = bid; job < MR / 16 + EXPAND_N; job += nblk) {
      if (job < MR / 16) rowop(P, 0, 0, (job * 4 + w) * NR, lane);
      else expand_job(P, job - MR / 16);
    }
    return;
  }
  const int layer = (ph - 2) / 10, sub = (ph - 2) % 10;
  switch (sub) {
    case 0: {
      EpiInproj epi{P};
      big_gemm_phase<2>(P.wt_in(), DM, P.abuf(), DM, DM, 7, 7, bid, nblk, smem, epi, xm);
      if (layer == 1)
        for (int job = bid; job < EXPAND_N; job += nblk) expand_job(P, job);
    } break;
    case 1: {
      const int J0 = 768, J1 = J0 + 48, J2 = J1 + 240, J3 = J2 + 512, J4 = J3 + 16;
      for (int job = bid; job < J4; job += nblk) {
        if (job < J0) {
          int rp2 = job & 63, bh = job >> 6;
          attn_wave2(P, layer, bh / 6, bh % 6, rp2 * 2, w, lane);
        } else if (job < J1) {
          int j = job - J0;
          int qb = j & 3, bh = j >> 2;
          attn_wave(P, layer, true, bh / 6, bh % 6, 0, qb * 4 + w, lane);
        } else if (job < J2) {
          int j = job - J1;
          int g = j / 10, t = j % 10;
          EpiSsmEnd epi{P.E() + (size_t)g * NCH * 256};
          gemm_tile<0>(P.A_end() + (size_t)g * 256 * 512, 512, P.UB() + (size_t)g * NCH * 768, 768, 512, (t & 1) * 128,
                           (t >> 1) * 128, NCH, smem, epi);
        } else if (job < J3) {
          int j = job - J2;
          int b = j >> 8, t = j & 255;
          EpiFnetA epi{P.A1() + (size_t)b * 128 * 128 * 256};
          gemm_tile<1>(P.D128(), 128, P.fbuf() + (size_t)b * SEQ * 256, 64 * 256, 128, (t & 1) * 128, (t >> 1) * 128,
                          64 * 256, smem, epi);
        } else {
          int j = job - J3;
          int b = j >> 3, t = j & 7;
          EpiFnetCtx epi{P.Gbuf() + (size_t)(NLAT + b * LCX) * 512};
          gemm_tile<1>(P.D256(), 256, P.fbuf() + (size_t)(NLAT + b * LCX) * 256, 256, 256, (t & 3) * 128, (t >> 2) * 128,
                          256, smem, epi);
        }
      }
    } break;
    case 2: {
      for (int job = bid; job < 192; job += nblk) carry_wave(P, job * 4 + w, lane);
    } break;
    case 3: {
      for (int job = bid; job < 480 + 512; job += nblk) {
        if (job < 480) {
          int g = job / 20, t = job % 20;
          EpiSsmOut epi{P.zbuf(), g};
          gemm_tile<0>(P.A_out() + (size_t)g * 512 * 768, 768, P.UB() + (size_t)g * NCH * 768, 768, 768, (t & 3) * 128,
                       (t >> 2) * 128, NCH, smem, epi);
        } else {
          int j = job - 480;
          int bk = j >> 1, t = j & 1;
          int k1 = bk & 127, b = bk >> 7;
          EpiFnetC epi{P.Gbuf() + (size_t)(b * SEQ + k1) * 512};
          gemm_tile<1>(P.Tmat() + (size_t)k1 * 128 * 128, 128, P.A1() + (size_t)bk * 128 * 256, 256, 128, 0, t * 128, 256,
                       smem, epi);
        }
      }
    } break;
    case 4: {
      for (int job = bid; job < 396 + 264; job += nblk) {
        if (job < 396) {
          EpiGlu epi{P.zbuf(), P.ycat()};
          gemm_tile<2>(P.wt_glu(), 384, P.zbuf(), 384, 384, (job % 3) * 128, (job / 3) * 128, MR, smem, epi);
        } else {
          int j = job - 396;
          EpiStoreBf epi{P.ycat(), DM, 384};
          gemm_tile<0>(P.MWt(), 512, P.Gbuf(), 512, 512, (j & 1) * 128, (j >> 1) * 128, MR, smem, epi);
        }
      }
    } break;
    case 5: {
      EpiStoreBf epi{P.obuf(), DM, 0};
      big_gemm_phase<3>(P.wt_out(), DM, P.ycat(), DM, DM, 4, 4, bid, nblk, smem, epi, xm);
    } break;
    case 6: {
      for (int job = bid; job < MR / 16; job += nblk) rowop(P, 1, layer, (job * 4 + w) * NR, lane);
    } break;
    case 7: {
      EpiGateUp epi{P.hidden()};
      big_gemm_phase<3>(P.wt_gu(), DM, P.abuf(), DM, DM, 22, 2, bid, nblk, smem, epi, xm);
    } break;
    case 8: {
      EpiStoreBf epi{P.obuf(), DM, 0};
      big_gemm_phase<3>(P.wt_dn(), DFF, P.hidden(), DFF, DFF, 4, 4, bid, nblk, smem, epi, xm);
    } break;
    case 9: {
      const int nrow = MR / 16;
      const int total = nrow + (layer == 0 ? PREP_N : 0);
      for (int job = bid; job < total; job += nblk) {
        if (job < nrow) rowop(P, 2, layer, (job * 4 + w) * NR, lane);
        else prep_job(P, 1, job - nrow, smem);
      }
    } break;
  }
}

#if MK_MULTI
__global__ void __launch_bounds__(256, 2) phase_kernel(Params P, int ph) {
  __shared__ __attribute__((aligned(16))) char smem[65536];
  XcdMap xm{0, 0, 0, 0};
  run_phase(P, ph, blockIdx.x, gridDim.x, smem, xm);
}
#else
#define XB_XCNT(j) (64 * (j))
#define XB_XSUB(j) (1024 + 64 * (j))
#define XB_XGEN(j) (2048 + 64 * (j))
#define XB_TOP 3072
#define XB_TOPGEN 3136
#define XB_WORDS 3200
DEV unsigned xb_ld(unsigned* p) { return __hip_atomic_load(p, __ATOMIC_RELAXED, __HIP_MEMORY_SCOPE_AGENT); }
DEV unsigned xb_add(unsigned* p, unsigned v) { return __hip_atomic_fetch_add(p, v, __ATOMIC_RELAXED, __HIP_MEMORY_SCOPE_AGENT); }

DEV void grid_barrier(unsigned* bar, unsigned k, unsigned xcc, unsigned nloc, unsigned nx) {
  asm volatile("s_waitcnt vmcnt(0)" ::: "memory");
  __syncthreads();
  if (threadIdx.x == 0) {
    const unsigned old = xb_add(&bar[XB_XSUB(xcc)], 1u);
    if (old + 1u == k * nloc) {
      __builtin_amdgcn_fence(__ATOMIC_RELEASE, "agent");
      asm volatile("s_waitcnt vmcnt(0)" ::: "memory");
      const unsigned og = xb_add(&bar[XB_TOP], 1u);
      if (og + 1u == k * nx) xb_add(&bar[XB_TOPGEN], 1u);
      else
        while (xb_ld(&bar[XB_TOPGEN]) < k) __builtin_amdgcn_s_sleep(4);
      __builtin_amdgcn_fence(__ATOMIC_ACQUIRE, "agent");
      xb_add(&bar[XB_XGEN(xcc)], 1u);
      asm volatile("s_waitcnt vmcnt(0)" ::: "memory");
    } else {
      while (xb_ld(&bar[XB_XGEN(xcc)]) < k) __builtin_amdgcn_s_sleep(8);
      __builtin_amdgcn_fence(__ATOMIC_ACQUIRE, "agent");
      asm volatile("s_waitcnt vmcnt(0)" ::: "memory");
    }
  }
  __syncthreads();
}

__global__ void __launch_bounds__(256) fwd_megakernel(Params P, unsigned* bar) {
  __shared__ __attribute__((aligned(16))) char smem[65536];
  cg::grid_group grid = cg::this_grid();
  const unsigned xcc = (unsigned)__builtin_amdgcn_s_getreg((3 << 11) | 20) & 0xFu;
  unsigned* s_rank = (unsigned*)smem;
  if (threadIdx.x == 0) *s_rank = xb_add(&bar[XB_XCNT(xcc)], 1u);
  __threadfence();
  grid.sync();
  const unsigned rank = __builtin_amdgcn_readfirstlane(*s_rank);
  __syncthreads();
  unsigned nloc = 0, nx = 0, ord = 0;
#pragma unroll
  for (unsigned j = 0; j < 16; ++j) {
    const unsigned c = xb_ld(&bar[XB_XCNT(j)]);
    nx += c > 0u ? 1u : 0u;
    ord += (c > 0u && j < xcc) ? 1u : 0u;
    nloc = j == xcc ? c : nloc;
  }
  nloc = __builtin_amdgcn_readfirstlane(nloc);
  nx = __builtin_amdgcn_readfirstlane(nx);
  ord = __builtin_amdgcn_readfirstlane(ord);
  const XcdMap xm{(int)ord, (int)nx, (int)rank, (int)nloc};
  unsigned round = 0;
  for (int ph = 0; ph < NPH; ++ph) {
    int bid = blockIdx.x;
    asm volatile("" : "+s"(bid));
    run_phase(P, ph, bid, gridDim.x, smem, xm);
#ifdef PROBE_DUP
    {
      const int sub = ph < 2 ? 10 + ph : (ph - 2) % 10;
      if ((PROBE_DUP >> sub) & 1) {
        grid_barrier(bar, ++round, xcc, nloc, nx);
        asm volatile("" : "+s"(bid));
        run_phase(P, ph, bid, gridDim.x, smem, xm);
      }
    }
#endif
    if (ph + 1 < NPH) grid_barrier(bar, ++round, xcc, nloc, nx);
  }
}
#endif

extern "C" void kernel_launch(void* const* d_in, const int* in_sizes, int n_in, void* d_out, int out_size, void* d_ws,
                              size_t ws_size, hipStream_t stream) {
  Params p{};
  const float* const* in = (const float* const*)d_in;
  p.x = in[0]; p.c = in[1]; p.ctx = in[2]; p.c_ctx = in[3]; p.w_mod = in[4]; p.b_mod = in[5];
  p.g_pre_mix = in[6]; p.g_post_mix = in[7]; p.w_in = in[8]; p.a_re = in[9]; p.a_im = in[10]; p.log_dt = in[11];
  p.b_re = in[12]; p.b_im = in[13]; p.c_re = in[14]; p.c_im = in[15]; p.ssm_d = in[16]; p.w_glu = in[17];
  p.w_fourier = in[18]; p.rpb = in[19]; p.w_out = in[20]; p.g_pre_ffn = in[21]; p.g_post_ffn = in[22];
  p.w_gate = in[23]; p.w_up = in[24]; p.w_down = in[25];
  p.out = (float*)d_out;
  p.ws = (char*)d_ws;
  if (WS_NEED > ws_size) {
    fprintf(stderr, "workspace too small: need %zu have %zu\n", (size_t)WS_NEED, ws_size);
    return;
  }
  unsigned* bar = (unsigned*)(p.ws + O_bar);
#if MK_MULTI
  for (int ph = 0; ph < NPH; ++ph) phase_kernel<<<dim3(1024), dim3(256), 0, stream>>>(p, ph);
#else
  static int grid_blocks = 0;
  if (!grid_blocks) {
    int dev = 0, cus = 0, per_cu = 0;
    hipGetDevice(&dev);
    hipDeviceGetAttribute(&cus, hipDeviceAttributeMultiprocessorCount, dev);
    hipOccupancyMaxActiveBlocksPerMultiprocessor(&per_cu, fwd_megakernel, 256, 0);
    if (per_cu > 2) per_cu = 2;
    grid_blocks = cus * per_cu;
  }
  hipMemsetAsync(bar, 0, XB_WORDS * 4, stream);
  void* args[] = {&p, &bar};
  hipError_t e = hipLaunchCooperativeKernel((void*)fwd_megakernel, dim3(grid_blocks), dim3(256), args, 0, stream);
  if (e != hipSuccess) fprintf(stderr, "cooperative launch failed: %s (grid %d)\n", hipGetErrorString(e), grid_blocks);
#endif
}
```

```cpp
#include <hip/hip_runtime.h>
#include <hip/hip_bf16.h>
#include <hip/hip_cooperative_groups.h>
#include <cstdio>
#include <cstdint>
namespace cg = cooperative_groups;

#ifndef MK_MULTI
#define MK_MULTI 0
#endif

typedef __attribute__((ext_vector_type(8))) short bf16x8;
typedef __attribute__((ext_vector_type(4))) float f32x4;
typedef __attribute__((ext_vector_type(16))) float f32x16;
typedef unsigned short u16;
typedef __attribute__((ext_vector_type(4))) unsigned u32x4;

#define DEV __device__ __forceinline__


constexpr int DM = 1024, SEQ = 8192, LCX = 256;
constexpr int NLAT = 2 * SEQ, NCTX = 2 * LCX, MR = NLAT + NCTX;
constexpr int INW = 1792, DFF = 2816;
constexpr int TCH = 32, NCH = MR / TCH;
constexpr int NPH = 22;
constexpr float EPS = 1e-6f;

constexpr size_t al256(size_t x) { return (x + 255) & ~(size_t)255; }
constexpr size_t O_wt_in = 0;
constexpr size_t O_wt_out = O_wt_in + al256((size_t)INW * DM * 2);
constexpr size_t O_wt_glu = O_wt_out + al256((size_t)DM * DM * 2);
constexpr size_t O_wt_gu = O_wt_glu + al256((size_t)384 * 384 * 2);
constexpr size_t O_wt_dn = O_wt_gu + al256((size_t)2 * DFF * DM * 2);
constexpr size_t O_A_out = O_wt_dn + al256((size_t)DM * DFF * 2);
constexpr size_t O_A_end = O_A_out + al256((size_t)24 * 512 * 768 * 2);
constexpr size_t O_D128 = O_A_end + al256((size_t)24 * 256 * 512 * 2);
constexpr size_t O_D256 = O_D128 + al256(256 * 128 * 2);
constexpr size_t O_Tmat = O_D256 + al256(512 * 256 * 2);
constexpr size_t O_MWt = O_Tmat + al256((size_t)128 * 128 * 128 * 2);
constexpr size_t O_lamT = O_MWt + al256(256 * 512 * 2);
constexpr size_t O_Ktau = O_lamT + al256(2 * 24 * 64 * 2 * 4);
constexpr size_t O_mod = O_Ktau + al256((size_t)24 * 63 * 256 * 4);
constexpr size_t O_abuf = O_mod + al256(2 * 3 * 6144 * 4);
constexpr size_t O_xctx = O_abuf + al256((size_t)MR * DM * 2);
constexpr size_t O_bar = O_xctx + al256((size_t)NCTX * DM * 4);
constexpr size_t O_R = O_bar + al256(16384);
constexpr size_t O_ycat = O_R;
constexpr size_t O_UB = O_ycat + al256((size_t)MR * DM * 2);
constexpr size_t O_fbuf = O_UB + al256((size_t)24 * NCH * 768 * 2);
constexpr size_t O_qbuf = O_fbuf + al256((size_t)MR * 256 * 2);
constexpr size_t O_kbuf = O_qbuf + al256((size_t)MR * 384 * 2);
constexpr size_t O_vT = O_kbuf + al256((size_t)MR * 384 * 2);
constexpr size_t O_vTc = O_vT + al256((size_t)2 * 384 * SEQ * 2);
constexpr size_t O_E = O_vTc + al256((size_t)2 * 384 * LCX * 2);
constexpr size_t O_A1 = O_E + al256((size_t)24 * NCH * 256 * 4);
constexpr size_t O_Gbuf = O_A1 + al256((size_t)2 * 128 * 128 * 256 * 2);
constexpr size_t O_Rend = O_Gbuf + al256((size_t)MR * 512 * 2);
constexpr size_t O_zbuf = O_qbuf;
constexpr size_t O_hidden = O_R;
constexpr size_t O_obuf = O_R + al256((size_t)MR * DFF * 2);
constexpr size_t O_obuf_end = O_obuf + al256((size_t)MR * DM * 2);
constexpr size_t WS_NEED = O_Rend > O_obuf_end ? O_Rend : O_obuf_end;

struct Params {
  const float *x, *c, *ctx, *c_ctx, *w_mod, *b_mod, *g_pre_mix, *g_post_mix, *w_in;
  const float *a_re, *a_im, *log_dt, *b_re, *b_im, *c_re, *c_im, *ssm_d, *w_glu, *w_fourier, *rpb, *w_out;
  const float *g_pre_ffn, *g_post_ffn, *w_gate, *w_up, *w_down;
  float* out;
  char* ws;
  DEV u16* wt_in() const { return (u16*)(ws + O_wt_in); }
  DEV u16* wt_out() const { return (u16*)(ws + O_wt_out); }
  DEV u16* wt_glu() const { return (u16*)(ws + O_wt_glu); }
  DEV u16* wt_gu() const { return (u16*)(ws + O_wt_gu); }
  DEV u16* wt_dn() const { return (u16*)(ws + O_wt_dn); }
  DEV u16* A_out() const { return (u16*)(ws + O_A_out); }
  DEV u16* A_end() const { return (u16*)(ws + O_A_end); }
  DEV u16* D128() const { return (u16*)(ws + O_D128); }
  DEV u16* D256() const { return (u16*)(ws + O_D256); }
  DEV u16* Tmat() const { return (u16*)(ws + O_Tmat); }
  DEV u16* MWt() const { return (u16*)(ws + O_MWt); }
  DEV u16* abuf() const { return (u16*)(ws + O_abuf); }
  DEV u16* UB() const { return (u16*)(ws + O_UB); }
  DEV u16* fbuf() const { return (u16*)(ws + O_fbuf); }
  DEV u16* qbuf() const { return (u16*)(ws + O_qbuf); }
  DEV u16* kbuf() const { return (u16*)(ws + O_kbuf); }
  DEV u16* vT() const { return (u16*)(ws + O_vT); }
  DEV u16* vTc() const { return (u16*)(ws + O_vTc); }
  DEV u16* zbuf() const { return (u16*)(ws + O_zbuf); }
  DEV u16* A1() const { return (u16*)(ws + O_A1); }
  DEV u16* Gbuf() const { return (u16*)(ws + O_Gbuf); }
  DEV u16* ycat() const { return (u16*)(ws + O_ycat); }
  DEV u16* obuf() const { return (u16*)(ws + O_obuf); }
  DEV u16* hidden() const { return (u16*)(ws + O_hidden); }
  DEV float* lamT() const { return (float*)(ws + O_lamT); }
  DEV float* mod() const { return (float*)(ws + O_mod); }
  DEV float* xctx() const { return (float*)(ws + O_xctx); }
  DEV float* E() const { return (float*)(ws + O_E); }
  DEV float* Ktau() const { return (float*)(ws + O_Ktau); }
};

struct XcdMap { int ord, nx, rank, nloc; };
DEV int g_tid() { int t = threadIdx.x; asm volatile("" : "+v"(t)); return t; }
DEV u16 f2bf(float f) { unsigned u = __float_as_uint(f); u += 0x7fffu + ((u >> 16) & 1u); return (u16)(u >> 16); }
DEV float bf2f(u16 h) { return __uint_as_float(((unsigned)h) << 16); }
DEV unsigned pack2(float a, float b) { return (unsigned)f2bf(a) | ((unsigned)f2bf(b) << 16); }
DEV void store_bf4(u16* p, float a, float b, float c, float d) { uint2 v; v.x = pack2(a, b); v.y = pack2(c, d); *(uint2*)p = v; }
DEV float wave_sum(float v) {
#pragma unroll
  for (int o = 32; o >= 1; o >>= 1) v += __shfl_xor(v, o);
  return v;
}
DEV float hw_sin_rev(float r) { return __builtin_amdgcn_sinf(r); }
DEV float hw_cos_rev(float r) { return __builtin_amdgcn_cosf(r); }

template <int BMODE, class Epi>
DEV void gemm_tile(const u16* A, int lda, const u16* B, int ldb, int K, int n0, int m0, int mmax, char* smem,
                   const Epi& epi) {
  const int tid = g_tid(), lane = tid & 63, w = tid >> 6;
  const int wn = w & 1, wm = w >> 1;
  f32x16 acc[2][2];
#pragma unroll
  for (int i = 0; i < 2; ++i)
#pragma unroll
    for (int j = 0; j < 2; ++j)
#pragma unroll
      for (int r = 0; r < 16; ++r) acc[i][j][r] = 0.f;
#define GT_GL1(S, I, K0)                                                                                  \
  {                                                                                                        \
    const int id = tid + 256 * (I);                                                                        \
    const int r = id >> 3, ch = id & 7;                                                                    \
    S##a##I = *(const u32x4*)(A + (size_t)(n0 + r) * lda + (K0) + ch * 8);                                 \
    if (BMODE == 0) {                                                                                      \
      int m = m0 + r;                                                                                      \
      m = m < mmax ? m : mmax - 1;                                                                         \
      S##b##I = *(const u32x4*)(B + (size_t)m * ldb + (K0) + ch * 8);                                      \
    } else if (BMODE == 2) {                                                                               \
      const int k = (K0) + ch * 8;                                                                         \
      S##b##I = *(const u32x4*)(B + ((size_t)(k >> 4) * MR + (m0 + r)) * 16 + (k & 15));                   \
    } else {                                                                                               \
      const int kk = id >> 4, nch = id & 15;                                                               \
      S##b##I = *(const u32x4*)(B + (size_t)((K0) + kk) * ldb + m0 + nch * 8);                             \
    }                                                                                                      \
  }
#define GT_GLOAD(S, K0) GT_GL1(S, 0, K0) GT_GL1(S, 1, K0) GT_GL1(S, 2, K0) GT_GL1(S, 3, K0)
#define GT_SS1(S, I, BUF)                                                                                 \
  {                                                                                                        \
    char* sa = smem + (BUF) * 32768;                                                                       \
    char* sb = sa + 16384;                                                                                 \
    const int id = tid + 256 * (I);                                                                        \
    const int r = id >> 3, ch = id & 7;                                                                    \
    *(u32x4*)(sa + r * 128 + ((ch ^ (r & 7)) << 4)) = S##a##I;                                             \
    if (BMODE != 1) {                                                                                      \
      *(u32x4*)(sb + r * 128 + ((ch ^ (r & 7)) << 4)) = S##b##I;                                           \
    } else {                                                                                               \
      const int kk = id >> 4, nch = id & 15;                                                               \
      _Pragma("unroll") for (int e = 0; e < 8; ++e) {                                                      \
        unsigned wd = S##b##I[e >> 1];                                                                     \
        u16 v = (u16)((e & 1) ? (wd >> 16) : (wd & 0xffffu));                                              \
        int n = nch * 8 + e;                                                                               \
        *(u16*)(sb + n * 128 + ((((kk >> 3) ^ (n & 7)) << 4) + (kk & 7) * 2)) = v;                         \
      }                                                                                                    \
    }                                                                                                      \
  }
#define GT_SSTORE(S, BUF) GT_SS1(S, 0, BUF) GT_SS1(S, 1, BUF) GT_SS1(S, 2, BUF) GT_SS1(S, 3, BUF)
  u32x4 pa0, pa1, pa2, pa3, pb0, pb1, pb2, pb3, qa0, qa1, qa2, qa3, qb0, qb1, qb2, qb3;
  const unsigned lds0 = (unsigned)(uintptr_t)((__attribute__((address_space(3))) char*)smem);
  const int frow = lane & 31, fhi = lane >> 5, fsw = lane & 7;
  const unsigned rA = lds0 + (wn * 64 + frow) * 128, rB = lds0 + 16384 + (wm * 64 + frow) * 128;
  const unsigned aA0 = rA + (((0 + fhi) ^ fsw) << 4), aA1 = rA + (((2 + fhi) ^ fsw) << 4);
  const unsigned aA2 = rA + (((4 + fhi) ^ fsw) << 4), aA3 = rA + (((6 + fhi) ^ fsw) << 4);
  const unsigned aB0 = rB + (((0 + fhi) ^ fsw) << 4), aB1 = rB + (((2 + fhi) ^ fsw) << 4);
  const unsigned aB2 = rB + (((4 + fhi) ^ fsw) << 4), aB3 = rB + (((6 + fhi) ^ fsw) << 4);
  bf16x8 x0a0, x0a1, x0b0, x0b1, x1a0, x1a1, x1b0, x1b1, x2a0, x2a1, x2b0, x2b1, x3a0, x3a1, x3b0, x3b1;
#define GT_DSR(dst, addr, OFF) asm volatile("ds_read_b128 %0, %1 offset:%2" : "=v"(dst) : "v"(addr), "n"(OFF))
#define GT_LOADKS(KS, BUF)                        \
  GT_DSR(x##KS##a0, aA##KS, (BUF) * 32768);        \
  GT_DSR(x##KS##a1, aA##KS, (BUF) * 32768 + 4096); \
  GT_DSR(x##KS##b0, aB##KS, (BUF) * 32768);        \
  GT_DSR(x##KS##b1, aB##KS, (BUF) * 32768 + 4096);
#define GT_MMAKS(KS, N)                                                                                         \
  asm volatile("s_waitcnt lgkmcnt(%4)" : "+v"(x##KS##a0), "+v"(x##KS##a1), "+v"(x##KS##b0), "+v"(x##KS##b1) : "n"(N)); \
  acc[0][0] = __builtin_amdgcn_mfma_f32_32x32x16_bf16(x##KS##a0, x##KS##b0, acc[0][0], 0, 0, 0);                 \
  acc[0][1] = __builtin_amdgcn_mfma_f32_32x32x16_bf16(x##KS##a0, x##KS##b1, acc[0][1], 0, 0, 0);                 \
  acc[1][0] = __builtin_amdgcn_mfma_f32_32x32x16_bf16(x##KS##a1, x##KS##b0, acc[1][0], 0, 0, 0);                 \
  acc[1][1] = __builtin_amdgcn_mfma_f32_32x32x16_bf16(x##KS##a1, x##KS##b1, acc[1][1], 0, 0, 0);
#define GT_COMPUTE(BUF)                                                               \
  GT_LOADKS(0, BUF) GT_LOADKS(1, BUF) GT_LOADKS(2, BUF) GT_LOADKS(3, BUF)              \
  GT_MMAKS(0, 12) GT_MMAKS(1, 8) GT_MMAKS(2, 4) GT_MMAKS(3, 0)
  const int nk = K >> 6;
  const int klast = K - 64;
  GT_GLOAD(p, 0)
  GT_GLOAD(q, 64)
  GT_SSTORE(p, 0)
  __syncthreads();
  for (int kt = 0; kt < nk; kt += 2) {
    {
      int k0 = (kt + 2) << 6;
      k0 = k0 > klast ? klast : k0;
      GT_GLOAD(p, k0)
    }
    GT_COMPUTE(0)
    GT_SSTORE(q, 1)
    __syncthreads();
    {
      int k0 = (kt + 3) << 6;
      k0 = k0 > klast ? klast : k0;
      GT_GLOAD(q, k0)
    }
    GT_COMPUTE(1)
    GT_SSTORE(p, 0)
    __syncthreads();
  }
  epi(acc, n0 + wn * 64, m0 + wm * 64, lane);
}

#define BIG_GLOAD(S, K0)                                                       \
  S##a0 = *(const u32x4*)(ga + (K0));                                          \
  S##a1 = *(const u32x4*)(ga + (size_t)64 * lda + (K0));                       \
  S##a2 = *(const u32x4*)(ga + (size_t)128 * lda + (K0));                      \
  S##a3 = *(const u32x4*)(ga + (size_t)192 * lda + (K0));                      \
  S##b0 = *(const u32x4*)(gb + (K0));                                          \
  S##b1 = *(const u32x4*)(gb + (size_t)64 * ldb + (K0));                       \
  if (NJ >= 3) S##b2 = *(const u32x4*)(gb + (size_t)128 * ldb + (K0));         \
  if (NJ == 4) S##b3 = *(const u32x4*)(gb + (size_t)192 * ldb + (K0));
#define BIG_SSTORE(S, BUF)                                                     \
  *(u32x4*)(smem + (BUF) * 32768 + soff) = S##a0;                              \
  *(u32x4*)(smem + (BUF) * 32768 + soff + 4096) = S##a1;                       \
  *(u32x4*)(smem + (BUF) * 32768 + soff + 8192) = S##a2;                       \
  *(u32x4*)(smem + (BUF) * 32768 + soff + 12288) = S##a3;                      \
  *(u32x4*)(smem + (BUF) * 32768 + 16384 + soff) = S##b0;                      \
  *(u32x4*)(smem + (BUF) * 32768 + 16384 + soff + 4096) = S##b1;               \
  if (NJ >= 3) *(u32x4*)(smem + (BUF) * 32768 + 16384 + soff + 8192) = S##b2;  \
  if (NJ == 4) *(u32x4*)(smem + (BUF) * 32768 + 16384 + soff + 12288) = S##b3;
template <int NJ, class Epi>
DEV void gemm_big(const u16* A, int lda, const u16* B, int ldb, int K, int n0, int m0, char* smem, const Epi& epi) {
  const int tid = g_tid(), lane = tid & 63, w = tid >> 6;
  const int wn = w & 1, wm = w >> 1;
  f32x16 acc[4][NJ];
#pragma unroll
  for (int i = 0; i < 4; ++i)
#pragma unroll
    for (int j = 0; j < NJ; ++j)
#pragma unroll
      for (int r = 0; r < 16; ++r) acc[i][j][r] = 0.f;
  u32x4 pa0, pa1, pa2, pa3, pb0, pb1, pb2, pb3, qa0, qa1, qa2, qa3, qb0, qb1, qb2, qb3;
  pb2 = pb3 = qb2 = qb3 = u32x4{0u, 0u, 0u, 0u};
  const int lrow = tid >> 2, lch = tid & 3;
  const u16* ga = A + (size_t)(n0 + lrow) * lda + lch * 8;
  const u16* gb = B + (size_t)(m0 + lrow) * ldb + lch * 8;
  const int soff = lrow * 64 + ((lch ^ ((lrow >> 2) & 3)) << 4);
  const int frow = lane & 31, fhi = lane >> 5;
  const int sw = (frow >> 2) & 3;
  const unsigned lds0 = (unsigned)(uintptr_t)((__attribute__((address_space(3))) char*)smem);
  const unsigned aA0 = lds0 + (wn * 128 + frow) * 64 + (((0 + fhi) ^ sw) << 4);
  const unsigned aA1 = lds0 + (wn * 128 + frow) * 64 + (((2 + fhi) ^ sw) << 4);
  const unsigned aB0 = lds0 + 16384 + (wm * 32 * NJ + frow) * 64 + (((0 + fhi) ^ sw) << 4);
  const unsigned aB1 = lds0 + 16384 + (wm * 32 * NJ + frow) * 64 + (((2 + fhi) ^ sw) << 4);
#define DSR(dst, addr, OFF) asm volatile("ds_read_b128 %0, %1 offset:%2" : "=v"(dst) : "v"(addr), "n"(OFF))
#define BIG_LOADF(F, AA, AB, BUF)                                   \
  DSR(F##a0, AA, (BUF) * 32768);                                     \
  DSR(F##a1, AA, (BUF) * 32768 + 2048);                              \
  DSR(F##a2, AA, (BUF) * 32768 + 4096);                              \
  DSR(F##a3, AA, (BUF) * 32768 + 6144);                              \
  DSR(F##b0, AB, (BUF) * 32768);                                     \
  DSR(F##b1, AB, (BUF) * 32768 + 2048);                              \
  if (NJ >= 3) DSR(F##b2, AB, (BUF) * 32768 + 4096);                 \
  if (NJ == 4) DSR(F##b3, AB, (BUF) * 32768 + 6144);
#define BIG_WAITF(N, F)                                                                                       \
  asm volatile("s_waitcnt lgkmcnt(%8)"                                                                       \
               : "+v"(F##a0), "+v"(F##a1), "+v"(F##a2), "+v"(F##a3), "+v"(F##b0), "+v"(F##b1), "+v"(F##b2), "+v"(F##b3) \
               : "n"(N));
#define BIG_MFMA(F)                                                                                           \
  acc[0][0] = __builtin_amdgcn_mfma_f32_32x32x16_bf16(F##a0, F##b0, acc[0][0], 0, 0, 0);                        \
  acc[0][1] = __builtin_amdgcn_mfma_f32_32x32x16_bf16(F##a0, F##b1, acc[0][1], 0, 0, 0);                        \
  if (NJ >= 3) acc[0][NJ >= 3 ? 2 : 0] = __builtin_amdgcn_mfma_f32_32x32x16_bf16(F##a0, F##b2, acc[0][NJ >= 3 ? 2 : 0], 0, 0, 0); \
  if (NJ == 4) acc[0][NJ - 1] = __builtin_amdgcn_mfma_f32_32x32x16_bf16(F##a0, F##b3, acc[0][NJ - 1], 0, 0, 0);  \
  acc[1][0] = __builtin_amdgcn_mfma_f32_32x32x16_bf16(F##a1, F##b0, acc[1][0], 0, 0, 0);                        \
  acc[1][1] = __builtin_amdgcn_mfma_f32_32x32x16_bf16(F##a1, F##b1, acc[1][1], 0, 0, 0);                        \
  if (NJ >= 3) acc[1][NJ >= 3 ? 2 : 0] = __builtin_amdgcn_mfma_f32_32x32x16_bf16(F##a1, F##b2, acc[1][NJ >= 3 ? 2 : 0], 0, 0, 0); \
  if (NJ == 4) acc[1][NJ - 1] = __builtin_amdgcn_mfma_f32_32x32x16_bf16(F##a1, F##b3, acc[1][NJ - 1], 0, 0, 0);  \
  acc[2][0] = __builtin_amdgcn_mfma_f32_32x32x16_bf16(F##a2, F##b0, acc[2][0], 0, 0, 0);                        \
  acc[2][1] = __builtin_amdgcn_mfma_f32_32x32x16_bf16(F##a2, F##b1, acc[2][1], 0, 0, 0);                        \
  if (NJ >= 3) acc[2][NJ >= 3 ? 2 : 0] = __builtin_amdgcn_mfma_f32_32x32x16_bf16(F##a2, F##b2, acc[2][NJ >= 3 ? 2 : 0], 0, 0, 0); \
  if (NJ == 4) acc[2][NJ - 1] = __builtin_amdgcn_mfma_f32_32x32x16_bf16(F##a2, F##b3, acc[2][NJ - 1], 0, 0, 0);  \
  acc[3][0] = __builtin_amdgcn_mfma_f32_32x32x16_bf16(F##a3, F##b0, acc[3][0], 0, 0, 0);                        \
  acc[3][1] = __builtin_amdgcn_mfma_f32_32x32x16_bf16(F##a3, F##b1, acc[3][1], 0, 0, 0);                        \
  if (NJ >= 3) acc[3][NJ >= 3 ? 2 : 0] = __builtin_amdgcn_mfma_f32_32x32x16_bf16(F##a3, F##b2, acc[3][NJ >= 3 ? 2 : 0], 0, 0, 0); \
  if (NJ == 4) acc[3][NJ - 1] = __builtin_amdgcn_mfma_f32_32x32x16_bf16(F##a3, F##b3, acc[3][NJ - 1], 0, 0, 0);
#define BIG_COMPUTE(BUF)                 \
  BIG_LOADF(f, aA0, aB0, BUF)            \
  BIG_LOADF(h, aA1, aB1, BUF)            \
  BIG_WAITF(NJ + 4, f)                   \
  BIG_MFMA(f)                            \
  BIG_WAITF(0, h)                        \
  BIG_MFMA(h)
  bf16x8 fa0, fa1, fa2, fa3, fb0, fb1, fb2, fb3, ha0, ha1, ha2, ha3, hb0, hb1, hb2, hb3;
  fb2 = fb3 = hb2 = hb3 = bf16x8{0, 0, 0, 0, 0, 0, 0, 0};
  const int nk = K >> 5;
  const int klast = K - 32;
  BIG_GLOAD(p, 0)
  BIG_GLOAD(q, 32)
  BIG_SSTORE(p, 0)
  __syncthreads();
  for (int kt = 0; kt < nk; kt += 2) {
    {
      int k0 = (kt + 2) << 5;
      k0 = k0 > klast ? klast : k0;
      BIG_GLOAD(p, k0)
    }
    BIG_COMPUTE(0)
    BIG_SSTORE(q, 1)
    __syncthreads();
    {
      int k0 = (kt + 3) << 5;
      k0 = k0 > klast ? klast : k0;
      BIG_GLOAD(q, k0)
    }
    BIG_COMPUTE(1)
    BIG_SSTORE(p, 0)
    __syncthreads();
  }
  epi(acc, n0 + wn * 128, m0 + wm * 32 * NJ, lane);
}


template <int NJ, class Epi>
DEV void big_gemm_phase(const u16* A, int lda, const u16* B, int ldb, int K, int NF, int G, int bid, int nblk, char* smem,
                        const Epi& epi, const XcdMap& xm) {
  constexpr int TT = 64 * NJ;
  const int NT = MR / TT;
  if (xm.nx > 0) {
    const int xcd = xm.ord, slot = xm.rank;
    const int rem = NT % xm.nx;
    const int TPX = NT / xm.nx + (xcd < rem ? 1 : 0);
    const int t0 = xcd * (NT / xm.nx) + (xcd < rem ? xcd : rem);
    for (int j = slot; j < NF * TPX; j += xm.nloc) {
      int f = (j / (G * TPX)) * G + j % G;
      int t = t0 + (j / G) % TPX;
      gemm_big<NJ>(A, lda, B, ldb, K, f * 256, t * TT, smem, epi);
    }
  } else {
    for (int job = bid; job < NF * NT; job += nblk) gemm_big<NJ>(A, lda, B, ldb, K, (job % NF) * 256, (job / NF) * TT, smem, epi);
  }
}

template <int NI, int NJ, class F>
DEV void for_quads(f32x16 (&acc)[NI][NJ], int nW, int mW, int lane, F f) {
#pragma unroll
  for (int i = 0; i < NI; ++i)
#pragma unroll
    for (int j = 0; j < NJ; ++j)
#pragma unroll
      for (int q = 0; q < 4; ++q) {
        int nf = nW + i * 32 + 8 * q + 4 * (lane >> 5);
        int m = mW + j * 32 + (lane & 31);
        f(nf, m, acc[i][j][4 * q], acc[i][j][4 * q + 1], acc[i][j][4 * q + 2], acc[i][j][4 * q + 3]);
      }
}

struct EpiInproj {
  const Params& P;
  template <int NI, int NJ>
  DEV void operator()(f32x16 (&acc)[NI][NJ], int nW, int mW, int lane) const {
    const int hi = lane >> 5;
#pragma unroll
    for (int i = 0; i < NI; ++i) {
      const int nt = nW + i * 32;
#pragma unroll
      for (int j = 0; j < NJ; ++j) {
        const int m = mW + j * 32 + (lane & 31);
        f32x16 a = acc[i][j];
        if (nt < 384) {
#pragma unroll
          for (int q = 0; q < 4; ++q) {
            int nf = nt + 8 * q + 4 * hi;
            int g = nf >> 4, h = nf & 15;
            u16* dst = P.UB() + ((size_t)(g * NCH + (m >> 5))) * 768 + (m & 31) * 16 + h;
            store_bf4(dst, a[4 * q], a[4 * q + 1], a[4 * q + 2], a[4 * q + 3]);
          }
        } else if (nt < 640) {
#pragma unroll
          for (int q = 0; q < 4; ++q) {
            int nf = nt + 8 * q + 4 * hi - 384;
            store_bf4(P.fbuf() + (size_t)m * 256 + nf, a[4 * q], a[4 * q + 1], a[4 * q + 2], a[4 * q + 3]);
          }
        } else if (nt < 1408) {
          const bool isq = nt < 1024;
          const int off = nt - (isq ? 640 : 1024);
          if (m < NLAT) {
            const int l = m & (SEQ - 1);
            const float pos = (off & 32) ? (float)(l & 63) : (float)(l >> 6);
#pragma unroll
            for (int e = 0; e < 8; ++e) {
              int fl = 8 * (e >> 2) + 4 * hi + (e & 3);
              float freq = exp2f(-(float)fl * (13.287712379549449f / 16.f));
              float rev = pos * freq * 0.15915494309189535f;
              float sn = hw_sin_rev(rev), cs = hw_cos_rev(rev);
              float x1 = a[e], x2 = a[e + 8];
              a[e] = x1 * cs - x2 * sn;
              a[e + 8] = x2 * cs + x1 * sn;
            }
          }
          const float sc = isq ? 0.125f : 1.f;
          u16* base = (isq ? P.qbuf() : P.kbuf()) + (size_t)m * 384 + off;
#pragma unroll
          for (int q = 0; q < 4; ++q)
            store_bf4(base + 8 * q + 4 * hi, a[4 * q] * sc, a[4 * q + 1] * sc, a[4 * q + 2] * sc, a[4 * q + 3] * sc);
        } else {
#pragma unroll
          for (int r = 0; r < 16; ++r) {
            int feat = nt - 1408 + (r & 3) + 8 * (r >> 2) + 4 * hi;
            if (m < NLAT)
              P.vT()[((size_t)((m >> 13) * 384 + feat)) * SEQ + (m & (SEQ - 1))] = f2bf(a[r]);
            else
              P.vTc()[((size_t)(((m - NLAT) >> 8) * 384 + feat)) * LCX + ((m - NLAT) & 255)] = f2bf(a[r]);
          }
        }
      }
    }
  }
};

struct EpiSsmEnd {
  float* Eg;
  template <int NI, int NJ>
  DEV void operator()(f32x16 (&acc)[NI][NJ], int nW, int mW, int lane) const {
    for_quads(acc, nW, mW, lane, [&](int nf, int m, float a, float b, float c, float d) {
      if (m < NCH) *(float4*)(Eg + (size_t)m * 256 + nf) = make_float4(a, b, c, d);
    });
  }
};

DEV float gelu_tanh(float x) {
  float u = 0.7978845608028654f * (x + 0.044715f * x * x * x);
  float t = 1.f - 2.f / (1.f + __expf(2.f * u));
  return 0.5f * x * (1.f + t);
}

struct EpiSsmOut {
  u16* zb;
  int g;
  template <int NI, int NJ>
  DEV void operator()(f32x16 (&acc)[NI][NJ], int nW, int mW, int lane) const {
    for_quads(acc, nW, mW, lane, [&](int nf, int m, float a, float b, float c, float d) {
      if (m < NCH) {
        int t = nf >> 4, h = nf & 15;
        store_bf4(zb + ((size_t)g * MR + m * TCH + t) * 16 + h, gelu_tanh(a), gelu_tanh(b), gelu_tanh(c),
                  gelu_tanh(d));
      }
    });
  }
};

struct EpiGlu {
  const u16* zb;
  u16* yc;
  template <int NI, int NJ>
  DEV void operator()(f32x16 (&acc)[NI][NJ], int nW, int mW, int lane) const {
    for_quads(acc, nW, mW, lane, [&](int nf, int m, float a, float b, float c, float d) {
      uint2 zz = *(const uint2*)(zb + ((size_t)(nf >> 4) * MR + m) * 16 + (nf & 15));
      float z0 = bf2f((u16)(zz.x & 0xffff)), z1 = bf2f((u16)(zz.x >> 16));
      float z2 = bf2f((u16)(zz.y & 0xffff)), z3 = bf2f((u16)(zz.y >> 16));
      store_bf4(yc + (size_t)m * 1024 + nf, z0 / (1.f + __expf(-a)), z1 / (1.f + __expf(-b)), z2 / (1.f + __expf(-c)),
                z3 / (1.f + __expf(-d)));
    });
  }
};

struct EpiFnetA {
  u16* A1b;
  template <int NI, int NJ>
  DEV void operator()(f32x16 (&acc)[NI][NJ], int nW, int mW, int lane) const {
    for_quads(acc, nW, mW, lane, [&](int nf, int m, float a, float b, float c, float d) {
      int k1 = nf >> 1;
      int cc = m >> 8, j = m & 255;
      u16* p = A1b + ((size_t)(k1 * 128 + cc * 2)) * 256 + j;
      p[0] = f2bf(a);
      p[256] = f2bf(b);
      p[128 * 256] = f2bf(c);
      p[128 * 256 + 256] = f2bf(d);
    });
  }
};

struct EpiFnetCtx {
  u16* Gb;
  template <int NI, int NJ>
  DEV void operator()(f32x16 (&acc)[NI][NJ], int nW, int mW, int lane) const {
    for_quads(acc, nW, mW, lane, [&](int nf, int m, float a, float b, float c, float d) {
      int k = nf >> 1;
      const float s = 1.f / 128.f;
      u16* p = Gb + (size_t)k * 512 + m;
      p[0] = f2bf(a * s);
      p[256] = f2bf(b * s);
      p[512] = f2bf(c * s);
      p[512 + 256] = f2bf(d * s);
    });
  }
};

struct EpiFnetC {
  u16* Gb;
  template <int NI, int NJ>
  DEV void operator()(f32x16 (&acc)[NI][NJ], int nW, int mW, int lane) const {
    for_quads(acc, nW, mW, lane, [&](int nf, int m, float a, float b, float c, float d) {
      int k2 = nf >> 1;
      const float s = 0.0013810679320049757f;
      u16* p = Gb + (size_t)k2 * 128 * 512 + m;
      p[0] = f2bf(a * s);
      p[256] = f2bf(b * s);
      p[128 * 512] = f2bf(c * s);
      p[128 * 512 + 256] = f2bf(d * s);
    });
  }
};

struct EpiStoreBf {
  u16* dst;
  int ld, coff;
  template <int NI, int NJ>
  DEV void operator()(f32x16 (&acc)[NI][NJ], int nW, int mW, int lane) const {
    for_quads(acc, nW, mW, lane, [&](int nf, int m, float a, float b, float c, float d) {
      store_bf4(dst + (size_t)m * ld + coff + nf, a, b, c, d);
    });
  }
};

struct EpiGateUp {
  u16* hid;
  template <int NI, int NJ>
  DEV void operator()(f32x16 (&acc)[NI][NJ], int nW, int mW, int lane) const {
    const int hi = lane >> 5;
#pragma unroll
    for (int ip = 0; ip < NI / 2; ++ip)
#pragma unroll
      for (int j = 0; j < NJ; ++j) {
        const int m = mW + j * 32 + (lane & 31);
#pragma unroll
        for (int q = 0; q < 4; ++q) {
          float o[4];
#pragma unroll
          for (int e = 0; e < 4; ++e) {
            float g = acc[2 * ip][j][4 * q + e], u = acc[2 * ip + 1][j][4 * q + e];
            o[e] = g / (1.f + __expf(-g)) * u;
          }
          int col = (nW >> 6) * 32 + ip * 32 + 8 * q + 4 * hi;
          store_bf4(hid + (size_t)m * DFF + col, o[0], o[1], o[2], o[3]);
        }
      }
  }
};

DEV void transpose_tile(const float* src, int K, int N, u16* dst, int mode, int t0, int NTN, char* smem) {
  float* s = (float*)smem;
  const int tid = g_tid();
  float4 v[2][4];
#pragma unroll
  for (int h = 0; h < 2; ++h) {
    const int k0 = ((t0 + h) / NTN) * 64, n0 = ((t0 + h) % NTN) * 64;
#pragma unroll
    for (int i = 0; i < 4; ++i) {
      int id = tid + 256 * i;
      int kk = id >> 4, c4 = id & 15;
      v[h][i] = *(const float4*)(src + (size_t)(k0 + kk) * N + n0 + c4 * 4);
    }
  }
#pragma unroll
  for (int h = 0; h < 2; ++h)
#pragma unroll
    for (int i = 0; i < 4; ++i) {
      int id = tid + 256 * i;
      int kk = id >> 4, c4 = id & 15;
      float* d = s + h * 4160 + kk * 65 + c4 * 4;
      d[0] = v[h][i].x;
      d[1] = v[h][i].y;
      d[2] = v[h][i].z;
      d[3] = v[h][i].w;
    }
  __syncthreads();
#pragma unroll
  for (int h = 0; h < 2; ++h) {
    const int k0 = ((t0 + h) / NTN) * 64, n0 = ((t0 + h) % NTN) * 64;
    const float* sh = s + h * 4160;
#pragma unroll
    for (int i = 0; i < 2; ++i) {
      int id = tid + 256 * i;
      int nn = id >> 3, kc = id & 7;
      int n = n0 + nn;
      int row = mode == 0 ? n : (64 * (n >> 5) + (n & 31) + (mode == 2 ? 32 : 0));
      uint4 o;
      o.x = pack2(sh[(kc * 8 + 0) * 65 + nn], sh[(kc * 8 + 1) * 65 + nn]);
      o.y = pack2(sh[(kc * 8 + 2) * 65 + nn], sh[(kc * 8 + 3) * 65 + nn]);
      o.z = pack2(sh[(kc * 8 + 4) * 65 + nn], sh[(kc * 8 + 5) * 65 + nn]);
      o.w = pack2(sh[(kc * 8 + 6) * 65 + nn], sh[(kc * 8 + 7) * 65 + nn]);
      *(uint4*)(dst + (size_t)row * K + k0 + kc * 8) = o;
    }
  }
  __syncthreads();
}

DEV void lam_pow(float are, float aim, float dt, int n, float& pr, float& pi) {
  float mag = expf((float)n * are * dt);
  double rev = (double)n * (double)aim * (double)dt * 0.15915494309189535;
  rev -= rint(rev);
  float fr = (float)rev;
  pr = mag * hw_cos_rev(fr);
  pi = mag * hw_sin_rev(fr);
}
DEV void zoh_factor(float are, float aim, float dt, float& fr, float& fi) {
  float lr, li;
  lam_pow(are, aim, dt, 1, lr, li);
  float nr = lr - 1.f, ni = li;
  float d2 = are * are + aim * aim;
  fr = (nr * are + ni * aim) / d2;
  fi = (ni * are - nr * aim) / d2;
}

constexpr int PREP_TR = 1426;
constexpr int PREP_KF = 24 * 63;
constexpr int PREP_WC = 24 * 2 * 32;
constexpr int PREP_WE = 24 * 2 * 8;
constexpr int PREP_MW = 64;
constexpr int PREP_N = PREP_TR + PREP_KF + PREP_WC + PREP_WE + PREP_MW;
constexpr int EXPAND_N = 24 * 32;

DEV void prep_job(const Params& P, int layer, int job, char* smem) {
  const int tid = g_tid();
  if (job < PREP_TR) {
    int j = job * 2;
    if (j < 448) { transpose_tile(P.w_in + (size_t)layer * DM * INW, DM, INW, P.wt_in(), 0, j, 28, smem); return; }
    j -= 448;
    if (j < 256) { transpose_tile(P.w_out + (size_t)layer * DM * DM, DM, DM, P.wt_out(), 0, j, 16, smem); return; }
    j -= 256;
    if (j < 36) { transpose_tile(P.w_glu + (size_t)layer * 384 * 384, 384, 384, P.wt_glu(), 0, j, 6, smem); return; }
    j -= 36;
    if (j < 704) { transpose_tile(P.w_gate + (size_t)layer * DM * DFF, DM, DFF, P.wt_gu(), 1, j, 44, smem); return; }
    j -= 704;
    if (j < 704) { transpose_tile(P.w_up + (size_t)layer * DM * DFF, DM, DFF, P.wt_gu(), 2, j, 44, smem); return; }
    j -= 704;
    transpose_tile(P.w_down + (size_t)layer * DFF * DM, DFF, DM, P.wt_dn(), 0, j, 16, smem);
    return;
  }
  job -= PREP_TR;
  float* sf = (float*)smem;
  if (job < PREP_KF) {
    const int g = job / 63, delta = job % 63 - 31;
    const int ad = delta < 0 ? -delta : delta;
    float* sQ = sf;
    float* sCQ = sf + 256;
    float* sB = sf + 256 + 4096;
#pragma unroll
    for (int i = 0; i < 4; ++i) {
      const float* src = ((i & 1) ? P.b_im : P.b_re) + ((size_t)(((layer * 2 + (i >> 1)) * 24 + g) * 64)) * 16;
      *(float4*)(sB + i * 1024 + tid * 4) = *(const float4*)(src + tid * 4);
    }
    if (tid < 128) {
      int dir = tid >> 6, p = tid & 63;
      int ix = ((layer * 2 + dir) * 24 + g) * 64 + p;
      float are = P.a_re[ix], aim = P.a_im[ix], dt = expf(P.log_dt[(layer * 2 + dir) * 24 + g]);
      float pr, pi, fr, fi;
      lam_pow(are, aim, dt, ad, pr, pi);
      zoh_factor(are, aim, dt, fr, fi);
      sQ[(dir * 64 + p) * 2 + 0] = pr * fr - pi * fi;
      sQ[(dir * 64 + p) * 2 + 1] = pr * fi + pi * fr;
    }
    __syncthreads();
#pragma unroll
    for (int i = 0; i < 8; ++i) {
      int e = tid + 256 * i;
      int dir = e >> 10, h = (e >> 6) & 15, p = e & 63;
      size_t ci = ((size_t)(((layer * 2 + dir) * 24 + g) * 16 + h)) * 64 + p;
      float cr = P.c_re[ci], cim = P.c_im[ci];
      float qr = sQ[(dir * 64 + p) * 2], qi = sQ[(dir * 64 + p) * 2 + 1];
      sCQ[e * 2 + 0] = cr * qr - cim * qi;
      sCQ[e * 2 + 1] = cr * qi + cim * qr;
    }
    __syncthreads();
    const int h = tid >> 4, hp = tid & 15;
    float val = 0.f;
#pragma unroll
    for (int dir = 0; dir < 2; ++dir) {
      bool need = dir == 0 ? (delta >= 0) : (delta <= 0);
      if (need) {
        const float* br = sB + (dir * 2) * 1024 + hp;
        const float* bi = sB + (dir * 2 + 1) * 1024 + hp;
        const float* cq = sCQ + ((dir * 16 + h) * 64) * 2;
#pragma unroll 16
        for (int p = 0; p < 64; ++p) val += cq[p * 2] * br[p * 16] - cq[p * 2 + 1] * bi[p * 16];
      }
    }
    if (delta == 0 && h == hp) val += P.ssm_d[layer * 384 + g * 16 + h];
    P.Ktau()[(size_t)job * 256 + tid] = val;
    __syncthreads();
    return;
  }
  job -= PREP_KF;
  if (job < PREP_WC) {
    const int j = job & 31, dir = (job >> 5) & 1, g = job >> 6;
    float* sP = sf;
    if (tid < 64) {
      int p = tid;
      int ix = ((layer * 2 + dir) * 24 + g) * 64 + p;
      float are = P.a_re[ix], aim = P.a_im[ix], dt = expf(P.log_dt[(layer * 2 + dir) * 24 + g]);
      float pr, pi;
      lam_pow(are, aim, dt, dir == 0 ? j + 1 : 32 - j, pr, pi);
      sP[p * 2] = pr;
      sP[p * 2 + 1] = pi;
      if (j == 0) {
        float tr, ti;
        lam_pow(are, aim, dt, 32, tr, ti);
        P.lamT()[((dir * 24 + g) * 64 + p) * 2] = tr;
        P.lamT()[((dir * 24 + g) * 64 + p) * 2 + 1] = ti;
      }
    }
    __syncthreads();
#pragma unroll
    for (int i = 0; i < 8; ++i) {
      int e = tid + 256 * i;
      int h = e >> 7, pc = e & 127, p = pc >> 1, ri = pc & 1;
      size_t ci = ((size_t)(((layer * 2 + dir) * 24 + g) * 16 + h)) * 64 + p;
      float cr = P.c_re[ci], cim = P.c_im[ci];
      float pr = sP[p * 2], pi = sP[p * 2 + 1];
      float v = ri == 0 ? (cr * pr - cim * pi) : -(cr * pi + cim * pr);
      P.A_out()[((size_t)(g * 512 + j * 16 + h)) * 768 + 512 + dir * 128 + pc] = f2bf(v);
    }
    __syncthreads();
    return;
  }
  job -= PREP_WC;
  if (job < PREP_WE) {
    const int jq = job & 7, dir = (job >> 3) & 1, g = job >> 4;
    float* sP = sf;
    {
      int jj = tid >> 6, p = tid & 63;
      int j = jq * 4 + jj;
      int ix = ((layer * 2 + dir) * 24 + g) * 64 + p;
      float are = P.a_re[ix], aim = P.a_im[ix], dt = expf(P.log_dt[(layer * 2 + dir) * 24 + g]);
      float pr, pi, fr, fi;
      lam_pow(are, aim, dt, dir == 0 ? 31 - j : j, pr, pi);
      zoh_factor(are, aim, dt, fr, fi);
      sP[(jj * 64 + p) * 2] = pr * fr - pi * fi;
      sP[(jj * 64 + p) * 2 + 1] = pr * fi + pi * fr;
    }
    __syncthreads();
    {
      const int prow = tid >> 1, half = tid & 1, p = prow >> 1, ri = prow & 1;
      const size_t bbase = ((size_t)(((layer * 2 + dir) * 24 + g) * 64 + p)) * 16;
      u16* dst = P.A_end() + ((size_t)(g * 256 + dir * 128 + prow)) * 512 + jq * 64 + half * 32;
#pragma unroll
      for (int q = 0; q < 2; ++q) {
        int jj = half * 2 + q;
        float pr = sP[(jj * 64 + p) * 2], pi = sP[(jj * 64 + p) * 2 + 1];
        unsigned pk[8];
#pragma unroll
        for (int h2 = 0; h2 < 8; ++h2) {
          float b0r = P.b_re[bbase + 2 * h2], b0i = P.b_im[bbase + 2 * h2];
          float b1r = P.b_re[bbase + 2 * h2 + 1], b1i = P.b_im[bbase + 2 * h2 + 1];
          float v0 = ri == 0 ? (pr * b0r - pi * b0i) : (pr * b0i + pi * b0r);
          float v1 = ri == 0 ? (pr * b1r - pi * b1i) : (pr * b1i + pi * b1r);
          pk[h2] = pack2(v0, v1);
        }
        *(uint4*)(dst + q * 16) = make_uint4(pk[0], pk[1], pk[2], pk[3]);
        *(uint4*)(dst + q * 16 + 8) = make_uint4(pk[4], pk[5], pk[6], pk[7]);
      }
    }
    __syncthreads();
    return;
  }
  job -= PREP_WE;
  {
    const int nb = job & 7, g = (job >> 3) & 3, ri = job >> 5;
    const float* wf = P.w_fourier + (size_t)layer * 256 * 256;
    float* sW = sf;
    float* sT = sf + 2048;
#pragma unroll
    for (int i = 0; i < 2; ++i) {
      int e = tid + 256 * i;
      *(float4*)(sW + e * 4) = *(const float4*)(wf + (size_t)(g * 64 + (e >> 3)) * 256 + nb * 32 + (e & 7) * 4);
    }
    if (tid < 64) {
      float fr = (float)tid * (1.f / 64.f);
      sT[tid] = ri ? hw_sin_rev(fr) : hw_cos_rev(fr);
    }
    __syncthreads();
    const int nl = tid >> 3, jg = tid & 7;
    const int n = nb * 32 + nl;
    unsigned pk[4];
#pragma unroll
    for (int jp = 0; jp < 4; ++jp) {
      float sum2[2];
#pragma unroll
      for (int q = 0; q < 2; ++q) {
        int j = jg * 8 + jp * 2 + q;
        float sum = 0.f;
#pragma unroll 8
        for (int m = 0; m < 64; ++m) sum += sT[(m * j) & 63] * sW[m * 32 + nl];
        sum2[q] = sum;
      }
      pk[jp] = pack2(sum2[0], sum2[1]);
    }
    *(uint4*)(P.MWt() + (size_t)n * 512 + ri * 256 + g * 64 + jg * 8) = make_uint4(pk[0], pk[1], pk[2], pk[3]);
    __syncthreads();
  }
}

DEV void expand_job(const Params& P, int job) {
  const int tid = g_tid();
  const int g = job >> 5, t = job & 31;
  const int h = tid >> 4, cgp = tid & 15;
  u16* dst = P.A_out() + ((size_t)(g * 512 + t * 16 + h)) * 768 + cgp * 32;
#pragma unroll
  for (int q = 0; q < 2; ++q) {
    int sidx = cgp * 2 + q;
    int dI = t - sidx + 31;
    const float4* src = (const float4*)(P.Ktau() + ((size_t)(g * 63 + dI)) * 256 + h * 16);
    float4 a = src[0], b = src[1], c = src[2], d = src[3];
    *(uint4*)(dst + q * 16) = make_uint4(pack2(a.x, a.y), pack2(a.z, a.w), pack2(b.x, b.y), pack2(b.z, b.w));
    *(uint4*)(dst + q * 16 + 8) = make_uint4(pack2(c.x, c.y), pack2(c.z, c.w), pack2(d.x, d.y), pack2(d.z, d.w));
  }
}

constexpr int CONST_MOD = 384, CONST_D128 = 16, CONST_D256 = 64, CONST_T = 1024;
constexpr int CONST_N = CONST_MOD + CONST_D128 + CONST_D256 + CONST_T;

DEV void const_job(const Params& P, int job, char* smem) {
  const int tid = g_tid();
  if (job < CONST_MOD) {
    const int layer = job / 192, cb = job % 192;
    float* sv = (float*)smem;
    float* red = sv + 3 * 1024;
    for (int i = tid; i < 3 * 1024; i += 256) {
      int v = i >> 10, k = i & 1023;
      float cv = v < 2 ? P.c[v * 1024 + k] : P.c_ctx[k];
      sv[i] = cv / (1.f + __expf(-cv));
    }
    __syncthreads();
    const int kg = tid >> 5, cl = tid & 31;
    const int n = cb * 32 + cl;
    const float* W = P.w_mod + (size_t)layer * DM * 6144 + n;
    float a0 = 0.f, a1 = 0.f, a2 = 0.f;
#pragma unroll 32
    for (int k = kg * 128; k < kg * 128 + 128; ++k) {
      float wv = W[(size_t)k * 6144];
      a0 += sv[k] * wv;
      a1 += sv[1024 + k] * wv;
      a2 += sv[2048 + k] * wv;
    }
    red[(kg * 3 + 0) * 32 + cl] = a0;
    red[(kg * 3 + 1) * 32 + cl] = a1;
    red[(kg * 3 + 2) * 32 + cl] = a2;
    __syncthreads();
    if (tid < 96) {
      int v = tid >> 5, c2 = tid & 31;
      float s = P.b_mod[layer * 6144 + cb * 32 + c2];
      for (int q = 0; q < 8; ++q) s += red[(q * 3 + v) * 32 + c2];
      P.mod()[(layer * 3 + v) * 6144 + cb * 32 + c2] = s;
    }
    __syncthreads();
    return;
  }
  job -= CONST_MOD;
  if (job < CONST_D128) {
#pragma unroll
    for (int i = 0; i < 8; ++i) {
      int idx = job * 2048 + tid + 256 * i;
      int row = idx >> 7, r = idx & 127;
      int k1 = row >> 1, ri = row & 1;
      float fr = (float)((k1 * r) & 127) * (1.f / 128.f);
      P.D128()[idx] = f2bf(ri ? -hw_sin_rev(fr) : hw_cos_rev(fr));
    }
    return;
  }
  job -= CONST_D128;
  if (job < CONST_D256) {
#pragma unroll
    for (int i = 0; i < 8; ++i) {
      int idx = job * 2048 + tid + 256 * i;
      int row = idx >> 8, l = idx & 255;
      int k = row >> 1, ri = row & 1;
      float fr = (float)((k * l) & 255) * (1.f / 256.f);
      P.D256()[idx] = f2bf(ri ? -hw_sin_rev(fr) : hw_cos_rev(fr));
    }
    return;
  }
  job -= CONST_D256;
  {
#pragma unroll
    for (int i = 0; i < 8; ++i) {
      int idx = job * 2048 + tid + 256 * i;
      int k1 = idx >> 14, row = (idx >> 7) & 127, col = idx & 127;
      int k2 = row >> 1, ri = row & 1, cc = col >> 1, rj = col & 1;
      float fr = (float)((cc * (k1 + 128 * k2)) & 8191) * (1.f / 8192.f);
      float cs = hw_cos_rev(fr), sn = hw_sin_rev(fr);
      float v = (ri == rj) ? cs : (ri == 0 ? sn : -sn);
      P.Tmat()[idx] = f2bf(v);
    }
  }
}

DEV float4 ld4(const float* p) { return *(const float4*)p; }
DEV float4 ldbf4(const u16* p) {
  uint2 v = *(const uint2*)p;
  return make_float4(bf2f((u16)(v.x & 0xffff)), bf2f((u16)(v.x >> 16)), bf2f((u16)(v.y & 0xffff)), bf2f((u16)(v.y >> 16)));
}
DEV float sq4(float4 v) { return v.x * v.x + v.y * v.y + v.z * v.z + v.w * v.w; }

constexpr int NR = 4;
DEV void rowop(const Params& P, int kind, int layer, int m0, int lane) {
  const bool last = layer == 1;
  if (kind == 2 && last && m0 >= NLAT) return;
  const int mi = m0 < NLAT ? (m0 >> 13) : 2;
  float* resid = m0 < NLAT ? P.out + (size_t)m0 * DM : P.xctx() + (size_t)(m0 - NLAT) * DM;
  const float* xin;
  if (kind == 0 || (kind == 1 && layer == 0))
    xin = m0 < NLAT ? P.x + (size_t)m0 * DM : P.ctx + (size_t)(m0 - NLAT) * DM;
  else
    xin = resid;
  const float* modv = P.mod() + (size_t)(layer * 3 + mi) * 6144;
  float4 v[NR][4];
#pragma unroll
  for (int r = 0; r < NR; ++r)
#pragma unroll
    for (int i = 0; i < 4; ++i) v[r][i] = ld4(xin + (size_t)r * DM + i * 256 + lane * 4);
  if (kind != 0) {
    const float* gpost = (kind == 1 ? P.g_post_mix : P.g_post_ffn) + layer * DM;
    const float* gate = modv + (kind == 1 ? 2048 : 5120);
    float4 o[NR][4];
    float ss[NR];
#pragma unroll
    for (int r = 0; r < NR; ++r) {
      ss[r] = 0.f;
#pragma unroll
      for (int i = 0; i < 4; ++i) {
        o[r][i] = ldbf4(P.obuf() + (size_t)(m0 + r) * DM + i * 256 + lane * 4);
        ss[r] += sq4(o[r][i]);
      }
    }
    float rinv[NR];
#pragma unroll
    for (int r = 0; r < NR; ++r) rinv[r] = rsqrtf(wave_sum(ss[r]) * (1.f / DM) + EPS);
#pragma unroll
    for (int i = 0; i < 4; ++i) {
      float4 gp = ld4(gpost + i * 256 + lane * 4), gt = ld4(gate + i * 256 + lane * 4);
#pragma unroll
      for (int r = 0; r < NR; ++r) {
        v[r][i].x += gt.x * (o[r][i].x * rinv[r] * gp.x);
        v[r][i].y += gt.y * (o[r][i].y * rinv[r] * gp.y);
        v[r][i].z += gt.z * (o[r][i].z * rinv[r] * gp.z);
        v[r][i].w += gt.w * (o[r][i].w * rinv[r] * gp.w);
      }
    }
    float* dst = (kind == 2 && last) ? P.out + (size_t)m0 * DM : resid;
#pragma unroll
    for (int r = 0; r < NR; ++r)
#pragma unroll
      for (int i = 0; i < 4; ++i) *(float4*)(dst + (size_t)r * DM + i * 256 + lane * 4) = v[r][i];
    if (kind == 2 && last) return;
  }
  const int la = kind == 2 ? layer + 1 : layer;
  const float* gpre = (kind == 1 ? P.g_pre_ffn : P.g_pre_mix) + la * DM;
  const float* mv = P.mod() + (size_t)(la * 3 + mi) * 6144;
  const float* sh = mv + (kind == 1 ? 3072 : 0);
  const float* sc = mv + (kind == 1 ? 4096 : 1024);
  float rinv2[NR];
#pragma unroll
  for (int r = 0; r < NR; ++r) {
    float ss = 0.f;
#pragma unroll
    for (int i = 0; i < 4; ++i) ss += sq4(v[r][i]);
    rinv2[r] = rsqrtf(wave_sum(ss) * (1.f / DM) + EPS);
  }
#pragma unroll
  for (int i = 0; i < 4; ++i) {
    int col = i * 256 + lane * 4;
    float4 gp = ld4(gpre + col), s1 = ld4(sc + col), s0 = ld4(sh + col);
#pragma unroll
    for (int r = 0; r < NR; ++r)
      store_bf4(P.abuf() + (size_t)(m0 + r) * DM + col, v[r][i].x * rinv2[r] * gp.x * (1.f + s1.x) + s0.x,
                v[r][i].y * rinv2[r] * gp.y * (1.f + s1.y) + s0.y, v[r][i].z * rinv2[r] * gp.z * (1.f + s1.z) + s0.z,
                v[r][i].w * rinv2[r] * gp.w * (1.f + s1.w) + s0.w);
  }
}

DEV void attn_wave(const Params& P, int layer, bool isctx, int b, int h, int r, int cgp, int lane) {
  const int qi = lane & 15, g = lane >> 4;
  int mq, c = 0, cs = 0, cb = 0, rs = 0;
  if (!isctx) {
    c = cgp * 16 + qi;
    mq = b * SEQ + r * 64 + c;
    cs = c - 8;
    cs = cs < 0 ? 0 : (cs > 48 ? 48 : cs);
    cb = cgp == 0 ? 0 : (cgp == 1 ? 8 : (cgp == 2 ? 24 : 32));
    rs = r - 4;
    rs = rs < 0 ? 0 : (rs > 120 ? 120 : rs);
  } else {
    mq = NLAT + b * LCX + cgp * 16 + qi;
  }
  const u16* qp = P.qbuf() + (size_t)mq * 384 + h * 64 + g * 8;
  const bf16x8 qf0 = *(const bf16x8*)qp, qf1 = *(const bf16x8*)(qp + 32);
  f32x4 o[4];
#pragma unroll
  for (int d = 0; d < 4; ++d) o[d] = f32x4{0.f, 0.f, 0.f, 0.f};
  float mrun = -1e30f, lrun = 0.f;
  const float* rp = P.rpb + (size_t)(layer * 6 + h) * 465;
  const int nblk = isctx ? 8 : 16;
  struct KV {
    bf16x8 k00, k01, k10, k11;
    uint2 v0a, v0b, v1a, v1b, v2a, v2b, v3a, v3b;
  };
  auto loadkv = [&](KV& x, int kb) {
    kb = kb < nblk ? kb : nblk - 1;
    const bool win = (!isctx) && kb < 8;
    size_t krow0;
    const u16* vbase;
    int vld;
    if (win) {
      int tok0 = (rs + kb) * 64 + cb;
      krow0 = (size_t)b * SEQ + tok0;
      vbase = P.vT() + ((size_t)(b * 384 + h * 64)) * SEQ + tok0;
      vld = SEQ;
    } else {
      int kc = (isctx ? kb : kb - 8) * 32;
      krow0 = (size_t)NLAT + b * LCX + kc;
      vbase = P.vTc() + ((size_t)(b * 384 + h * 64)) * LCX + kc;
      vld = LCX;
    }
    const u16* kp0 = P.kbuf() + (krow0 + qi) * 384 + h * 64 + g * 8;
    const u16* kp1 = kp0 + 16 * 384;
    x.k00 = *(const bf16x8*)kp0;
    x.k01 = *(const bf16x8*)(kp0 + 32);
    x.k10 = *(const bf16x8*)kp1;
    x.k11 = *(const bf16x8*)(kp1 + 32);
    const u16* vp = vbase + (size_t)qi * vld + g * 4;
    x.v0a = *(const uint2*)vp;
    x.v0b = *(const uint2*)(vp + 16);
    x.v1a = *(const uint2*)(vp + (size_t)16 * vld);
    x.v1b = *(const uint2*)(vp + (size_t)16 * vld + 16);
    x.v2a = *(const uint2*)(vp + (size_t)32 * vld);
    x.v2b = *(const uint2*)(vp + (size_t)32 * vld + 16);
    x.v3a = *(const uint2*)(vp + (size_t)48 * vld);
    x.v3b = *(const uint2*)(vp + (size_t)48 * vld + 16);
  };
  auto pvmma = [&](f32x4& od, uint2 va, uint2 vb, bf16x8 pf) {
    union { uint4 u; bf16x8 v; } cv;
    cv.u = make_uint4(va.x, va.y, vb.x, vb.y);
    od = __builtin_amdgcn_mfma_f32_16x16x32_bf16(cv.v, pf, od, 0, 0, 0);
  };
  auto step = [&](const KV& x, int kb) {
    const bool win = (!isctx) && kb < 8;
    f32x4 s[2];
    {
      f32x4 z = {0.f, 0.f, 0.f, 0.f};
      z = __builtin_amdgcn_mfma_f32_16x16x32_bf16(x.k00, qf0, z, 0, 0, 0);
      s[0] = __builtin_amdgcn_mfma_f32_16x16x32_bf16(x.k01, qf1, z, 0, 0, 0);
      f32x4 z2 = {0.f, 0.f, 0.f, 0.f};
      z2 = __builtin_amdgcn_mfma_f32_16x16x32_bf16(x.k10, qf0, z2, 0, 0, 0);
      s[1] = __builtin_amdgcn_mfma_f32_16x16x32_bf16(x.k11, qf1, z2, 0, 0, 0);
    }
    if (win) {
      const int dr = rs + kb - r + 7;
#pragma unroll
      for (int t = 0; t < 2; ++t)
#pragma unroll
        for (int i = 0; i < 4; ++i) {
          int keycol = cb + t * 16 + g * 4 + i;
          bool valid = keycol >= cs && keycol < cs + 16;
          int dc = keycol - c + 15;
          dc = dc < 0 ? 0 : (dc > 30 ? 30 : dc);
          float bias = rp[dr * 31 + dc];
          s[t][i] = valid ? s[t][i] + bias : -1e30f;
        }
    }
    float mx = fmaxf(fmaxf(fmaxf(s[0][0], s[0][1]), fmaxf(s[0][2], s[0][3])),
                     fmaxf(fmaxf(s[1][0], s[1][1]), fmaxf(s[1][2], s[1][3])));
    mx = fmaxf(mx, __shfl_xor(mx, 16));
    mx = fmaxf(mx, __shfl_xor(mx, 32));
    const float mnew = fmaxf(mrun, mx);
    const float alpha = __expf(mrun - mnew);
    mrun = mnew;
    float p[8], psum = 0.f;
#pragma unroll
    for (int t = 0; t < 2; ++t)
#pragma unroll
      for (int i = 0; i < 4; ++i) {
        p[t * 4 + i] = __expf(s[t][i] - mnew);
        psum += p[t * 4 + i];
      }
    lrun = lrun * alpha + psum;
    bf16x8 pf;
#pragma unroll
    for (int e = 0; e < 8; ++e) pf[e] = (short)f2bf(p[e]);
#pragma unroll
    for (int d = 0; d < 4; ++d) o[d] *= alpha;
    pvmma(o[0], x.v0a, x.v0b, pf);
    pvmma(o[1], x.v1a, x.v1b, pf);
    pvmma(o[2], x.v2a, x.v2b, pf);
    pvmma(o[3], x.v3a, x.v3b, pf);
  };
  KV ka, kb2;
  loadkv(ka, 0);
  for (int kb = 0; kb < nblk; kb += 2) {
    loadkv(kb2, kb + 1);
    step(ka, kb);
    loadkv(ka, kb + 2);
    step(kb2, kb + 1);
  }
  float l = lrun + __shfl_xor(lrun, 16);
  l += __shfl_xor(l, 32);
  const float inv = 1.f / l;
#pragma unroll
  for (int d = 0; d < 4; ++d)
    store_bf4(P.ycat() + (size_t)mq * DM + 640 + h * 64 + d * 16 + g * 4, o[d][0] * inv, o[d][1] * inv, o[d][2] * inv,
              o[d][3] * inv);
}

DEV void attn_wave2(const Params& P, int layer, int b, int h, int r, int cgp, int lane) {
  const int qi = lane & 15, g = lane >> 4;
  const int c = cgp * 16 + qi;
  int cs = c - 8;
  cs = cs < 0 ? 0 : (cs > 48 ? 48 : cs);
  const int cb = cgp == 0 ? 0 : (cgp == 1 ? 8 : (cgp == 2 ? 24 : 32));
  int rsA = r - 4, rsB = r - 3;
  rsA = rsA < 0 ? 0 : (rsA > 120 ? 120 : rsA);
  rsB = rsB < 0 ? 0 : (rsB > 120 ? 120 : rsB);
  const int nwin = rsB - rsA + 8, nb = nwin + 8;
  const int mqA = b * SEQ + r * 64 + c, mqB = mqA + 64;
  const u16* qpA = P.qbuf() + (size_t)mqA * 384 + h * 64 + g * 8;
  const u16* qpB = qpA + 64 * 384;
  const bf16x8 qA0 = *(const bf16x8*)qpA, qA1 = *(const bf16x8*)(qpA + 32);
  const bf16x8 qB0 = *(const bf16x8*)qpB, qB1 = *(const bf16x8*)(qpB + 32);
  f32x4 oA[4], oB[4];
#pragma unroll
  for (int d = 0; d < 4; ++d) oA[d] = oB[d] = f32x4{0.f, 0.f, 0.f, 0.f};
  float mA = -1e30f, lA = 0.f, mB = -1e30f, lB = 0.f;
  const float* rp = P.rpb + (size_t)(layer * 6 + h) * 465;
  struct KV {
    bf16x8 k00, k01, k10, k11;
    uint2 v0a, v0b, v1a, v1b, v2a, v2b, v3a, v3b;
  };
  auto loadkv = [&](KV& x, int idx) {
    idx = idx < nb ? idx : nb - 1;
    size_t krow0;
    const u16* vbase;
    int vld;
    if (idx < nwin) {
      int tok0 = (rsA + idx) * 64 + cb;
      krow0 = (size_t)b * SEQ + tok0;
      vbase = P.vT() + ((size_t)(b * 384 + h * 64)) * SEQ + tok0;
      vld = SEQ;
    } else {
      int kc = (idx - nwin) * 32;
      krow0 = (size_t)NLAT + b * LCX + kc;
      vbase = P.vTc() + ((size_t)(b * 384 + h * 64)) * LCX + kc;
      vld = LCX;
    }
    const u16* kp0 = P.kbuf() + (krow0 + qi) * 384 + h * 64 + g * 8;
    const u16* kp1 = kp0 + 16 * 384;
    x.k00 = *(const bf16x8*)kp0;
    x.k01 = *(const bf16x8*)(kp0 + 32);
    x.k10 = *(const bf16x8*)kp1;
    x.k11 = *(const bf16x8*)(kp1 + 32);
    const u16* vp = vbase + (size_t)qi * vld + g * 4;
    x.v0a = *(const uint2*)vp;
    x.v0b = *(const uint2*)(vp + 16);
    x.v1a = *(const uint2*)(vp + (size_t)16 * vld);
    x.v1b = *(const uint2*)(vp + (size_t)16 * vld + 16);
    x.v2a = *(const uint2*)(vp + (size_t)32 * vld);
    x.v2b = *(const uint2*)(vp + (size_t)32 * vld + 16);
    x.v3a = *(const uint2*)(vp + (size_t)48 * vld);
    x.v3b = *(const uint2*)(vp + (size_t)48 * vld + 16);
  };
  auto pvmma = [&](f32x4& od, uint2 va, uint2 vb, bf16x8 pf) {
    union { uint4 u; bf16x8 v; } cv;
    cv.u = make_uint4(va.x, va.y, vb.x, vb.y);
    od = __builtin_amdgcn_mfma_f32_16x16x32_bf16(cv.v, pf, od, 0, 0, 0);
  };
  auto update = [&](const KV& x, f32x4 (&o)[4], float& mrun, float& lrun, bf16x8 q0, bf16x8 q1, int dr) {
    f32x4 s[2];
    {
      f32x4 z = {0.f, 0.f, 0.f, 0.f};
      z = __builtin_amdgcn_mfma_f32_16x16x32_bf16(x.k00, q0, z, 0, 0, 0);
      s[0] = __builtin_amdgcn_mfma_f32_16x16x32_bf16(x.k01, q1, z, 0, 0, 0);
      f32x4 z2 = {0.f, 0.f, 0.f, 0.f};
      z2 = __builtin_amdgcn_mfma_f32_16x16x32_bf16(x.k10, q0, z2, 0, 0, 0);
      s[1] = __builtin_amdgcn_mfma_f32_16x16x32_bf16(x.k11, q1, z2, 0, 0, 0);
    }
    if (dr >= 0) {
#pragma unroll
      for (int t = 0; t < 2; ++t)
#pragma unroll
        for (int i = 0; i < 4; ++i) {
          int keycol = cb + t * 16 + g * 4 + i;
          bool valid = keycol >= cs && keycol < cs + 16;
          int dc = keycol - c + 15;
          dc = dc < 0 ? 0 : (dc > 30 ? 30 : dc);
          float bias = rp[dr * 31 + dc];
          s[t][i] = valid ? s[t][i] + bias : -1e30f;
        }
    }
    float mx = fmaxf(fmaxf(fmaxf(s[0][0], s[0][1]), fmaxf(s[0][2], s[0][3])),
                     fmaxf(fmaxf(s[1][0], s[1][1]), fmaxf(s[1][2], s[1][3])));
    mx = fmaxf(mx, __shfl_xor(mx, 16));
    mx = fmaxf(mx, __shfl_xor(mx, 32));
    const float mnew = fmaxf(mrun, mx);
    const float alpha = __expf(mrun - mnew);
    mrun = mnew;
    float p[8], psum = 0.f;
#pragma unroll
    for (int t = 0; t < 2; ++t)
#pragma unroll
      for (int i = 0; i < 4; ++i) {
        p[t * 4 + i] = __expf(s[t][i] - mnew);
        psum += p[t * 4 + i];
      }
    lrun = lrun * alpha + psum;
    bf16x8 pf;
#pragma unroll
    for (int e = 0; e < 8; ++e) pf[e] = (short)f2bf(p[e]);
#pragma unroll
    for (int d = 0; d < 4; ++d) o[d] *= alpha;
    pvmma(o[0], x.v0a, x.v0b, pf);
    pvmma(o[1], x.v1a, x.v1b, pf);
    pvmma(o[2], x.v2a, x.v2b, pf);
    pvmma(o[3], x.v3a, x.v3b, pf);
  };
  auto step = [&](const KV& x, int idx) {
    if (idx < nwin) {
      const int kr = rsA + idx;
      if (kr < rsA + 8) update(x, oA, mA, lA, qA0, qA1, kr - r + 7);
      if (kr >= rsB) update(x, oB, mB, lB, qB0, qB1, kr - (r + 1) + 7);
    } else {
      update(x, oA, mA, lA, qA0, qA1, -1);
      update(x, oB, mB, lB, qB0, qB1, -1);
    }
  };
  KV ka, kb2;
  loadkv(ka, 0);
  for (int idx = 0; idx < nb; idx += 2) {
    loadkv(kb2, idx + 1);
    step(ka, idx);
    loadkv(ka, idx + 2);
    if (idx + 1 < nb) step(kb2, idx + 1);
  }
  {
    float l = lA + __shfl_xor(lA, 16);
    l += __shfl_xor(l, 32);
    const float inv = 1.f / l;
#pragma unroll
    for (int d = 0; d < 4; ++d)
      store_bf4(P.ycat() + (size_t)mqA * DM + 640 + h * 64 + d * 16 + g * 4, oA[d][0] * inv, oA[d][1] * inv,
                oA[d][2] * inv, oA[d][3] * inv);
  }
  {
    float l = lB + __shfl_xor(lB, 16);
    l += __shfl_xor(l, 32);
    const float inv = 1.f / l;
#pragma unroll
    for (int d = 0; d < 4; ++d)
      store_bf4(P.ycat() + (size_t)mqB * DM + 640 + h * 64 + d * 16 + g * 4, oB[d][0] * inv, oB[d][1] * inv,
                oB[d][2] * inv, oB[d][3] * inv);
  }
}

DEV void carry_wave(const Params& P, int wjob, int lane) {
  const int pg = wjob & 7;
  int combo = wjob >> 3;
  const int g = combo % 24;
  combo /= 24;
  const int dir = combo & 1, b = combo >> 1;
  const int p = pg * 8 + (lane & 7), seg = lane >> 3;
  const float lr = P.lamT()[((dir * 24 + g) * 64 + p) * 2], li = P.lamT()[((dir * 24 + g) * 64 + p) * 2 + 1];
  auto chunk_of = [&](int n) {
    if (n < 8) return 512 + b * 8 + (dir ? 7 - n : n);
    int c = n - 8;
    return b * 256 + (dir ? 255 - c : c);
  };
  float cr = 0.f, ci = 0.f;
#pragma unroll 1
  for (int bt = 0; bt < 3; ++bt) {
    float2 e[11];
#pragma unroll
    for (int i = 0; i < 11; ++i) {
      size_t row = (size_t)(g * NCH + chunk_of(seg * 33 + bt * 11 + i));
      e[i] = *(const float2*)(P.E() + row * 256 + dir * 128 + p * 2);
    }
#pragma unroll
    for (int i = 0; i < 11; ++i) {
      float nr = lr * cr - li * ci + e[i].x, ni = lr * ci + li * cr + e[i].y;
      cr = nr;
      ci = ni;
    }
  }
  float sr = lr, si = li;
#pragma unroll
  for (int k = 0; k < 5; ++k) {
    float t = sr * sr - si * si;
    si = 2.f * sr * si;
    sr = t;
  }
  const float l33r = sr * lr - si * li, l33i = sr * li + si * lr;
  float stR = 0.f, stI = 0.f;
#pragma unroll
  for (int k = 1; k < 8; ++k) {
    int src = (lane - 8) & 63;
    float pr_ = __shfl(stR, src), pi_ = __shfl(stI, src), er = __shfl(cr, src), ei = __shfl(ci, src);
    if (seg == k) {
      stR = l33r * pr_ - l33i * pi_ + er;
      stI = l33r * pi_ + l33i * pr_ + ei;
    }
  }
  cr = stR;
  ci = stI;
#pragma unroll 1
  for (int bt = 0; bt < 3; ++bt) {
    float2 e[11];
#pragma unroll
    for (int i = 0; i < 11; ++i) {
      size_t row = (size_t)(g * NCH + chunk_of(seg * 33 + bt * 11 + i));
      e[i] = *(const float2*)(P.E() + row * 256 + dir * 128 + p * 2);
    }
#pragma unroll
    for (int i = 0; i < 11; ++i) {
      size_t row = (size_t)(g * NCH + chunk_of(seg * 33 + bt * 11 + i));
      *(unsigned*)(P.UB() + row * 768 + 512 + dir * 128 + p * 2) = pack2(cr, ci);
      float nr = lr * cr - li * ci + e[i].x, ni = lr * ci + li * cr + e[i].y;
      cr = nr;
      ci = ni;
    }
  }
}

DEV void run_phase(const Params& P, int ph, int bid, int nblk, char* smem, const XcdMap& xm) {
  const int lane = g_tid() & 63, w = g_tid() >> 6;
  if (ph == 0) {
    for (int job = bid; job < CONST_N + PREP_N; job += nblk) {
      if (job < CONST_N) const_job(P, job, smem);
      else prep_job(P, 0, job - CONST_N, smem);
    }
    return;
  }
  if (ph == 1) {
    for (int job = bid; job < MR / 16 + EXPAND_N; job += nblk) {
      if (job < MR / 16) rowop(P, 0, 0, (job * 4 + w) * NR, lane);
      else expand_job(P, job - MR / 16);
    }
    return;
  }
  const int layer = (ph - 2) / 10, sub = (ph - 2) % 10;
  switch (sub) {
    case 0: {
      EpiInproj epi{P};
      big_gemm_phase<2>(P.wt_in(), DM, P.abuf(), DM, DM, 7, 7, bid, nblk, smem, epi, xm);
      if (layer == 1)
        for (int job = bid; job < EXPAND_N; job += nblk) expand_job(P, job);
    } break;
    case 1: {
      const int J0 = 768, J1 = J0 + 48, J2 = J1 + 240, J3 = J2 + 512, J4 = J3 + 16;
      for (int job = bid; job < J4; job += nblk) {
        if (job < J0) {
          int rp2 = job & 63, bh = job >> 6;
          attn_wave2(P, layer, bh / 6, bh % 6, rp2 * 2, w, lane);
        } else if (job < J1) {
          if (layer == 1) continue;
          int j = job - J0;
          int qb = j & 3, bh = j >> 2;
          attn_wave(P, layer, true, bh / 6, bh % 6, 0, qb * 4 + w, lane);
        } else if (job < J2) {
          int j = job - J1;
          int g = j / 10, t = j % 10;
          EpiSsmEnd epi{P.E() + (size_t)g * NCH * 256};
          gemm_tile<0>(P.A_end() + (size_t)g * 256 * 512, 512, P.UB() + (size_t)g * NCH * 768, 768, 512, (t & 1) * 128,
                           (t >> 1) * 128, NCH, smem, epi);
        } else if (job < J3) {
          int j = job - J2;
          int b = j >> 8, t = j & 255;
          EpiFnetA epi{P.A1() + (size_t)b * 128 * 128 * 256};
          gemm_tile<1>(P.D128(), 128, P.fbuf() + (size_t)b * SEQ * 256, 64 * 256, 128, (t & 1) * 128, (t >> 1) * 128,
                          64 * 256, smem, epi);
        } else {
          if (layer == 1) continue;
          int j = job - J3;
          int b = j >> 3, t = j & 7;
          EpiFnetCtx epi{P.Gbuf() + (size_t)(NLAT + b * LCX) * 512};
          gemm_tile<1>(P.D256(), 256, P.fbuf() + (size_t)(NLAT + b * LCX) * 256, 256, 256, (t & 3) * 128, (t >> 2) * 128,
                          256, smem, epi);
        }
      }
    } break;
    case 2: {
      for (int job = bid; job < 192; job += nblk) carry_wave(P, job * 4 + w, lane);
    } break;
    case 3: {
      for (int job = bid; job < 480 + 512; job += nblk) {
        if (job < 480) {
          int g = job / 20, t = job % 20;
          EpiSsmOut epi{P.zbuf(), g};
          gemm_tile<0>(P.A_out() + (size_t)g * 512 * 768, 768, P.UB() + (size_t)g * NCH * 768, 768, 768, (t & 3) * 128,
                       (t >> 2) * 128, NCH, smem, epi);
        } else {
          int j = job - 480;
          int bk = j >> 1, t = j & 1;
          int k1 = bk & 127, b = bk >> 7;
          EpiFnetC epi{P.Gbuf() + (size_t)(b * SEQ + k1) * 512};
          gemm_tile<1>(P.Tmat() + (size_t)k1 * 128 * 128, 128, P.A1() + (size_t)bk * 128 * 256, 256, 128, 0, t * 128, 256,
                       smem, epi);
        }
      }
    } break;
    case 4: {
      for (int job = bid; job < 396 + 264; job += nblk) {
        if (job < 396) {
          EpiGlu epi{P.zbuf(), P.ycat()};
          gemm_tile<2>(P.wt_glu(), 384, P.zbuf(), 384, 384, (job % 3) * 128, (job / 3) * 128, MR, smem, epi);
        } else {
          int j = job - 396;
          EpiStoreBf epi{P.ycat(), DM, 384};
          gemm_tile<0>(P.MWt(), 512, P.Gbuf(), 512, 512, (j & 1) * 128, (j >> 1) * 128, MR, smem, epi);
        }
      }
    } break;
    case 5: {
      EpiStoreBf epi{P.obuf(), DM, 0};
      big_gemm_phase<3>(P.wt_out(), DM, P.ycat(), DM, DM, 4, 4, bid, nblk, smem, epi, xm);
    } break;
    case 6: {
      for (int job = bid; job < MR / 16; job += nblk) rowop(P, 1, layer, (job * 4 + w) * NR, lane);
    } break;
    case 7: {
      EpiGateUp epi{P.hidden()};
      big_gemm_phase<3>(P.wt_gu(), DM, P.abuf(), DM, DM, 22, 2, bid, nblk, smem, epi, xm);
    } break;
    case 8: {
      EpiStoreBf epi{P.obuf(), DM, 0};
      big_gemm_phase<3>(P.wt_dn(), DFF, P.hidden(), DFF, DFF, 4, 4, bid, nblk, smem, epi, xm);
    } break;
    case 9: {
      const int nrow = MR / 16;
      const int total = nrow + (layer == 0 ? PREP_N : 0);
      for (int job = bid; job < total; job += nblk) {
        if (job < nrow) rowop(P, 2, layer, (job * 4 + w) * NR, lane);
        else prep_job(P, 1, job - nrow, smem);
      }
    } break;
  }
}

#if MK_MULTI
__global__ void __launch_bounds__(256, 2) phase_kernel(Params P, int ph) {
  __shared__ __attribute__((aligned(16))) char smem[65536];
  XcdMap xm{0, 0, 0, 0};
  run_phase(P, ph, blockIdx.x, gridDim.x, smem, xm);
}
#else
#define XB_XCNT(j) (64 * (j))
#define XB_XSUB(j) (1024 + 64 * (j))
#define XB_XGEN(j) (2048 + 64 * (j))
#define XB_TOP 3072
#define XB_TOPGEN 3136
#define XB_WORDS 3200
DEV unsigned xb_ld(unsigned* p) { return __hip_atomic_load(p, __ATOMIC_RELAXED, __HIP_MEMORY_SCOPE_AGENT); }
DEV unsigned xb_add(unsigned* p, unsigned v) { return __hip_atomic_fetch_add(p, v, __ATOMIC_RELAXED, __HIP_MEMORY_SCOPE_AGENT); }

DEV void grid_barrier(unsigned* bar, unsigned k, unsigned xcc, unsigned nloc, unsigned nx) {
  asm volatile("s_waitcnt vmcnt(0)" ::: "memory");
  __syncthreads();
  if (threadIdx.x == 0) {
    const unsigned old = xb_add(&bar[XB_XSUB(xcc)], 1u);
    if (old + 1u == k * nloc) {
      __builtin_amdgcn_fence(__ATOMIC_RELEASE, "agent");
      asm volatile("s_waitcnt vmcnt(0)" ::: "memory");
      const unsigned og = xb_add(&bar[XB_TOP], 1u);
      if (og + 1u == k * nx) xb_add(&bar[XB_TOPGEN], 1u);
      else
        while (xb_ld(&bar[XB_TOPGEN]) < k) __builtin_amdgcn_s_sleep(4);
      __builtin_amdgcn_fence(__ATOMIC_ACQUIRE, "agent");
      xb_add(&bar[XB_XGEN(xcc)], 1u);
      asm volatile("s_waitcnt vmcnt(0)" ::: "memory");
    } else {
      while (xb_ld(&bar[XB_XGEN(xcc)]) < k) __builtin_amdgcn_s_sleep(8);
      __builtin_amdgcn_fence(__ATOMIC_ACQUIRE, "agent");
      asm volatile("s_waitcnt vmcnt(0)" ::: "memory");
    }
  }
  __syncthreads();
}

__global__ void __launch_bounds__(256) fwd_megakernel(Params P, unsigned* bar) {
  __shared__ __attribute__((aligned(16))) char smem[65536];
  cg::grid_group grid = cg::this_grid();
  const unsigned xcc = (unsigned)__builtin_amdgcn_s_getreg((3 << 11) | 20) & 0xFu;
  unsigned* s_rank = (unsigned*)smem;
  if (threadIdx.x == 0) *s_rank = xb_add(&bar[XB_XCNT(xcc)], 1u);
  __threadfence();
  grid.sync();
  const unsigned rank = __builtin_amdgcn_readfirstlane(*s_rank);
  __syncthreads();
  unsigned nloc = 0, nx = 0, ord = 0;
#pragma unroll
  for (unsigned j = 0; j < 16; ++j) {
    const unsigned c = xb_ld(&bar[XB_XCNT(j)]);
    nx += c > 0u ? 1u : 0u;
    ord += (c > 0u && j < xcc) ? 1u : 0u;
    nloc = j == xcc ? c : nloc;
  }
  nloc = __builtin_amdgcn_readfirstlane(nloc);
  nx = __builtin_amdgcn_readfirstlane(nx);
  ord = __builtin_amdgcn_readfirstlane(ord);
  const XcdMap xm{(int)ord, (int)nx, (int)rank, (int)nloc};
  unsigned round = 0;
  for (int ph = 0; ph < NPH; ++ph) {
    int bid = blockIdx.x;
    asm volatile("" : "+s"(bid));
    run_phase(P, ph, bid, gridDim.x, smem, xm);
#ifdef PROBE_DUP
    {
      const int sub = ph < 2 ? 10 + ph : (ph - 2) % 10;
      if ((PROBE_DUP >> sub) & 1) {
        grid_barrier(bar, ++round, xcc, nloc, nx);
        asm volatile("" : "+s"(bid));
        run_phase(P, ph, bid, gridDim.x, smem, xm);
      }
    }
#endif
    if (ph + 1 < NPH) grid_barrier(bar, ++round, xcc, nloc, nx);
  }
}
#endif

extern "C" void kernel_launch(void* const* d_in, const int* in_sizes, int n_in, void* d_out, int out_size, void* d_ws,
                              size_t ws_size, hipStream_t stream) {
  Params p{};
  const float* const* in = (const float* const*)d_in;
  p.x = in[0]; p.c = in[1]; p.ctx = in[2]; p.c_ctx = in[3]; p.w_mod = in[4]; p.b_mod = in[5];
  p.g_pre_mix = in[6]; p.g_post_mix = in[7]; p.w_in = in[8]; p.a_re = in[9]; p.a_im = in[10]; p.log_dt = in[11];
  p.b_re = in[12]; p.b_im = in[13]; p.c_re = in[14]; p.c_im = in[15]; p.ssm_d = in[16]; p.w_glu = in[17];
  p.w_fourier = in[18]; p.rpb = in[19]; p.w_out = in[20]; p.g_pre_ffn = in[21]; p.g_post_ffn = in[22];
  p.w_gate = in[23]; p.w_up = in[24]; p.w_down = in[25];
  p.out = (float*)d_out;
  p.ws = (char*)d_ws;
  if (WS_NEED > ws_size) {
    fprintf(stderr, "workspace too small: need %zu have %zu\n", (size_t)WS_NEED, ws_size);
    return;
  }
  unsigned* bar = (unsigned*)(p.ws + O_bar);
#if MK_MULTI
  for (int ph = 0; ph < NPH; ++ph) phase_kernel<<<dim3(1024), dim3(256), 0, stream>>>(p, ph);
#else
  static int grid_blocks = 0;
  if (!grid_blocks) {
    int dev = 0, cus = 0, per_cu = 0;
    hipGetDevice(&dev);
    hipDeviceGetAttribute(&cus, hipDeviceAttributeMultiprocessorCount, dev);
    hipOccupancyMaxActiveBlocksPerMultiprocessor(&per_cu, fwd_megakernel, 256, 0);
    if (per_cu > 2) per_cu = 2;
    grid_blocks = cus * per_cu;
  }
  hipMemsetAsync(bar, 0, XB_WORDS * 4, stream);
  void* args[] = {&p, &bar};
  hipError_t e = hipLaunchCooperativeKernel((void*)fwd_megakernel, dim3(grid_blocks), dim3(256), args, 0, stream);
  if (e != hipSuccess) fprintf(stderr, "cooperative launch failed: %s (grid %d)\n", hipGetErrorString(e), grid_blocks);
#endif
}
```
